# Optimizing an MI355X kernel written in HIP

```python
import jax, jax.numpy as jnp
from jax import lax
import numpy as np

D_MODEL = 1024
BATCH = 16
SEQ = 2048
DEPTH = 1
DEC_BATCH = 32
DEC_SEQ = 32
PAST_LEN = 1024

CHUNK = 64
N_META = 16
D_RG = 1024
N_RG_HEADS = 16
RG_HEAD_DIM = D_RG // N_RG_HEADS
RG_CONV = 4
RG_C = 8.0
D_CV = 1024
CV_CONV = 31
D_MIX = D_RG + D_CV
D_IN = 2 * D_RG + 3 * D_CV
EPS = 1e-6

kernel_name = 'hymba_rglru_conformer_stream_step'


def rms_norm(x, g):
    xf = x.astype(jnp.float32)
    y = xf * lax.rsqrt(jnp.mean(xf * xf, axis=-1, keepdims=True) + EPS)
    return (y * g.astype(jnp.float32)).astype(x.dtype)


def layer_norm(x, g, b):
    xf = x.astype(jnp.float32)
    mu = jnp.mean(xf, axis=-1, keepdims=True)
    xc = xf - mu
    var = jnp.mean(xc * xc, axis=-1, keepdims=True)
    y = xc * lax.rsqrt(var + EPS) * g.astype(jnp.float32) + b.astype(jnp.float32)
    return y.astype(x.dtype)


def causal_dwconv(x, buf, w, b):
    width = w.shape[0]
    xp = jnp.concatenate([buf.astype(x.dtype), x], axis=1)
    y = lax.conv_general_dilated(
        xp, w[:, None, :].astype(x.dtype), window_strides=(1,), padding='VALID',
        dimension_numbers=('NWC', 'WIO', 'NWC'), feature_group_count=x.shape[-1])
    return y + b.astype(x.dtype), xp[:, xp.shape[1] - (width - 1):]


def rg_lru(x, h0, w_a, b_a, w_x, b_x, lam):
    bsz, t_len, _ = x.shape
    xf = x.astype(jnp.float32)
    xh = xf.reshape(bsz, t_len, N_RG_HEADS, RG_HEAD_DIM)
    r = jax.nn.sigmoid(jnp.einsum('bthi,hij->bthj', xh, w_a.astype(jnp.float32)).reshape(bsz, t_len, D_RG)
                       + b_a.astype(jnp.float32))
    i = jax.nn.sigmoid(jnp.einsum('bthi,hij->bthj', xh, w_x.astype(jnp.float32)).reshape(bsz, t_len, D_RG)
                       + b_x.astype(jnp.float32))
    log_a = -RG_C * r * jax.nn.softplus(-lam.astype(jnp.float32))
    a = jnp.exp(log_a)
    bx = jnp.sqrt(-jnp.expm1(2.0 * log_a)) * (i * xf)

    def step(h, ab):
        a_t, b_t = ab
        h = a_t * h + b_t
        return h, h

    h_last, hs = lax.scan(step, h0.astype(jnp.float32), (a.swapaxes(0, 1), bx.swapaxes(0, 1)))
    return hs.swapaxes(0, 1).astype(x.dtype), h_last.astype(h0.dtype)


def hybrid_layer(x, rg_buf, rg_h, cv_buf, pre_g, w_in, rg_cw, rg_cb, rg_wa, rg_ba, rg_wx, rg_bx, rg_lam,
                 cv_cw, cv_cb, cv_lg, cv_lb, cv_w2, cv_b2, w_out, post_g):
    xn = rms_norm(x, pre_g)
    u = jnp.einsum('btd,de->bte', xn, w_in.astype(x.dtype))
    xr, gr, cv_v, cv_g, gc = jnp.split(u, [D_RG, 2 * D_RG, 2 * D_RG + D_CV, 2 * D_RG + 2 * D_CV], axis=-1)
    xr, rg_buf_new = causal_dwconv(xr, rg_buf, rg_cw, rg_cb)
    hr, rg_h_new = rg_lru(xr, rg_h, rg_wa, rg_ba, rg_wx, rg_bx, rg_lam)
    y_r = hr * jax.nn.silu(gr)
    v = cv_v * jax.nn.sigmoid(cv_g)
    v, cv_buf_new = causal_dwconv(v, cv_buf, cv_cw, cv_cb)
    v = jax.nn.silu(layer_norm(v, cv_lg, cv_lb))
    y_c = (jnp.einsum('btc,ce->bte', v, cv_w2.astype(x.dtype)) + cv_b2.astype(x.dtype)) * jax.nn.silu(gc)
    y = jnp.einsum('btm,md->btd', jnp.concatenate([y_r, y_c], axis=-1), w_out.astype(x.dtype))
    return x + rms_norm(y, post_g), rg_buf_new, rg_h_new, cv_buf_new


def setup_inputs(seed: int = 0) -> dict:
    key = jax.random.key(seed)
    ks = jax.random.split(key, 24)
    f32 = jnp.float32
    nrm = lambda k, s, sc: jax.random.normal(k, s, f32) * sc
    u = jax.random.uniform(ks[12], (DEPTH, D_RG), f32, 0.9, 0.999)
    a0 = u ** (1.0 / RG_C)
    lam = jnp.log(a0) - jnp.log1p(-a0)
    return {
        'x_prompt': nrm(ks[0], (BATCH, SEQ, D_MODEL), 1.0),
        'x_sample': nrm(ks[1], (DEC_BATCH, DEC_SEQ, D_MODEL), 1.0),
        'state_rg_h': nrm(ks[2], (DEPTH, DEC_BATCH, D_RG), 0.5),
        'state_rg_conv': nrm(ks[3], (DEPTH, DEC_BATCH, RG_CONV - 1, D_RG), 1.0),
        'state_cv_conv': nrm(ks[4], (DEPTH, DEC_BATCH, CV_CONV - 1, D_CV), 0.5),
        'meta_tokens': nrm(ks[5], (N_META, D_MODEL), 1.0),
        'pre_norm_g': 1.0 + nrm(ks[6], (DEPTH, D_MODEL), 0.02),
        'w_in': nrm(ks[7], (DEPTH, D_MODEL, D_IN), D_MODEL ** -0.5),
        'rg_conv_w': nrm(ks[8], (DEPTH, RG_CONV, D_RG), RG_CONV ** -0.5),
        'rg_conv_b': nrm(ks[9], (DEPTH, D_RG), 0.02),
        'rg_wa': nrm(ks[10], (DEPTH, N_RG_HEADS, RG_HEAD_DIM, RG_HEAD_DIM), RG_HEAD_DIM ** -0.5),
        'rg_ba': nrm(ks[11], (DEPTH, D_RG), 0.02),
        'rg_wx': nrm(ks[13], (DEPTH, N_RG_HEADS, RG_HEAD_DIM, RG_HEAD_DIM), RG_HEAD_DIM ** -0.5),
        'rg_bx': nrm(ks[14], (DEPTH, D_RG), 0.02),
        'rg_lambda': lam,
        'cv_conv_w': nrm(ks[15], (DEPTH, CV_CONV, D_CV), CV_CONV ** -0.5),
        'cv_conv_b': nrm(ks[16], (DEPTH, D_CV), 0.02),
        'cv_ln_g': 1.0 + nrm(ks[17], (DEPTH, D_CV), 0.02),
        'cv_ln_b': nrm(ks[18], (DEPTH, D_CV), 0.02),
        'cv_w_pw2': nrm(ks[19], (DEPTH, D_CV, D_CV), D_CV ** -0.5),
        'cv_b_pw2': nrm(ks[20], (DEPTH, D_CV), 0.02),
        'w_out': nrm(ks[21], (DEPTH, D_MIX, D_MODEL), D_MIX ** -0.5),
        'post_norm_g': 1.0 + nrm(ks[22], (DEPTH, D_MODEL), 0.02),
    }


def reference(x_prompt, x_sample, state_rg_h, state_rg_conv, state_cv_conv, meta_tokens, pre_norm_g, w_in,
              rg_conv_w, rg_conv_b, rg_wa, rg_ba, rg_wx, rg_bx, rg_lambda, cv_conv_w, cv_conv_b, cv_ln_g,
              cv_ln_b, cv_w_pw2, cv_b_pw2, w_out, post_norm_g):
    bsz = x_prompt.shape[0]
    dt = x_prompt.dtype
    hp = jnp.concatenate([jnp.broadcast_to(meta_tokens.astype(dt)[None], (bsz, N_META, D_MODEL)), x_prompt], axis=1)
    hs = x_sample
    p_rgh, p_rgc, p_cvc, s_rgh, s_rgc, s_cvc = [], [], [], [], [], []
    for l in range(DEPTH):
        w = (pre_norm_g[l], w_in[l], rg_conv_w[l], rg_conv_b[l], rg_wa[l], rg_ba[l], rg_wx[l], rg_bx[l],
             rg_lambda[l], cv_conv_w[l], cv_conv_b[l], cv_ln_g[l], cv_ln_b[l], cv_w_pw2[l], cv_b_pw2[l],
             w_out[l], post_norm_g[l])
        hp, rgc, rgh, cvc = hybrid_layer(
            hp, jnp.zeros((bsz, RG_CONV - 1, D_RG), dt), jnp.zeros((bsz, D_RG), dt),
            jnp.zeros((bsz, CV_CONV - 1, D_CV), dt), *w)
        p_rgh.append(rgh); p_rgc.append(rgc); p_cvc.append(cvc)
        hs, rgc, rgh, cvc = hybrid_layer(hs, state_rg_conv[l], state_rg_h[l], state_cv_conv[l], *w)
        s_rgh.append(rgh); s_rgc.append(rgc); s_cvc.append(cvc)
    y_prompt = hp[:, N_META:]
    y_sample = hs
    return (y_prompt, y_sample, jnp.stack(p_rgh), jnp.stack(p_rgc), jnp.stack(p_cvc),
            jnp.stack(s_rgh), jnp.stack(s_rgc), jnp.stack(s_cvc))
```

```cpp
#include <hip/hip_runtime.h>
#include <hip/hip_cooperative_groups.h>
#include <cstdio>
#include <cstdint>
namespace cg = cooperative_groups;
namespace pg8 {
#define PG8_LAS __attribute__((address_space(3)))
typedef unsigned short bf16_t;
typedef short bf16x8 __attribute__((ext_vector_type(8)));
typedef float f32x4 __attribute__((ext_vector_type(4)));
typedef unsigned u32x4 __attribute__((ext_vector_type(4)));
constexpr int BM = 256, BK = 64, HALF = 128, HTB = HALF * BK * 2  , STAGE_BYTES = 8 * HTB, NXCD = 8, WGM = 8;

__host__ __device__ __forceinline__ int lds_byte(int r, int c) { const int st = (r >> 4) * 2 + (c >> 5), rr = r & 15, cc = c & 31, ob = rr * 64 + cc * 2; return st * 1024 + (ob ^ (((ob >> 9) & 1) << 5)); }
__host__ __device__ __forceinline__ void stage_rc(int b, int& R, int& C) { const int st = b / 1024, sb = b % 1024, swz = sb ^ (((sb >> 9) & 1) << 5); R = (st >> 1) * 16 + swz / 64; C = (st & 1) * 32 + (swz % 64) / 2; }
__host__ __device__ __forceinline__ int perm32(int rho) { const int n = rho >> 4, i = rho & 15; return 8 * (i >> 2) + 4 * n + (i & 3); }

struct Unit { int pm, pn; };
struct Gemm { const bf16_t* A; const bf16_t* Bt; int M, N, K; };

struct StaticOrder {
    int nM, nN, nwg, G, c;
    __host__ __device__ void init(int M, int N, int G_, int c_) { nM = M / BM; nN = N / BM; nwg = nM * nN; G = G_; c = c_; }
    __host__ __device__ bool next(int i, Unit& u) const {
        const long L = (long)i * G + c; if (L >= nwg) return false;
        int wgid = (int)L; { const int q = nwg / NXCD, r = nwg % NXCD, xcd = wgid % NXCD, off = wgid / NXCD; wgid = (xcd < r ? xcd * (q + 1) : r * (q + 1) + (xcd - r) * q) + off; }
        const int nig = WGM * nN, gid = wgid / nig, fm = gid * WGM, gsz = (nM - fm) < WGM ? (nM - fm) : WGM;
        u.pm = fm + ((wgid % nig) % gsz); u.pn = (wgid % nig) / gsz; return true;
    }
    __device__ __forceinline__ void a_ready(const Unit&) const {}
    __device__ __forceinline__ void done(const Unit&) const {}
};

__device__ __forceinline__ unsigned cvt_pk_bf16(float lo, float hi) { unsigned r; asm volatile("v_cvt_pk_bf16_f32 %0, %1, %2" : "=v"(r) : "v"(lo), "v"(hi)); return r; }
template <class Epi, class Sched, bool ALIGN_EPI = false, bool SP2 = false>
__device__ __forceinline__ void gemm_phase(PG8_LAS unsigned char* lds, const Gemm g, const Sched& S, const Epi& E) {
    const int tid = threadIdx.x, wid = __builtin_amdgcn_readfirstlane(tid >> 6), lane = tid & 63, wr = wid >> 2, wc = wid & 3, fr = lane & 15, fq = lane >> 4;
    const int K = g.K, nt = K / BK;
    unsigned voffA[2], voffB[2];
#pragma unroll
    for (int i = 0; i < 2; ++i) { int R, C; stage_rc(tid * 16 + i * 8192, R, C); const int Rb = Epi::PERM ? ((R & ~31) + perm32(R & 31)) : R;
        voffA[i] = (unsigned)(R * K + C) * 2u; voffB[i] = (unsigned)(Rb * K + C) * 2u; }
    const size_t kstep = (size_t)(BK * 2);
    const size_t hstep = (size_t)HALF * K * 2;
    const size_t tstep = 2 * hstep;
    const unsigned ldsw = (unsigned)wid * 1024u;
    const int aoff = lds_byte(wr * 64 + fr, fq * 8), boff = lds_byte(wc * 32 + fr, fq * 8);
#define PG8_SA(b, h) (((b) * 2 + (h)) * HTB)
#define PG8_SB(b, h) ((4 + (b) * 2 + (h)) * HTB)
#define PG8_STAGE(bufoff, gbase, voff) do { _Pragma("unroll") for (int _i = 0; _i < 2; ++_i) \
        __builtin_amdgcn_global_load_lds((const unsigned*)((const char*)(gbase) + (voff)[_i]), (PG8_LAS unsigned*)(lds + (bufoff) + ldsw + _i * 8192), 16, 0, 0); } while (0)
#define PG8_LDA(dst, b, h) do { _Pragma("unroll") for (int m = 0; m < 4; ++m) _Pragma("unroll") for (int k = 0; k < 2; ++k) dst[m][k] = *(const PG8_LAS bf16x8*)(lds + PG8_SA(b, h) + aoff + m * 2048 + k * 1024); } while (0)
#define PG8_LDB(dst, b, h) do { _Pragma("unroll") for (int n = 0; n < 2; ++n) _Pragma("unroll") for (int k = 0; k < 2; ++k) dst[n][k] = *(const PG8_LAS bf16x8*)(lds + PG8_SB(b, h) + boff + n * 2048 + k * 1024); } while (0)
#define PG8_MMA(ai, bj, At, Bt) do { __builtin_amdgcn_s_setprio(1); _Pragma("unroll") for (int m = 0; m < 4; ++m) _Pragma("unroll") for (int n = 0; n < 2; ++n) _Pragma("unroll") for (int k = 0; k < 2; ++k) \
        acc[ai][bj][m][n] = __builtin_amdgcn_mfma_f32_16x16x32_bf16(Bt[n][k], At[m][k], acc[ai][bj][m][n], 0, 0, 0); __builtin_amdgcn_s_setprio(0); } while (0)
#define PG8_WAIT_V(n) asm volatile("s_waitcnt vmcnt(" #n ")" ::: "memory")
#define PG8_WAIT_L(n) asm volatile("s_waitcnt lgkmcnt(" #n ")" ::: "memory")
#define PG8_BAR __builtin_amdgcn_s_barrier()
#define PG8_SCHED __builtin_amdgcn_sched_barrier(0)
    Unit cur, nxt; int ui = 0;
    if (!S.next(0, cur)) return;
    f32x4 acc[2][2][4][2];
#pragma unroll
    for (int a = 0; a < 2; ++a)
#pragma unroll
        for (int b = 0; b < 2; ++b)
#pragma unroll
            for (int m = 0; m < 4; ++m)
#pragma unroll
                for (int n = 0; n < 2; ++n) acc[a][b][m][n] = (f32x4){0.f, 0.f, 0.f, 0.f};
    bf16x8 At[4][2], B0[2][2], B1[2][2];
    const char* cA = (const char*)g.A + (size_t)cur.pm * tstep; const char* cB = (const char*)g.Bt + (size_t)cur.pn * tstep;
    S.a_ready(cur);
    if constexpr (SP2) {
        PG8_STAGE(PG8_SB(0, 0), cB, voffB); PG8_STAGE(PG8_SB(0, 1), cB + hstep, voffB); PG8_STAGE(PG8_SA(0, 0), cA, voffA); PG8_STAGE(PG8_SA(0, 1), cA + hstep, voffA);
        if (wr == 1) PG8_BAR;
        PG8_WAIT_V(2); PG8_BAR;
        PG8_STAGE(PG8_SB(1, 0), cB + kstep, voffB); PG8_STAGE(PG8_SA(1, 0), cA + kstep, voffA); PG8_STAGE(PG8_SB(1, 1), cB + hstep + kstep, voffB);
        PG8_WAIT_V(6); PG8_BAR;
    } else {
        PG8_STAGE(PG8_SB(0, 0), cB, voffB); PG8_STAGE(PG8_SA(0, 0), cA, voffA); PG8_STAGE(PG8_SB(0, 1), cB + hstep, voffB); PG8_STAGE(PG8_SA(0, 1), cA + hstep, voffA);
        if (wr == 1) PG8_BAR;
        PG8_WAIT_V(4); PG8_BAR;
        PG8_STAGE(PG8_SB(1, 0), cB + kstep, voffB); PG8_STAGE(PG8_SA(1, 0), cA + kstep, voffA); PG8_STAGE(PG8_SB(1, 1), cB + hstep + kstep, voffB);
        PG8_WAIT_V(6); PG8_BAR;
    }
    for (;;) {
        const bool has_next = S.next(ui + 1, nxt);
        const char* nA = has_next ? (const char*)g.A + (size_t)nxt.pm * tstep : cA; const char* nB = has_next ? (const char*)g.Bt + (size_t)nxt.pn * tstep : cB;
        for (int t = 0; t < nt; t += 2) {
            const bool last = (t == nt - 2);
            const char* a1 = cA + (size_t)(t + 1) * kstep;
            const char* a2 = last ? nA : cA + (size_t)(t + 2) * kstep; const char* b2 = last ? nB : cB + (size_t)(t + 2) * kstep;
            const char* a3 = a2 + kstep; const char* b3 = b2 + kstep;
            if (last && has_next) S.a_ready(nxt);
            if constexpr (SP2) {
            PG8_LDB(B0, 0, 0); PG8_LDB(B1, 0, 1); PG8_SCHED; PG8_LDA(At, 0, 0); PG8_STAGE(PG8_SA(1, 1), a1 + hstep, voffA);
            PG8_WAIT_V(8); PG8_WAIT_L(0); PG8_BAR; PG8_MMA(0, 0, At, B0); PG8_MMA(0, 1, At, B1); PG8_BAR; PG8_SCHED;
            PG8_LDA(At, 0, 1); PG8_STAGE(PG8_SB(0, 0), b2, voffB); PG8_STAGE(PG8_SB(0, 1), b2 + hstep, voffB); PG8_STAGE(PG8_SA(0, 0), a2, voffA);
            PG8_WAIT_V(8); PG8_WAIT_L(0); PG8_BAR; PG8_MMA(1, 0, At, B0); PG8_MMA(1, 1, At, B1); PG8_BAR; PG8_SCHED;
            PG8_LDB(B0, 1, 0); PG8_LDB(B1, 1, 1); PG8_SCHED; PG8_LDA(At, 1, 0); PG8_STAGE(PG8_SA(0, 1), a2 + hstep, voffA);
            PG8_WAIT_V(8); PG8_WAIT_L(0); PG8_BAR; PG8_MMA(0, 0, At, B0); PG8_MMA(0, 1, At, B1); PG8_BAR; PG8_SCHED;
            PG8_LDA(At, 1, 1); PG8_STAGE(PG8_SB(1, 0), b3, voffB); PG8_STAGE(PG8_SB(1, 1), b3 + hstep, voffB); PG8_STAGE(PG8_SA(1, 0), a3, voffA);
            PG8_WAIT_V(8); PG8_WAIT_L(0); PG8_BAR; PG8_MMA(1, 0, At, B0); PG8_MMA(1, 1, At, B1); PG8_BAR; PG8_SCHED;
            } else {
            PG8_LDB(B0, 0, 0); PG8_SCHED; PG8_LDA(At, 0, 0); PG8_STAGE(PG8_SA(1, 1), a1 + hstep, voffA);
            PG8_WAIT_L(8); PG8_BAR; PG8_WAIT_L(0); PG8_MMA(0, 0, At, B0); PG8_BAR; PG8_SCHED;
            PG8_LDB(B1, 0, 1); PG8_STAGE(PG8_SB(0, 0), b2, voffB);
            PG8_BAR; PG8_WAIT_L(0); PG8_MMA(0, 1, At, B1); PG8_BAR;
            PG8_LDA(At, 0, 1); PG8_STAGE(PG8_SA(0, 0), a2, voffA);
            PG8_BAR; PG8_WAIT_L(0); PG8_MMA(1, 0, At, B0); PG8_BAR; PG8_SCHED;
            PG8_STAGE(PG8_SB(0, 1), b2 + hstep, voffB);
            PG8_WAIT_V(6); PG8_BAR; PG8_MMA(1, 1, At, B1); PG8_BAR;
            PG8_LDB(B0, 1, 0); PG8_SCHED; PG8_LDA(At, 1, 0); PG8_STAGE(PG8_SA(0, 1), a2 + hstep, voffA);
            PG8_WAIT_L(8); PG8_BAR; PG8_WAIT_L(0); PG8_MMA(0, 0, At, B0); PG8_BAR; PG8_SCHED;
            PG8_LDB(B1, 1, 1); PG8_STAGE(PG8_SB(1, 0), b3, voffB);
            PG8_BAR; PG8_WAIT_L(0); PG8_MMA(0, 1, At, B1); PG8_BAR;
            PG8_LDA(At, 1, 1); PG8_STAGE(PG8_SA(1, 0), a3, voffA);
            PG8_BAR; PG8_WAIT_L(0); PG8_MMA(1, 0, At, B0); PG8_BAR; PG8_SCHED;
            PG8_STAGE(PG8_SB(1, 1), b3 + hstep, voffB);
            PG8_WAIT_V(6); PG8_BAR; PG8_MMA(1, 1, At, B1); PG8_BAR;
            }
        }
        if constexpr (ALIGN_EPI) { if (wr == 0) PG8_BAR; }
        if constexpr (!Epi::AFTER_DRAIN) { E(acc, cur, wr, wc, fr, fq); S.done(cur); }
        if (!has_next) break;
#pragma unroll
        for (int a = 0; a < 2; ++a)
#pragma unroll
            for (int b = 0; b < 2; ++b)
#pragma unroll
                for (int m = 0; m < 4; ++m)
#pragma unroll
                    for (int n = 0; n < 2; ++n) acc[a][b][m][n] = (f32x4){0.f, 0.f, 0.f, 0.f};
        cur = nxt; cA = nA; cB = nB; ++ui;
        if constexpr (ALIGN_EPI) { if (wr == 1) PG8_BAR; }
    }
    PG8_WAIT_V(0);
    if constexpr (!ALIGN_EPI) { if (wr == 0) PG8_BAR; }
    PG8_BAR;
    if constexpr (Epi::AFTER_DRAIN) { E.fused(acc, cur, wr, wc, fr, fq, lds, wid, lane); S.done(cur); }
#undef PG8_SA
#undef PG8_SB
#undef PG8_STAGE
#undef PG8_LDA
#undef PG8_LDB
#undef PG8_MMA
#undef PG8_WAIT_V
#undef PG8_WAIT_L
#undef PG8_BAR
#undef PG8_SCHED
}
}

#ifndef PG8_SP2
#define PG8_SP2 true
#endif
#ifndef PG8_ALIGN
#define PG8_ALIGN true
#endif

constexpr int DM = 1024, NB = 16, SEQ = 2048, NMETA = 16, TP = SEQ + NMETA;
constexpr int DB = 32, DS = 32;
constexpr int MP = NB * TP, MS = DB * DS, M = MP + MS;
constexpr int DIN = 5120, DMIX = 2048;
constexpr int NSEQ = NB + DB;
constexpr float EPS = 1e-6f;
static_assert(M % 256 == 0, "M tiles");

constexpr size_t MiB = 1u << 20;
constexpr size_t ACT = (size_t)M * 1024 * 2;
constexpr size_t WS_WIN = 1 * MiB, WS_W2 = 11 * MiB, WS_WOUT = 13 * MiB;
constexpr size_t WS_XN = 20 * MiB;
constexpr size_t WS_XR = WS_XN + ACT, WS_GR = WS_XR + ACT, WS_V = WS_GR + ACT, WS_GC = WS_V + ACT, WS_YCAT = WS_GC + ACT;
constexpr size_t WS_END = WS_YCAT + 2 * ACT;
constexpr size_t WS_Y = WS_XR;

constexpr size_t O_YP = 0, O_YS = (size_t)NB * SEQ * DM, O_RGH_P = O_YS + (size_t)MS * DM, O_RGC_P = O_RGH_P + NB * 1024,
                 O_CVC_P = O_RGC_P + NB * 3 * 1024, O_RGH_S = O_CVC_P + NB * 30 * 1024, O_RGC_S = O_RGH_S + DB * 1024,
                 O_CVC_S = O_RGC_S + DB * 3 * 1024, O_END = O_CVC_S + DB * 30 * 1024;

constexpr int LDS_BYTES = 147456;

#define GAS __attribute__((address_space(1)))
#define LAS __attribute__((address_space(3)))
typedef unsigned short bf16;
typedef unsigned v4u __attribute__((ext_vector_type(4)));
typedef unsigned v2u __attribute__((ext_vector_type(2)));
typedef float f32x4 __attribute__((ext_vector_type(4)));
typedef float f32x2 __attribute__((ext_vector_type(2)));
typedef short bf16x8 __attribute__((ext_vector_type(8)));
#define LDS_WAIT() asm volatile("s_waitcnt lgkmcnt(0)" ::: "memory")

__device__ __forceinline__ unsigned pk2(float lo, float hi) { return pg8::cvt_pk_bf16(lo, hi); }
__device__ __forceinline__ float bflo(unsigned u) { return __builtin_bit_cast(float, u << 16); }
__device__ __forceinline__ float bfhi(unsigned u) { return __builtin_bit_cast(float, u & 0xffff0000u); }
__device__ __forceinline__ float fsigmoid(float x) { return __builtin_amdgcn_rcpf(1.0f + __builtin_amdgcn_exp2f(-1.4426950408889634f * x)); }
__device__ __forceinline__ float fsilu(float x) { return x * fsigmoid(x); }
__device__ __forceinline__ float wave_sum(float v) {
#pragma unroll
    for (int o = 1; o < 64; o <<= 1) v += __shfl_xor(v, o);
    return v;
}

struct Args { const float* in[23]; float* out; unsigned char* ws; int ph_lo, ph_hi; };

struct Epi1 {
    static constexpr bool PERM = true, AFTER_DRAIN = false;
    bf16 *XR, *GR, *V, *GC;
    __device__ __forceinline__ void operator()(const pg8::f32x4 (&acc)[2][2][4][2], const pg8::Unit& u, int wr, int wc, int fr, int fq) const {
        const int row0 = u.pm * 256 + wr * 64 + fr; const int pn = u.pn;
        if (pn >= 8 && pn < 16) {
            const int col0 = 128 * (pn - 8) + wc * 32 + 8 * fq;
#pragma unroll
            for (int ai = 0; ai < 2; ++ai)
#pragma unroll
                for (int m = 0; m < 4; ++m) {
                    float o[8];
#pragma unroll
                    for (int n = 0; n < 2; ++n)
#pragma unroll
                        for (int e = 0; e < 4; ++e) o[4 * n + e] = acc[ai][0][m][n][e] * fsigmoid(acc[ai][1][m][n][e]);
                    v4u w; w.x = pk2(o[0], o[1]); w.y = pk2(o[2], o[3]); w.z = pk2(o[4], o[5]); w.w = pk2(o[6], o[7]);
                    *(v4u*)(V + (size_t)(row0 + ai * 128 + m * 16) * 1024 + col0) = w;
                }
        } else {
            bf16* base; int colt; bool act;
            if (pn < 4) { base = XR; colt = pn * 256; act = false; }
            else if (pn < 8) { base = GR; colt = (pn - 4) * 256; act = true; }
            else { base = GC; colt = (pn - 16) * 256; act = true; }
            const int col0 = colt + wc * 32 + 8 * fq;
#pragma unroll
            for (int ai = 0; ai < 2; ++ai)
#pragma unroll
                for (int m = 0; m < 4; ++m) {
                    bf16* rowp = base + (size_t)(row0 + ai * 128 + m * 16) * 1024 + col0;
#pragma unroll
                    for (int bj = 0; bj < 2; ++bj) {
                        float o[8];
#pragma unroll
                        for (int n = 0; n < 2; ++n)
#pragma unroll
                            for (int e = 0; e < 4; ++e) { const float x = acc[ai][bj][m][n][e]; o[4 * n + e] = act ? fsilu(x) : x; }
                        v4u w; w.x = pk2(o[0], o[1]); w.y = pk2(o[2], o[3]); w.z = pk2(o[4], o[5]); w.w = pk2(o[6], o[7]);
                        *(v4u*)(rowp + bj * 128) = w;
                    }
                }
        }
    }
};
struct Epi2 {
    static constexpr bool PERM = true, AFTER_DRAIN = false;
    bf16* YCAT; const bf16* GC; const float* bias;
    __device__ __forceinline__ void operator()(const pg8::f32x4 (&acc)[2][2][4][2], const pg8::Unit& u, int wr, int wc, int fr, int fq) const {
        const int row0 = u.pm * 256 + wr * 64 + fr, col0 = u.pn * 256 + wc * 32 + 8 * fq;
        f32x4 bv[2][2];
#pragma unroll
        for (int bj = 0; bj < 2; ++bj)
#pragma unroll
            for (int n = 0; n < 2; ++n) bv[bj][n] = *(const f32x4*)(bias + col0 + bj * 128 + 4 * n);
#pragma unroll
        for (int ai = 0; ai < 2; ++ai)
#pragma unroll
            for (int m = 0; m < 4; ++m) {
                const size_t r = (size_t)(row0 + ai * 128 + m * 16);
#pragma unroll
                for (int bj = 0; bj < 2; ++bj) {
                    const v4u g = *(const v4u*)(GC + r * 1024 + col0 + bj * 128);
                    const f32x4 v0 = acc[ai][bj][m][0] + bv[bj][0], v1 = acc[ai][bj][m][1] + bv[bj][1];
                    v4u w; w.x = pk2(v0[0] * bflo(g.x), v0[1] * bfhi(g.x)); w.y = pk2(v0[2] * bflo(g.y), v0[3] * bfhi(g.y));
                    w.z = pk2(v1[0] * bflo(g.z), v1[1] * bfhi(g.z)); w.w = pk2(v1[2] * bflo(g.w), v1[3] * bfhi(g.w));
                    *(v4u*)(YCAT + r * 2048 + 1024 + col0 + bj * 128) = w;
                }
            }
    }
};
struct Epi3 {
    static constexpr bool PERM = false, AFTER_DRAIN = false;
    float* C;
    __device__ __forceinline__ void operator()(const pg8::f32x4 (&acc)[2][2][4][2], const pg8::Unit& u, int wr, int wc, int fr, int fq) const {
        const int row0 = u.pm * 256 + wr * 64 + fr, col0 = u.pn * 256 + wc * 32 + 4 * fq;
#pragma unroll
        for (int ai = 0; ai < 2; ++ai)
#pragma unroll
            for (int m = 0; m < 4; ++m) { float* rowp = C + (size_t)(row0 + ai * 128 + m * 16) * 1024 + col0;
#pragma unroll
                for (int bj = 0; bj < 2; ++bj)
#pragma unroll
                    for (int n = 0; n < 2; ++n) *(f32x4*)(rowp + bj * 128 + n * 16) = acc[ai][bj][m][n]; }
    }
};

__device__ __forceinline__ void p0_transpose_item(const float* W, int K, int N, bf16* WT, int k0, int n0, int dst_row0, LAS float* scr, int lane) {
#pragma unroll 8
    for (int i = 0; i < 32; ++i) { const int kk = 2 * i + (lane >> 5); scr[kk * 33 + (lane & 31)] = W[(size_t)(k0 + kk) * N + n0 + (lane & 31)]; }
    LDS_WAIT();
    const int c = lane & 7;
#pragma unroll
    for (int j = 0; j < 4; ++j) { const int n = (lane >> 3) + 8 * j; const LAS float* s = scr + (8 * c) * 33 + n;
        v4u o; o.x = pk2(s[0 * 33], s[1 * 33]); o.y = pk2(s[2 * 33], s[3 * 33]); o.z = pk2(s[4 * 33], s[5 * 33]); o.w = pk2(s[6 * 33], s[7 * 33]);
        *(v4u*)(WT + (size_t)(dst_row0 + n) * K + k0 + 8 * c) = o; }
    LDS_WAIT();
}
__device__ __forceinline__ int win_dst_row(int n) {
    if (n < 2048 || n >= 4096) return n;
    if (n < 3072) { const int c = n - 2048; return 2048 + 256 * (c >> 7) + (c & 127); }
    const int c = n - 3072; return 2048 + 256 * (c >> 7) + 128 + (c & 127);
}
__device__ __forceinline__ const float* x_row_ptr(const float* xp, const float* xs, const float* meta, int r) {
    if (r < MP) { const int b = r / TP, t = r - b * TP; return t < NMETA ? meta + (size_t)t * DM : xp + ((size_t)b * SEQ + (t - NMETA)) * DM; }
    return xs + (size_t)(r - MP) * DM;
}
__device__ __forceinline__ void p0_prologue(const Args& a, LAS unsigned char* lds, int gw, int NGW, int wave, int lane) {
    LAS float* scr = (LAS float*)(lds + wave * 16384);
    constexpr int I_IN = 16 * 160, I_W2 = 16 * 32, I_WO = 32 * 32;
    bf16* WinT = (bf16*)(a.ws + WS_WIN); bf16* W2T = (bf16*)(a.ws + WS_W2); bf16* WoT = (bf16*)(a.ws + WS_WOUT);
    for (int it = gw; it < I_IN + I_W2 + I_WO; it += NGW) {
        int r = it;
        if (r < I_IN) { const int kb = r / 160, nb = r % 160; p0_transpose_item(a.in[7], 1024, DIN, WinT, 64 * kb, 32 * nb, win_dst_row(32 * nb), scr, lane); continue; } r -= I_IN;
        if (r < I_W2) { const int kb = r / 32, nb = r % 32; p0_transpose_item(a.in[19], 1024, 1024, W2T, 64 * kb, 32 * nb, 32 * nb, scr, lane); continue; } r -= I_W2;
        { const int kb = r / 32, nb = r % 32; p0_transpose_item(a.in[21], 2048, 1024, WoT, 64 * kb, 32 * nb, 32 * nb, scr, lane); }
    }
    bf16* XN = (bf16*)(a.ws + WS_XN);
    const f32x4* gp = (const f32x4*)a.in[6] + lane;
    f32x4 g[4];
#pragma unroll
    for (int j = 0; j < 4; ++j) g[j] = gp[64 * j];
    for (int r = gw; r < M; r += NGW) {
        const f32x4* xr = (const f32x4*)x_row_ptr(a.in[0], a.in[1], a.in[5], r) + lane;
        f32x4 v[4]; float s = 0.f;
#pragma unroll
        for (int j = 0; j < 4; ++j) { v[j] = xr[64 * j]; s += (v[j].x * v[j].x + v[j].y * v[j].y) + (v[j].z * v[j].z + v[j].w * v[j].w); }
        const float rstd = 1.0f / sqrtf(wave_sum(s) * (1.f / DM) + EPS);
        v2u* o8 = (v2u*)(XN + (size_t)r * DM) + lane;
#pragma unroll
        for (int j = 0; j < 4; ++j) { v2u o; o.x = pk2(v[j].x * rstd * g[j].x, v[j].y * rstd * g[j].y); o.y = pk2(v[j].z * rstd * g[j].z, v[j].w * rstd * g[j].w); o8[64 * j] = o; }
    }
}

constexpr int RG_XS = 0, RG_GS = 18944, RG_XC = 37376, RG_YS = 72192, RG_TOT = 90624, RG_CW = 98816, RG_BF = 100096;
constexpr int XS_STRIDE = 144, XC_STRIDE = 68;

__device__ __forceinline__ void rg_prefetch(v4u (&px)[3], v4u (&pg)[2], const bf16* XR, const bf16* GR, const float* rgbuf, int row0, int T, int h, int c0, int tid) {
#pragma unroll
    for (int j = 0; j < 3; ++j) {
        const int idx = tid + 512 * j, row = idx >> 3, seg = idx & 7, t = c0 - 3 + row;
        v4u v = (v4u){0u, 0u, 0u, 0u};
        if (row < 131) {
            if (t >= 0 && t < T) v = *(const v4u*)(XR + (size_t)(row0 + t) * 1024 + h * 64 + seg * 8);
            else if (t < 0 && rgbuf) { const f32x4* p = (const f32x4*)(rgbuf + (3 + t) * 1024 + h * 64 + seg * 8); const f32x4 a = p[0], b = p[1];
                v.x = pk2(a.x, a.y); v.y = pk2(a.z, a.w); v.z = pk2(b.x, b.y); v.w = pk2(b.z, b.w); }
        }
        px[j] = v;
    }
#pragma unroll
    for (int j = 0; j < 2; ++j) {
        const int idx = tid + 512 * j, row = idx >> 3, seg = idx & 7, t = c0 + row;
        v4u v = (v4u){0u, 0u, 0u, 0u};
        if (t < T) v = *(const v4u*)(GR + (size_t)(row0 + t) * 1024 + h * 64 + seg * 8);
        pg[j] = v;
    }
}

__device__ __forceinline__ void rg_item(const Args& a, LAS unsigned char* lds, int s, int h) {
    const int tid = threadIdx.x, lane = tid & 63, w = __builtin_amdgcn_readfirstlane(tid >> 6), fr = lane & 15, fq = lane >> 4;
    const bf16* XR = (const bf16*)(a.ws + WS_XR); const bf16* GR = (const bf16*)(a.ws + WS_GR); bf16* YCAT = (bf16*)(a.ws + WS_YCAT);
    int row0, T; const float* h0 = nullptr; const float* rgbuf = nullptr; float* hout;
    if (s < NB) { row0 = s * TP; T = TP; hout = a.out + O_RGH_P + (size_t)s * 1024; }
    else { const int q = s - NB; row0 = MP + q * DS; T = DS; h0 = a.in[2] + (size_t)q * 1024; rgbuf = a.in[3] + (size_t)q * 3 * 1024; hout = a.out + O_RGH_S + (size_t)q * 1024; }
    const int nch = (T + 127) >> 7;
    LAS float* cwl = (LAS float*)(lds + RG_CW);
    if (tid < 320) { const int k = tid >> 6, c = tid & 63; cwl[tid] = (k < 4) ? a.in[8][k * 1024 + h * 64 + c] : a.in[9][h * 64 + c]; }
    {
        const int mat = tid >> 8, i4 = tid & 255, k = i4 >> 2, nt = i4 & 3, ks = k >> 5, fqk = (k & 31) >> 3, e = k & 7;
        const float* wsrc = (mat ? a.in[12] : a.in[10]) + (size_t)h * 4096 + k * 64 + nt * 16;
        LAS unsigned short* dst = (LAS unsigned short*)(lds + RG_BF + ((mat * 8 + nt * 2 + ks) * 64 + fqk * 16) * 16 + e * 2);
#pragma unroll
        for (int q = 0; q < 4; ++q) { const f32x4 v = ((const f32x4*)wsrc)[q];
            dst[(4 * q + 0) * 8] = (unsigned short)(pk2(v.x, 0.f) & 0xffffu); dst[(4 * q + 1) * 8] = (unsigned short)(pk2(v.y, 0.f) & 0xffffu);
            dst[(4 * q + 2) * 8] = (unsigned short)(pk2(v.z, 0.f) & 0xffffu); dst[(4 * q + 3) * 8] = (unsigned short)(pk2(v.w, 0.f) & 0xffffu); }
    }
    float ba_[4], bx_[4], nsp[4], hc[4];
#pragma unroll
    for (int nt = 0; nt < 4; ++nt) { const int c = h * 64 + 16 * nt + fr; ba_[nt] = a.in[11][c]; bx_[nt] = a.in[13][c];
        const float x = -a.in[14][c]; const float sp = fmaxf(x, 0.f) + log1pf(expf(-fabsf(x)));
        nsp[nt] = -8.0f * sp * 1.4426950408889634f; hc[nt] = h0 ? h0[c] : 0.f; }

    v4u px[3], pg[2];
    rg_prefetch(px, pg, XR, GR, rgbuf, row0, T, h, 0, tid);
    LAS float* xcw = (LAS float*)(lds + RG_XC + w * (16 * XC_STRIDE * 4));
    LAS unsigned char* ysw = lds + RG_YS + w * (16 * XS_STRIDE);
    for (int ch = 0; ch < nch; ++ch) {
        const int c0 = ch * 128, par = ch & 1;
#pragma unroll
        for (int j = 0; j < 3; ++j) { const int idx = tid + 512 * j, row = idx >> 3, seg = idx & 7; if (row < 131) *(LAS v4u*)(lds + RG_XS + row * XS_STRIDE + seg * 16) = px[j]; }
#pragma unroll
        for (int j = 0; j < 2; ++j) { const int idx = tid + 512 * j, row = idx >> 3, seg = idx & 7; *(LAS v4u*)(lds + RG_GS + row * XS_STRIDE + seg * 16) = pg[j]; }
        __syncthreads();
        if (ch + 1 < nch) rg_prefetch(px, pg, XR, GR, rgbuf, row0, T, h, c0 + 128, tid);
        bf16x8 Af[2];
#pragma unroll
        for (int ks = 0; ks < 2; ++ks) {
            const int cb = 32 * ks + 8 * fq;
            f32x4 lo = *(const LAS f32x4*)(cwl + 256 + cb), hi = *(const LAS f32x4*)(cwl + 256 + cb + 4);
#pragma unroll
            for (int k = 0; k < 4; ++k) {
                const v4u xv = *(const LAS v4u*)(lds + RG_XS + (16 * w + fr + k) * XS_STRIDE + cb * 2);
                const f32x4 wl = *(const LAS f32x4*)(cwl + 64 * k + cb), wh = *(const LAS f32x4*)(cwl + 64 * k + cb + 4);
                lo.x += wl.x * bflo(xv.x); lo.y += wl.y * bfhi(xv.x); lo.z += wl.z * bflo(xv.y); lo.w += wl.w * bfhi(xv.y);
                hi.x += wh.x * bflo(xv.z); hi.y += wh.y * bfhi(xv.z); hi.z += wh.z * bflo(xv.w); hi.w += wh.w * bfhi(xv.w);
            }
            v4u u; u.x = pk2(lo.x, lo.y); u.y = pk2(lo.z, lo.w); u.z = pk2(hi.x, hi.y); u.w = pk2(hi.z, hi.w);
            Af[ks] = __builtin_bit_cast(bf16x8, u);
            *(LAS f32x4*)(xcw + fr * XC_STRIDE + cb) = lo; *(LAS f32x4*)(xcw + fr * XC_STRIDE + cb + 4) = hi;
        }
        f32x4 accA[4], accX[4];
#pragma unroll
        for (int nt = 0; nt < 4; ++nt) { accA[nt] = (f32x4){0.f, 0.f, 0.f, 0.f}; accX[nt] = (f32x4){0.f, 0.f, 0.f, 0.f};
#pragma unroll
            for (int ks = 0; ks < 2; ++ks) { const bf16x8 Ba = *(const LAS bf16x8*)(lds + RG_BF + ((nt * 2 + ks) * 64 + lane) * 16), Bx = *(const LAS bf16x8*)(lds + RG_BF + ((8 + nt * 2 + ks) * 64 + lane) * 16);
                                             accA[nt] = __builtin_amdgcn_mfma_f32_16x16x32_bf16(Af[ks], Ba, accA[nt], 0, 0, 0);
                                             accX[nt] = __builtin_amdgcn_mfma_f32_16x16x32_bf16(Af[ks], Bx, accX[nt], 0, 0, 0); } }
        LDS_WAIT();
        float hl[4][4], pl[4][4], sg[4][4], PE[4], HE[4];
#pragma unroll
        for (int nt = 0; nt < 4; ++nt) {
            float P = 1.f, H = 0.f;
#pragma unroll
            for (int j = 0; j < 4; ++j) {
                const int row = 4 * fq + j, cc = 16 * nt + fr;
                const float xc = xcw[row * XC_STRIDE + cc];
                const unsigned short gsv = *(const LAS unsigned short*)(lds + RG_GS + (16 * w + row) * XS_STRIDE + cc * 2);
                sg[nt][j] = __builtin_bit_cast(float, (unsigned)gsv << 16);
                const float r = fsigmoid(accA[nt][j] + ba_[nt]), ig = fsigmoid(accX[nt][j] + bx_[nt]);
                float av = __builtin_amdgcn_exp2f(r * nsp[nt]);
                float bv = __builtin_amdgcn_sqrtf(fmaxf(fmaf(-av, av, 1.0f), 0.f)) * (ig * xc);
                if (c0 + 16 * w + row >= T) { av = 1.f; bv = 0.f; }
                H = fmaf(av, H, bv); P *= av; hl[nt][j] = H; pl[nt][j] = P;
            }
            float Pi = P, Hi = H;
            { const float tp = __shfl_up(Pi, 16), th = __shfl_up(Hi, 16); if (fq >= 1) { Hi = fmaf(Pi, th, Hi); Pi *= tp; } }
            { const float tp = __shfl_up(Pi, 32), th = __shfl_up(Hi, 32); if (fq >= 2) { Hi = fmaf(Pi, th, Hi); Pi *= tp; } }
            { const float tp = __shfl_up(Pi, 16), th = __shfl_up(Hi, 16); PE[nt] = fq >= 1 ? tp : 1.f; HE[nt] = fq >= 1 ? th : 0.f; }
            if (fq == 3) *(LAS f32x2*)(lds + RG_TOT + ((par * 8 + w) * 64 + 16 * nt + fr) * 8) = (f32x2){Pi, Hi};
        }
        __syncthreads();
#pragma unroll
        for (int nt = 0; nt < 4; ++nt) {
            float run = hc[nt], cin = 0.f;
#pragma unroll
            for (int ww = 0; ww < 8; ++ww) { const f32x2 t = *(const LAS f32x2*)(lds + RG_TOT + ((par * 8 + ww) * 64 + 16 * nt + fr) * 8);
                if (ww == w) cin = run; run = fmaf(t.x, run, t.y); }
            hc[nt] = run;
            const float G = fmaf(PE[nt], cin, HE[nt]);
#pragma unroll
            for (int j = 0; j < 4; ++j) { const float hv = fmaf(pl[nt][j], G, hl[nt][j]); const float y = hv * sg[nt][j];
                *(LAS unsigned short*)(ysw + (4 * fq + j) * XS_STRIDE + (16 * nt + fr) * 2) = (unsigned short)(pk2(y, 0.f) & 0xffffu); }
        }
        LDS_WAIT();
        { const int row = lane >> 2, q = lane & 3, t = c0 + 16 * w + row;
          const v4u y0 = *(const LAS v4u*)(ysw + row * XS_STRIDE + q * 32), y1 = *(const LAS v4u*)(ysw + row * XS_STRIDE + q * 32 + 16);
          if (t < T) { bf16* dst = YCAT + (size_t)(row0 + t) * 2048 + h * 64 + q * 16; *(v4u*)dst = y0; *(v4u*)(dst + 8) = y1; } }
    }
    if (w == 0 && fq == 0) {
#pragma unroll
        for (int nt = 0; nt < 4; ++nt) hout[h * 64 + 16 * nt + fr] = hc[nt];
    }
    __syncthreads();
}

__device__ __forceinline__ void cv_item(const Args& a, LAS unsigned char* lds, int s, int t0, const f32x2 (&cw)[31], f32x2 cb) {
    const int tid = threadIdx.x, lane = tid & 63, w = __builtin_amdgcn_readfirstlane(tid >> 6);
    const bf16* V = (const bf16*)(a.ws + WS_V); bf16* VN = (bf16*)(a.ws + WS_XN);
    int row0; const float* cvbuf = nullptr;
    if (s < NB) row0 = s * TP; else { const int q = s - NB; row0 = MP + q * DS; cvbuf = a.in[4] + (size_t)q * 30 * 1024; }
    unsigned vin[46];
#pragma unroll
    for (int i = 0; i < 46; ++i) {
        const int j = t0 + i;
        if (j < 30) { if (cvbuf) { const f32x2 f = *(const f32x2*)(cvbuf + j * 1024 + 2 * tid); vin[i] = pk2(f.x, f.y); } else vin[i] = 0u; }
        else vin[i] = *(const unsigned*)(V + (size_t)(row0 + j - 30) * 1024 + 2 * tid);
    }
    f32x2 o[16];
#pragma unroll
    for (int k = 0; k < 16; ++k) o[k] = cb;
#pragma unroll
    for (int i = 0; i < 46; ++i) {
        const f32x2 x = (f32x2){bflo(vin[i]), bfhi(vin[i])};
#pragma unroll
        for (int k = 0; k < 16; ++k) { const int tap = i - k; if (tap >= 0 && tap <= 30) o[k] = cw[tap] * x + o[k]; }
    }
    LAS float* cbuf = (LAS float*)lds;
#pragma unroll
    for (int k = 0; k < 16; ++k) *(LAS f32x2*)(cbuf + k * 1024 + 2 * tid) = o[k];
    __syncthreads();
#pragma unroll
    for (int rr = 0; rr < 2; ++rr) {
        const int row = 2 * w + rr;
        f32x4 v[4]; float sum = 0.f;
#pragma unroll
        for (int j = 0; j < 4; ++j) { v[j] = *(const LAS f32x4*)(cbuf + row * 1024 + 4 * lane + 256 * j); sum += (v[j].x + v[j].y) + (v[j].z + v[j].w); }
        const float mean = wave_sum(sum) * (1.f / 1024.f); float q = 0.f;
#pragma unroll
        for (int j = 0; j < 4; ++j) { v[j] = v[j] - mean; q += (v[j].x * v[j].x + v[j].y * v[j].y) + (v[j].z * v[j].z + v[j].w * v[j].w); }
        const float rstd = 1.0f / sqrtf(wave_sum(q) * (1.f / 1024.f) + EPS);
        v2u* dst = (v2u*)(VN + (size_t)(row0 + t0 + row) * 1024) + lane;
#pragma unroll
        for (int j = 0; j < 4; ++j) {
            const f32x4 g = *((const f32x4*)a.in[17] + lane + 64 * j), b = *((const f32x4*)a.in[18] + lane + 64 * j);
            const f32x4 y = v[j] * rstd * g + b;
            v2u ov; ov.x = pk2(fsilu(y.x), fsilu(y.y)); ov.y = pk2(fsilu(y.z), fsilu(y.w)); dst[64 * j] = ov;
        }
    }
    __syncthreads();
}

__global__ void __launch_bounds__(512, 2) hymba_fwd(Args args) {
    extern __shared__ __attribute__((aligned(16))) unsigned char lds_raw[];
    cg::grid_group grid = cg::this_grid();
    LAS unsigned char* lds = (LAS unsigned char*)lds_raw;
    const int tid = threadIdx.x, lane = tid & 63, wave = __builtin_amdgcn_readfirstlane(tid >> 6);
    const int G = gridDim.x, bx = blockIdx.x;
    const int vcu = (G % 8 == 0) ? (bx % 8) * (G / 8) + bx / 8 : bx;
    const int gw = vcu * 8 + wave, NGW = G * 8;
    const int lo = args.ph_lo, hi = args.ph_hi;
#define IN(k) (lo <= (k) && (k) < hi)
#define BOTH(k) (IN(k) && IN((k) + 1))
    unsigned char* ws = args.ws;

    if (IN(0)) { p0_prologue(args, lds, gw, NGW, wave, lane); if (BOTH(0)) grid.sync(); }

    if (IN(1)) {
        pg8::Gemm g{(const bf16*)(ws + WS_XN), (const bf16*)(ws + WS_WIN), M, DIN, 1024}; pg8::StaticOrder S; S.init(M, DIN, G, bx);
        Epi1 E{(bf16*)(ws + WS_XR), (bf16*)(ws + WS_GR), (bf16*)(ws + WS_V), (bf16*)(ws + WS_GC)};
        pg8::gemm_phase<Epi1, pg8::StaticOrder, PG8_ALIGN, PG8_SP2>(lds, g, S, E);
        if (BOTH(1)) grid.sync();
    }

    if (IN(2)) {
        __syncthreads();
        for (int it = bx; it < NB * 16; it += G) rg_item(args, lds, it >> 4, it & 15);
        {
            f32x2 cw[31];
#pragma unroll
            for (int k = 0; k < 31; ++k) cw[k] = *(const f32x2*)(args.in[15] + k * 1024 + 2 * tid);
            const f32x2 cb = *(const f32x2*)(args.in[16] + 2 * tid);
            constexpr int NCV_P = NB * (TP / 16), NCV = NCV_P + DB * (DS / 16);
            for (int it = bx; it < NCV; it += G) {
                int s, t0;
                if (it < NCV_P) { s = it / (TP / 16); t0 = (it - s * (TP / 16)) * 16; } else { const int r = it - NCV_P; s = NB + (r >> 1); t0 = (r & 1) * 16; }
                cv_item(args, lds, s, t0, cw, cb);
            }
        }
        for (int it = bx; it < DB * 16; it += G) rg_item(args, lds, NB + (it >> 4), it & 15);
        {
            const bf16* XR = (const bf16*)(ws + WS_XR); const bf16* V = (const bf16*)(ws + WS_V);
            const int gt = vcu * 512 + tid, NGT = G * 512;
            for (int i = gt; i < NSEQ * 33 * 512; i += NGT) {
                const int c2 = i & 511, rr = (i >> 9) % 33, s = (i >> 9) / 33;
                int row0, T; float* o3; float* o30;
                if (s < NB) { row0 = s * TP; T = TP; o3 = args.out + O_RGC_P + (size_t)s * 3 * 1024; o30 = args.out + O_CVC_P + (size_t)s * 30 * 1024; }
                else { const int q = s - NB; row0 = MP + q * DS; T = DS; o3 = args.out + O_RGC_S + (size_t)q * 3 * 1024; o30 = args.out + O_CVC_S + (size_t)q * 30 * 1024; }
                if (rr < 3) { const unsigned u = *(const unsigned*)(XR + (size_t)(row0 + T - 3 + rr) * 1024 + 2 * c2); *(f32x2*)(o3 + rr * 1024 + 2 * c2) = (f32x2){bflo(u), bfhi(u)}; }
                else { const int r2 = rr - 3; const unsigned u = *(const unsigned*)(V + (size_t)(row0 + T - 30 + r2) * 1024 + 2 * c2); *(f32x2*)(o30 + r2 * 1024 + 2 * c2) = (f32x2){bflo(u), bfhi(u)}; }
            }
        }
        if (BOTH(2)) grid.sync();
    }

    if (IN(3)) {
        pg8::Gemm g{(const bf16*)(ws + WS_XN), (const bf16*)(ws + WS_W2), M, 1024, 1024}; pg8::StaticOrder S; S.init(M, 1024, G, bx);
        Epi2 E{(bf16*)(ws + WS_YCAT), (const bf16*)(ws + WS_GC), args.in[20]};
        pg8::gemm_phase<Epi2, pg8::StaticOrder, PG8_ALIGN, PG8_SP2>(lds, g, S, E);
        if (BOTH(3)) grid.sync();
    }

    if (IN(4)) {
        pg8::Gemm g{(const bf16*)(ws + WS_YCAT), (const bf16*)(ws + WS_WOUT), M, 1024, 2048}; pg8::StaticOrder S; S.init(M, 1024, G, bx);
        Epi3 E{(float*)(ws + WS_Y)};
        pg8::gemm_phase<Epi3, pg8::StaticOrder, PG8_ALIGN, PG8_SP2>(lds, g, S, E);
        if (BOTH(4)) grid.sync();
    }

    if (IN(5)) {
        const float* Y = (const float*)(ws + WS_Y);
        const f32x4* gp = (const f32x4*)args.in[22] + lane;
        f32x4 g[4];
#pragma unroll
        for (int j = 0; j < 4; ++j) g[j] = gp[64 * j];
        for (int r = gw; r < M; r += NGW) {
            const float* xrow; float* orow;
            if (r < MP) { const int b = r / TP, t = r - b * TP; if (t < NMETA) continue; const size_t o = ((size_t)b * SEQ + (t - NMETA)) * DM; xrow = args.in[0] + o; orow = args.out + O_YP + o; }
            else { const size_t o = (size_t)(r - MP) * DM; xrow = args.in[1] + o; orow = args.out + O_YS + o; }
            const f32x4* yr = (const f32x4*)(Y + (size_t)r * DM) + lane;
            f32x4 v[4]; float s = 0.f;
#pragma unroll
            for (int j = 0; j < 4; ++j) { v[j] = yr[64 * j]; s += (v[j].x * v[j].x + v[j].y * v[j].y) + (v[j].z * v[j].z + v[j].w * v[j].w); }
            const float rstd = 1.0f / sqrtf(wave_sum(s) * (1.f / DM) + EPS);
#pragma unroll
            for (int j = 0; j < 4; ++j) { const f32x4 xv = ((const f32x4*)xrow)[lane + 64 * j]; ((f32x4*)orow)[lane + 64 * j] = xv + v[j] * rstd * g[j]; }
        }
    }
#undef IN
#undef BOTH
}

extern "C" void kernel_launch(void* const* d_in, const int* in_sizes, int n_in, void* d_out, int out_size, void* d_ws, size_t ws_size, hipStream_t stream) {
    static int grid = 0;
    if (grid == 0) {
        if (n_in != 23 || out_size != (int)O_END || ws_size < WS_END) { fprintf(stderr, "kernel_launch: unexpected problem (n_in %d, out %d, ws %zu; need ws >= %zu)\n", n_in, out_size, ws_size, (size_t)WS_END); grid = -1; return; }
        int dev = 0, cus = 0, per_cu = 0;
        if (hipGetDevice(&dev) != hipSuccess || hipDeviceGetAttribute(&cus, hipDeviceAttributeMultiprocessorCount, dev) != hipSuccess) { grid = -1; return; }
        if (hipFuncSetAttribute((const void*)hymba_fwd, hipFuncAttributeMaxDynamicSharedMemorySize, LDS_BYTES) != hipSuccess) { fprintf(stderr, "kernel_launch: hipFuncSetAttribute failed\n"); grid = -1; return; }
        if (hipOccupancyMaxActiveBlocksPerMultiprocessor(&per_cu, (const void*)hymba_fwd, 512, LDS_BYTES) != hipSuccess || per_cu < 1) { fprintf(stderr, "kernel_launch: occupancy query says %d\n", per_cu); per_cu = 1; }
        (void)hipGetLastError();
        grid = cus;
    }
    if (grid < 0) return;
    Args a{};
    for (int i = 0; i < 23; ++i) a.in[i] = (const float*)d_in[i];
    a.out = (float*)d_out; a.ws = (unsigned char*)d_ws; a.ph_lo = 0; a.ph_hi = 6;
    void* kargs[] = {&a};
    hipError_t e = hipLaunchCooperativeKernel((const void*)hymba_fwd, dim3(grid), dim3(512), kargs, LDS_BYTES, stream);
    if (e != hipSuccess) fprintf(stderr, "kernel_launch: cooperative launch failed: %s (grid %d)\n", hipGetErrorString(e), grid);
}
```

```cpp
#include <hip/hip_runtime.h>
#include <hip/hip_cooperative_groups.h>
#include <cstdio>
#include <cstdint>
namespace cg = cooperative_groups;
namespace pg8 {
#define PG8_LAS __attribute__((address_space(3)))
typedef unsigned short bf16_t;
typedef short bf16x8 __attribute__((ext_vector_type(8)));
typedef float f32x4 __attribute__((ext_vector_type(4)));
typedef unsigned u32x4 __attribute__((ext_vector_type(4)));
constexpr int BM = 256, BK = 64, HALF = 128, HTB = HALF * BK * 2  , STAGE_BYTES = 8 * HTB, NXCD = 8, WGM = 8;

__host__ __device__ __forceinline__ int lds_byte(int r, int c) { const int st = (r >> 4) * 2 + (c >> 5), rr = r & 15, cc = c & 31, ob = rr * 64 + cc * 2; return st * 1024 + (ob ^ (((ob >> 9) & 1) << 5)); }
__host__ __device__ __forceinline__ void stage_rc(int b, int& R, int& C) { const int st = b / 1024, sb = b % 1024, swz = sb ^ (((sb >> 9) & 1) << 5); R = (st >> 1) * 16 + swz / 64; C = (st & 1) * 32 + (swz % 64) / 2; }
__host__ __device__ __forceinline__ int perm32(int rho) { const int n = rho >> 4, i = rho & 15; return 8 * (i >> 2) + 4 * n + (i & 3); }

struct Unit { int pm, pn; };
struct Gemm { const bf16_t* A; const bf16_t* Bt; int M, N, K; };

struct StaticOrder {
    int nM, nN, nwg, G, c;
    __host__ __device__ void init(int M, int N, int G_, int c_) { nM = M / BM; nN = N / BM; nwg = nM * nN; G = G_; c = c_; }
    __host__ __device__ bool next(int i, Unit& u) const {
        const long L = (long)i * G + c; if (L >= nwg) return false;
        int wgid = (int)L; { const int q = nwg / NXCD, r = nwg % NXCD, xcd = wgid % NXCD, off = wgid / NXCD; wgid = (xcd < r ? xcd * (q + 1) : r * (q + 1) + (xcd - r) * q) + off; }
        const int nig = WGM * nN, gid = wgid / nig, fm = gid * WGM, gsz = (nM - fm) < WGM ? (nM - fm) : WGM;
        u.pm = fm + ((wgid % nig) % gsz); u.pn = (wgid % nig) / gsz; return true;
    }
    __device__ __forceinline__ void a_ready(const Unit&) const {}
    __device__ __forceinline__ void done(const Unit&) const {}
};

__device__ __forceinline__ unsigned cvt_pk_bf16(float lo, float hi) { unsigned r; asm volatile("v_cvt_pk_bf16_f32 %0, %1, %2" : "=v"(r) : "v"(lo), "v"(hi)); return r; }
template <class Epi, class Sched, bool ALIGN_EPI = false, bool SP2 = false>
__device__ __forceinline__ void gemm_phase(PG8_LAS unsigned char* lds, const Gemm g, const Sched& S, const Epi& E) {
    const int tid = threadIdx.x, wid = __builtin_amdgcn_readfirstlane(tid >> 6), lane = tid & 63, wr = wid >> 2, wc = wid & 3, fr = lane & 15, fq = lane >> 4;
    const int K = g.K, nt = K / BK;
    unsigned voffA[2], voffB[2];
#pragma unroll
    for (int i = 0; i < 2; ++i) { int R, C; stage_rc(tid * 16 + i * 8192, R, C); const int Rb = Epi::PERM ? ((R & ~31) + perm32(R & 31)) : R;
        voffA[i] = (unsigned)(R * K + C) * 2u; voffB[i] = (unsigned)(Rb * K + C) * 2u; }
    const size_t kstep = (size_t)(BK * 2);
    const size_t hstep = (size_t)HALF * K * 2;
    const size_t tstep = 2 * hstep;
    const unsigned ldsw = (unsigned)wid * 1024u;
    const int aoff = lds_byte(wr * 64 + fr, fq * 8), boff = lds_byte(wc * 32 + fr, fq * 8);
#define PG8_SA(b, h) (((b) * 2 + (h)) * HTB)
#define PG8_SB(b, h) ((4 + (b) * 2 + (h)) * HTB)
#define PG8_STAGE(bufoff, gbase, voff) do { _Pragma("unroll") for (int _i = 0; _i < 2; ++_i) \
        __builtin_amdgcn_global_load_lds((const unsigned*)((const char*)(gbase) + (voff)[_i]), (PG8_LAS unsigned*)(lds + (bufoff) + ldsw + _i * 8192), 16, 0, 0); } while (0)
#define PG8_LDA(dst, b, h) do { _Pragma("unroll") for (int m = 0; m < 4; ++m) _Pragma("unroll") for (int k = 0; k < 2; ++k) dst[m][k] = *(const PG8_LAS bf16x8*)(lds + PG8_SA(b, h) + aoff + m * 2048 + k * 1024); } while (0)
#define PG8_LDB(dst, b, h) do { _Pragma("unroll") for (int n = 0; n < 2; ++n) _Pragma("unroll") for (int k = 0; k < 2; ++k) dst[n][k] = *(const PG8_LAS bf16x8*)(lds + PG8_SB(b, h) + boff + n * 2048 + k * 1024); } while (0)
#define PG8_MMA(ai, bj, At, Bt) do { __builtin_amdgcn_s_setprio(1); _Pragma("unroll") for (int m = 0; m < 4; ++m) _Pragma("unroll") for (int n = 0; n < 2; ++n) _Pragma("unroll") for (int k = 0; k < 2; ++k) \
        acc[ai][bj][m][n] = __builtin_amdgcn_mfma_f32_16x16x32_bf16(Bt[n][k], At[m][k], acc[ai][bj][m][n], 0, 0, 0); __builtin_amdgcn_s_setprio(0); } while (0)
#define PG8_WAIT_V(n) asm volatile("s_waitcnt vmcnt(" #n ")" ::: "memory")
#define PG8_WAIT_L(n) asm volatile("s_waitcnt lgkmcnt(" #n ")" ::: "memory")
#define PG8_BAR __builtin_amdgcn_s_barrier()
#define PG8_SCHED __builtin_amdgcn_sched_barrier(0)
    Unit cur, nxt; int ui = 0;
    if (!S.next(0, cur)) return;
    f32x4 acc[2][2][4][2];
#pragma unroll
    for (int a = 0; a < 2; ++a)
#pragma unroll
        for (int b = 0; b < 2; ++b)
#pragma unroll
            for (int m = 0; m < 4; ++m)
#pragma unroll
                for (int n = 0; n < 2; ++n) acc[a][b][m][n] = (f32x4){0.f, 0.f, 0.f, 0.f};
    bf16x8 At[4][2], B0[2][2], B1[2][2];
    const char* cA = (const char*)g.A + (size_t)cur.pm * tstep; const char* cB = (const char*)g.Bt + (size_t)cur.pn * tstep;
    S.a_ready(cur);
    if constexpr (SP2) {
        PG8_STAGE(PG8_SB(0, 0), cB, voffB); PG8_STAGE(PG8_SB(0, 1), cB + hstep, voffB); PG8_STAGE(PG8_SA(0, 0), cA, voffA); PG8_STAGE(PG8_SA(0, 1), cA + hstep, voffA);
        if (wr == 1) PG8_BAR;
        PG8_WAIT_V(2); PG8_BAR;
        PG8_STAGE(PG8_SB(1, 0), cB + kstep, voffB); PG8_STAGE(PG8_SA(1, 0), cA + kstep, voffA); PG8_STAGE(PG8_SB(1, 1), cB + hstep + kstep, voffB);
        PG8_WAIT_V(6); PG8_BAR;
    } else {
        PG8_STAGE(PG8_SB(0, 0), cB, voffB); PG8_STAGE(PG8_SA(0, 0), cA, voffA); PG8_STAGE(PG8_SB(0, 1), cB + hstep, voffB); PG8_STAGE(PG8_SA(0, 1), cA + hstep, voffA);
        if (wr == 1) PG8_BAR;
        PG8_WAIT_V(4); PG8_BAR;
        PG8_STAGE(PG8_SB(1, 0), cB + kstep, voffB); PG8_STAGE(PG8_SA(1, 0), cA + kstep, voffA); PG8_STAGE(PG8_SB(1, 1), cB + hstep + kstep, voffB);
        PG8_WAIT_V(6); PG8_BAR;
    }
    for (;;) {
        const bool has_next = S.next(ui + 1, nxt);
        const char* nA = has_next ? (const char*)g.A + (size_t)nxt.pm * tstep : cA; const char* nB = has_next ? (const char*)g.Bt + (size_t)nxt.pn * tstep : cB;
        for (int t = 0; t < nt; t += 2) {
            const bool last = (t == nt - 2);
            const char* a1 = cA + (size_t)(t + 1) * kstep;
            const char* a2 = last ? nA : cA + (size_t)(t + 2) * kstep; const char* b2 = last ? nB : cB + (size_t)(t + 2) * kstep;
            const char* a3 = a2 + kstep; const char* b3 = b2 + kstep;
            if (last && has_next) S.a_ready(nxt);
            if constexpr (SP2) {
            PG8_LDB(B0, 0, 0); PG8_LDB(B1, 0, 1); PG8_SCHED; PG8_LDA(At, 0, 0); PG8_STAGE(PG8_SA(1, 1), a1 + hstep, voffA);
            PG8_WAIT_V(8); PG8_WAIT_L(0); PG8_BAR; PG8_MMA(0, 0, At, B0); PG8_MMA(0, 1, At, B1); PG8_BAR; PG8_SCHED;
            PG8_LDA(At, 0, 1); PG8_STAGE(PG8_SB(0, 0), b2, voffB); PG8_STAGE(PG8_SB(0, 1), b2 + hstep, voffB); PG8_STAGE(PG8_SA(0, 0), a2, voffA);
            PG8_WAIT_V(8); PG8_WAIT_L(0); PG8_BAR; PG8_MMA(1, 0, At, B0); PG8_MMA(1, 1, At, B1); PG8_BAR; PG8_SCHED;
            PG8_LDB(B0, 1, 0); PG8_LDB(B1, 1, 1); PG8_SCHED; PG8_LDA(At, 1, 0); PG8_STAGE(PG8_SA(0, 1), a2 + hstep, voffA);
            PG8_WAIT_V(8); PG8_WAIT_L(0); PG8_BAR; PG8_MMA(0, 0, At, B0); PG8_MMA(0, 1, At, B1); PG8_BAR; PG8_SCHED;
            PG8_LDA(At, 1, 1); PG8_STAGE(PG8_SB(1, 0), b3, voffB); PG8_STAGE(PG8_SB(1, 1), b3 + hstep, voffB); PG8_STAGE(PG8_SA(1, 0), a3, voffA);
            PG8_WAIT_V(8); PG8_WAIT_L(0); PG8_BAR; PG8_MMA(1, 0, At, B0); PG8_MMA(1, 1, At, B1); PG8_BAR; PG8_SCHED;
            } else {
            PG8_LDB(B0, 0, 0); PG8_SCHED; PG8_LDA(At, 0, 0); PG8_STAGE(PG8_SA(1, 1), a1 + hstep, voffA);
            PG8_WAIT_L(8); PG8_BAR; PG8_WAIT_L(0); PG8_MMA(0, 0, At, B0); PG8_BAR; PG8_SCHED;
            PG8_LDB(B1, 0, 1); PG8_STAGE(PG8_SB(0, 0), b2, voffB);
            PG8_BAR; PG8_WAIT_L(0); PG8_MMA(0, 1, At, B1); PG8_BAR;
            PG8_LDA(At, 0, 1); PG8_STAGE(PG8_SA(0, 0), a2, voffA);
            PG8_BAR; PG8_WAIT_L(0); PG8_MMA(1, 0, At, B0); PG8_BAR; PG8_SCHED;
            PG8_STAGE(PG8_SB(0, 1), b2 + hstep, voffB);
            PG8_WAIT_V(6); PG8_BAR; PG8_MMA(1, 1, At, B1); PG8_BAR;
            PG8_LDB(B0, 1, 0); PG8_SCHED; PG8_LDA(At, 1, 0); PG8_STAGE(PG8_SA(0, 1), a2 + hstep, voffA);
            PG8_WAIT_L(8); PG8_BAR; PG8_WAIT_L(0); PG8_MMA(0, 0, At, B0); PG8_BAR; PG8_SCHED;
            PG8_LDB(B1, 1, 1); PG8_STAGE(PG8_SB(1, 0), b3, voffB);
            PG8_BAR; PG8_WAIT_L(0); PG8_MMA(0, 1, At, B1); PG8_BAR;
            PG8_LDA(At, 1, 1); PG8_STAGE(PG8_SA(1, 0), a3, voffA);
            PG8_BAR; PG8_WAIT_L(0); PG8_MMA(1, 0, At, B0); PG8_BAR; PG8_SCHED;
            PG8_STAGE(PG8_SB(1, 1), b3 + hstep, voffB);
            PG8_WAIT_V(6); PG8_BAR; PG8_MMA(1, 1, At, B1); PG8_BAR;
            }
        }
        if constexpr (ALIGN_EPI) { if (wr == 0) PG8_BAR; }
        if constexpr (!Epi::AFTER_DRAIN) { E(acc, cur, wr, wc, fr, fq); S.done(cur); }
        if (!has_next) break;
#pragma unroll
        for (int a = 0; a < 2; ++a)
#pragma unroll
            for (int b = 0; b < 2; ++b)
#pragma unroll
                for (int m = 0; m < 4; ++m)
#pragma unroll
                    for (int n = 0; n < 2; ++n) acc[a][b][m][n] = (f32x4){0.f, 0.f, 0.f, 0.f};
        cur = nxt; cA = nA; cB = nB; ++ui;
        if constexpr (ALIGN_EPI) { if (wr == 1) PG8_BAR; }
    }
    PG8_WAIT_V(0);
    if constexpr (!ALIGN_EPI) { if (wr == 0) PG8_BAR; }
    PG8_BAR;
    if constexpr (Epi::AFTER_DRAIN) { E.fused(acc, cur, wr, wc, fr, fq, lds, wid, lane); S.done(cur); }
#undef PG8_SA
#undef PG8_SB
#undef PG8_STAGE
#undef PG8_LDA
#undef PG8_LDB
#undef PG8_MMA
#undef PG8_WAIT_V
#undef PG8_WAIT_L
#undef PG8_BAR
#undef PG8_SCHED
}
}

#ifndef PG8_SP2
#define PG8_SP2 true
#endif
#ifndef PG8_ALIGN
#define PG8_ALIGN true
#endif

constexpr int DM = 1024, NB = 16, SEQ = 2048, NMETA = 16, TP = SEQ + NMETA;
constexpr int DB = 32, DS = 32;
constexpr int MP = NB * TP, MS = DB * DS, M = MP + MS;
constexpr int DIN = 5120, DMIX = 2048;
constexpr int NSEQ = NB + DB;
constexpr float EPS = 1e-6f;
static_assert(M % 256 == 0, "M tiles");

constexpr size_t MiB = 1u << 20;
constexpr size_t ACT = (size_t)M * 1024 * 2;
constexpr size_t WS_WIN = 1 * MiB, WS_W2 = 11 * MiB, WS_WOUT = 13 * MiB;
constexpr size_t WS_XN = 20 * MiB;
constexpr size_t WS_XR = WS_XN + ACT, WS_GR = WS_XR + ACT, WS_V = WS_GR + ACT, WS_GC = WS_V + ACT, WS_YCAT = WS_GC + ACT;
constexpr size_t WS_END = WS_YCAT + 2 * ACT;
constexpr size_t WS_Y = WS_XR;

constexpr size_t O_YP = 0, O_YS = (size_t)NB * SEQ * DM, O_RGH_P = O_YS + (size_t)MS * DM, O_RGC_P = O_RGH_P + NB * 1024,
                 O_CVC_P = O_RGC_P + NB * 3 * 1024, O_RGH_S = O_CVC_P + NB * 30 * 1024, O_RGC_S = O_RGH_S + DB * 1024,
                 O_CVC_S = O_RGC_S + DB * 3 * 1024, O_END = O_CVC_S + DB * 30 * 1024;

constexpr int LDS_BYTES = 147456;

#define GAS __attribute__((address_space(1)))
#define LAS __attribute__((address_space(3)))
typedef unsigned short bf16;
typedef unsigned v4u __attribute__((ext_vector_type(4)));
typedef unsigned v2u __attribute__((ext_vector_type(2)));
typedef float f32x4 __attribute__((ext_vector_type(4)));
typedef float f32x2 __attribute__((ext_vector_type(2)));
typedef short bf16x8 __attribute__((ext_vector_type(8)));
#define LDS_WAIT() asm volatile("s_waitcnt lgkmcnt(0)" ::: "memory")

__device__ __forceinline__ unsigned pk2(float lo, float hi) { return pg8::cvt_pk_bf16(lo, hi); }
__device__ __forceinline__ float bflo(unsigned u) { return __builtin_bit_cast(float, u << 16); }
__device__ __forceinline__ float bfhi(unsigned u) { return __builtin_bit_cast(float, u & 0xffff0000u); }
__device__ __forceinline__ float fsigmoid(float x) { return __builtin_amdgcn_rcpf(1.0f + __builtin_amdgcn_exp2f(-1.4426950408889634f * x)); }
__device__ __forceinline__ float fsilu(float x) { return x * fsigmoid(x); }
__device__ __forceinline__ float wave_sum(float v) {
#pragma unroll
    for (int o = 1; o < 64; o <<= 1) v += __shfl_xor(v, o);
    return v;
}

struct Args { const float* in[23]; float* out; unsigned char* ws; int ph_lo, ph_hi; };

struct Epi1 {
    static constexpr bool PERM = true, AFTER_DRAIN = false;
    bf16 *XR, *GR, *V, *GC;
    __device__ __forceinline__ void operator()(const pg8::f32x4 (&acc)[2][2][4][2], const pg8::Unit& u, int wr, int wc, int fr, int fq) const {
        const int row0 = u.pm * 256 + wr * 64 + fr; const int pn = u.pn;
        if (pn >= 8 && pn < 16) {
            const int col0 = 128 * (pn - 8) + wc * 32 + 8 * fq;
#pragma unroll
            for (int ai = 0; ai < 2; ++ai)
#pragma unroll
                for (int m = 0; m < 4; ++m) {
                    float o[8];
#pragma unroll
                    for (int n = 0; n < 2; ++n)
#pragma unroll
                        for (int e = 0; e < 4; ++e) o[4 * n + e] = acc[ai][0][m][n][e] * fsigmoid(acc[ai][1][m][n][e]);
                    v4u w; w.x = pk2(o[0], o[1]); w.y = pk2(o[2], o[3]); w.z = pk2(o[4], o[5]); w.w = pk2(o[6], o[7]);
                    *(v4u*)(V + (size_t)(row0 + ai * 128 + m * 16) * 1024 + col0) = w;
                }
        } else {
            bf16* base; int colt; bool act;
            if (pn < 4) { base = XR; colt = pn * 256; act = false; }
            else if (pn < 8) { base = GR; colt = (pn - 4) * 256; act = true; }
            else { base = GC; colt = (pn - 16) * 256; act = true; }
            const int col0 = colt + wc * 32 + 8 * fq;
#pragma unroll
            for (int ai = 0; ai < 2; ++ai)
#pragma unroll
                for (int m = 0; m < 4; ++m) {
                    bf16* rowp = base + (size_t)(row0 + ai * 128 + m * 16) * 1024 + col0;
#pragma unroll
                    for (int bj = 0; bj < 2; ++bj) {
                        float o[8];
#pragma unroll
                        for (int n = 0; n < 2; ++n)
#pragma unroll
                            for (int e = 0; e < 4; ++e) { const float x = acc[ai][bj][m][n][e]; o[4 * n + e] = act ? fsilu(x) : x; }
                        v4u w; w.x = pk2(o[0], o[1]); w.y = pk2(o[2], o[3]); w.z = pk2(o[4], o[5]); w.w = pk2(o[6], o[7]);
                        *(v4u*)(rowp + bj * 128) = w;
                    }
                }
        }
    }
};
struct Epi2 {
    static constexpr bool PERM = true, AFTER_DRAIN = false;
    bf16* YCAT; const bf16* GC; const float* bias;
    __device__ __forceinline__ void operator()(const pg8::f32x4 (&acc)[2][2][4][2], const pg8::Unit& u, int wr, int wc, int fr, int fq) const {
        const int row0 = u.pm * 256 + wr * 64 + fr, col0 = u.pn * 256 + wc * 32 + 8 * fq;
        f32x4 bv[2][2];
#pragma unroll
        for (int bj = 0; bj < 2; ++bj)
#pragma unroll
            for (int n = 0; n < 2; ++n) bv[bj][n] = *(const f32x4*)(bias + col0 + bj * 128 + 4 * n);
#pragma unroll
        for (int ai = 0; ai < 2; ++ai)
#pragma unroll
            for (int m = 0; m < 4; ++m) {
                const size_t r = (size_t)(row0 + ai * 128 + m * 16);
#pragma unroll
                for (int bj = 0; bj < 2; ++bj) {
                    const v4u g = *(const v4u*)(GC + r * 1024 + col0 + bj * 128);
                    const f32x4 v0 = acc[ai][bj][m][0] + bv[bj][0], v1 = acc[ai][bj][m][1] + bv[bj][1];
                    v4u w; w.x = pk2(v0[0] * bflo(g.x), v0[1] * bfhi(g.x)); w.y = pk2(v0[2] * bflo(g.y), v0[3] * bfhi(g.y));
                    w.z = pk2(v1[0] * bflo(g.z), v1[1] * bfhi(g.z)); w.w = pk2(v1[2] * bflo(g.w), v1[3] * bfhi(g.w));
                    *(v4u*)(YCAT + r * 2048 + 1024 + col0 + bj * 128) = w;
                }
            }
    }
};
struct Epi3 {
    static constexpr bool PERM = false, AFTER_DRAIN = false;
    float* C;
    __device__ __forceinline__ void operator()(const pg8::f32x4 (&acc)[2][2][4][2], const pg8::Unit& u, int wr, int wc, int fr, int fq) const {
        const int row0 = u.pm * 256 + wr * 64 + fr, col0 = u.pn * 256 + wc * 32 + 4 * fq;
#pragma unroll
        for (int ai = 0; ai < 2; ++ai)
#pragma unroll
            for (int m = 0; m < 4; ++m) { float* rowp = C + (size_t)(row0 + ai * 128 + m * 16) * 1024 + col0;
#pragma unroll
                for (int bj = 0; bj < 2; ++bj)
#pragma unroll
                    for (int n = 0; n < 2; ++n) *(f32x4*)(rowp + bj * 128 + n * 16) = acc[ai][bj][m][n]; }
    }
};

constexpr size_t CTL_CNT = 0, CTL_SLOTS = 65536;
struct OrderP4 {
    int nwg, G, c;
    __device__ void init(int M_, int G_, int c_) { nwg = (M_ / 256) * 4; G = G_; c = c_; }
    __device__ bool next(int i, pg8::Unit& u) const { const int L = i * G + c; if (L >= nwg) return false; u.pm = L >> 2; u.pn = L & 3; return true; }
    __device__ __forceinline__ void a_ready(const pg8::Unit&) const {}
    __device__ __forceinline__ void done(const pg8::Unit&) const {}
};
struct EpiFinal {
    static constexpr bool PERM = false, AFTER_DRAIN = false;
    const float* xp; const float* xs; float* out; const float* g; float* slots; unsigned* cnt; LAS float* scr;
    __device__ __forceinline__ void operator()(const pg8::f32x4 (&acc)[2][2][4][2], const pg8::Unit& u, int wr, int wc, int fr, int fq) const {
        const int tid = threadIdx.x, lane = tid & 63, wid = __builtin_amdgcn_readfirstlane(tid >> 6);
        LAS float* P = scr; LAS float* S = scr + 1024;
#pragma unroll
        for (int ai = 0; ai < 2; ++ai)
#pragma unroll
            for (int m = 0; m < 4; ++m) {
                float s = 0.f;
#pragma unroll
                for (int bj = 0; bj < 2; ++bj)
#pragma unroll
                    for (int n = 0; n < 2; ++n) { const pg8::f32x4 x = acc[ai][bj][m][n]; s += (x[0] * x[0] + x[1] * x[1]) + (x[2] * x[2] + x[3] * x[3]); }
                s += __shfl_xor(s, 16); s += __shfl_xor(s, 32);
                if (fq == 0) P[(ai * 128 + wr * 64 + m * 16 + fr) * 4 + wc] = s;
            }
        asm volatile("s_waitcnt lgkmcnt(0)" ::: "memory"); __builtin_amdgcn_s_barrier(); asm volatile("" ::: "memory");
        if (tid < 256) { const f32x4 p = *(const LAS f32x4*)(P + tid * 4);
            __hip_atomic_store(slots + ((size_t)(u.pm * 256 + tid) * 4 + u.pn), (p.x + p.y) + (p.z + p.w), __ATOMIC_RELAXED, __HIP_MEMORY_SCOPE_AGENT); }
        asm volatile("s_waitcnt vmcnt(0)" ::: "memory");
        if (wid < 4 && lane == 0) __hip_atomic_fetch_add(cnt + 64 * u.pm, 1u, __ATOMIC_RELAXED, __HIP_MEMORY_SCOPE_AGENT);
        if (wid == 0) {
            unsigned spins = 0;
            while ((unsigned)__builtin_amdgcn_readfirstlane(__hip_atomic_load(cnt + 64 * u.pm, __ATOMIC_RELAXED, __HIP_MEMORY_SCOPE_AGENT)) < 16u) { __builtin_amdgcn_s_sleep(2); if (++spins > (1u << 22)) break; }
            __builtin_amdgcn_fence(__ATOMIC_ACQUIRE, "agent");
        }
        asm volatile("s_waitcnt vmcnt(0) lgkmcnt(0)" ::: "memory"); __builtin_amdgcn_s_barrier(); asm volatile("" ::: "memory");
        if (tid < 256) { const float* sl = slots + (size_t)(u.pm * 256 + tid) * 4; float t = 0.f;
#pragma unroll
            for (int q = 0; q < 4; ++q) t += __hip_atomic_load(sl + q, __ATOMIC_RELAXED, __HIP_MEMORY_SCOPE_AGENT);
            S[tid] = 1.0f / sqrtf(t * (1.f / 1024.f) + EPS); }
        asm volatile("s_waitcnt lgkmcnt(0)" ::: "memory"); __builtin_amdgcn_s_barrier(); asm volatile("" ::: "memory");
        const int col0 = u.pn * 256 + wc * 32 + 4 * fq;
        f32x4 gv[2][2];
#pragma unroll
        for (int bj = 0; bj < 2; ++bj)
#pragma unroll
            for (int n = 0; n < 2; ++n) gv[bj][n] = *(const f32x4*)(g + col0 + bj * 128 + n * 16);
#pragma unroll
        for (int ai = 0; ai < 2; ++ai)
#pragma unroll
            for (int m = 0; m < 4; ++m) {
                const int rl = ai * 128 + wr * 64 + m * 16 + fr, r = u.pm * 256 + rl; const float rs = S[rl];
                const float* xrow; float* orow; bool ok = true;
                if (r < MP) { const int b = r / TP, t = r - b * TP; ok = t >= NMETA; const size_t o = ((size_t)b * SEQ + (ok ? t - NMETA : 0)) * DM; xrow = xp + o; orow = out + O_YP + o; }
                else { const size_t o = (size_t)(r - MP) * DM; xrow = xs + o; orow = out + O_YS + o; }
                if (ok) {
#pragma unroll
                    for (int bj = 0; bj < 2; ++bj)
#pragma unroll
                        for (int n = 0; n < 2; ++n) { const f32x4 xv = *(const f32x4*)(xrow + col0 + bj * 128 + n * 16);
                            *(f32x4*)(orow + col0 + bj * 128 + n * 16) = xv + acc[ai][bj][m][n] * rs * gv[bj][n]; }
                }
                asm volatile("" ::: "memory");
            }
    }
};

__device__ __forceinline__ void p0_transpose_item(const float* W, int K, int N, bf16* WT, int k0, int n0, int dst_row0, LAS float* scr, int lane) {
#pragma unroll 8
    for (int i = 0; i < 32; ++i) { const int kk = 2 * i + (lane >> 5); scr[kk * 33 + (lane & 31)] = W[(size_t)(k0 + kk) * N + n0 + (lane & 31)]; }
    LDS_WAIT();
    const int c = lane & 7;
#pragma unroll
    for (int j = 0; j < 4; ++j) { const int n = (lane >> 3) + 8 * j; const LAS float* s = scr + (8 * c) * 33 + n;
        v4u o; o.x = pk2(s[0 * 33], s[1 * 33]); o.y = pk2(s[2 * 33], s[3 * 33]); o.z = pk2(s[4 * 33], s[5 * 33]); o.w = pk2(s[6 * 33], s[7 * 33]);
        *(v4u*)(WT + (size_t)(dst_row0 + n) * K + k0 + 8 * c) = o; }
    LDS_WAIT();
}
__device__ __forceinline__ int win_dst_row(int n) {
    if (n < 2048 || n >= 4096) return n;
    if (n < 3072) { const int c = n - 2048; return 2048 + 256 * (c >> 7) + (c & 127); }
    const int c = n - 3072; return 2048 + 256 * (c >> 7) + 128 + (c & 127);
}
__device__ __forceinline__ const float* x_row_ptr(const float* xp, const float* xs, const float* meta, int r) {
    if (r < MP) { const int b = r / TP, t = r - b * TP; return t < NMETA ? meta + (size_t)t * DM : xp + ((size_t)b * SEQ + (t - NMETA)) * DM; }
    return xs + (size_t)(r - MP) * DM;
}
__device__ __forceinline__ void p0_prologue(const Args& a, LAS unsigned char* lds, int gw, int NGW, int wave, int lane) {
    LAS float* scr = (LAS float*)(lds + wave * 16384);
    constexpr int I_IN = 16 * 160, I_W2 = 16 * 32, I_WO = 32 * 32;
    bf16* WinT = (bf16*)(a.ws + WS_WIN); bf16* W2T = (bf16*)(a.ws + WS_W2); bf16* WoT = (bf16*)(a.ws + WS_WOUT);
    for (int it = gw; it < I_IN + I_W2 + I_WO; it += NGW) {
        int r = it;
        if (r < I_IN) { const int kb = r / 160, nb = r % 160; p0_transpose_item(a.in[7], 1024, DIN, WinT, 64 * kb, 32 * nb, win_dst_row(32 * nb), scr, lane); continue; } r -= I_IN;
        if (r < I_W2) { const int kb = r / 32, nb = r % 32; p0_transpose_item(a.in[19], 1024, 1024, W2T, 64 * kb, 32 * nb, 32 * nb, scr, lane); continue; } r -= I_W2;
        { const int kb = r / 32, nb = r % 32; p0_transpose_item(a.in[21], 2048, 1024, WoT, 64 * kb, 32 * nb, 32 * nb, scr, lane); }
    }
    if (gw < 133) { if (lane == 0) *((unsigned*)(a.ws + CTL_CNT) + 64 * gw) = 0u; }
    bf16* XN = (bf16*)(a.ws + WS_XN);
    const f32x4* gp = (const f32x4*)a.in[6] + lane;
    f32x4 g[4];
#pragma unroll
    for (int j = 0; j < 4; ++j) g[j] = gp[64 * j];
    for (int r = gw; r < M; r += NGW) {
        const f32x4* xr = (const f32x4*)x_row_ptr(a.in[0], a.in[1], a.in[5], r) + lane;
        f32x4 v[4]; float s = 0.f;
#pragma unroll
        for (int j = 0; j < 4; ++j) { v[j] = xr[64 * j]; s += (v[j].x * v[j].x + v[j].y * v[j].y) + (v[j].z * v[j].z + v[j].w * v[j].w); }
        const float rstd = 1.0f / sqrtf(wave_sum(s) * (1.f / DM) + EPS);
        v2u* o8 = (v2u*)(XN + (size_t)r * DM) + lane;
#pragma unroll
        for (int j = 0; j < 4; ++j) { v2u o; o.x = pk2(v[j].x * rstd * g[j].x, v[j].y * rstd * g[j].y); o.y = pk2(v[j].z * rstd * g[j].z, v[j].w * rstd * g[j].w); o8[64 * j] = o; }
    }
}

constexpr int RG_XS = 0, RG_GS = 18944, RG_XC = 37376, RG_YS = 72192, RG_TOT = 90624, RG_CW = 98816, RG_BF = 100096;
constexpr int XS_STRIDE = 144, XC_STRIDE = 68;

__device__ __forceinline__ void rg_prefetch(v4u (&px)[3], v4u (&pg)[2], const bf16* XR, const bf16* GR, const float* rgbuf, int row0, int T, int h, int c0, int tid) {
#pragma unroll
    for (int j = 0; j < 3; ++j) {
        const int idx = tid + 512 * j, row = idx >> 3, seg = idx & 7, t = c0 - 3 + row;
        v4u v = (v4u){0u, 0u, 0u, 0u};
        if (row < 131) {
            if (t >= 0 && t < T) v = *(const v4u*)(XR + (size_t)(row0 + t) * 1024 + h * 64 + seg * 8);
            else if (t < 0 && rgbuf) { const f32x4* p = (const f32x4*)(rgbuf + (3 + t) * 1024 + h * 64 + seg * 8); const f32x4 a = p[0], b = p[1];
                v.x = pk2(a.x, a.y); v.y = pk2(a.z, a.w); v.z = pk2(b.x, b.y); v.w = pk2(b.z, b.w); }
        }
        px[j] = v;
    }
#pragma unroll
    for (int j = 0; j < 2; ++j) {
        const int idx = tid + 512 * j, row = idx >> 3, seg = idx & 7, t = c0 + row;
        v4u v = (v4u){0u, 0u, 0u, 0u};
        if (t < T) v = *(const v4u*)(GR + (size_t)(row0 + t) * 1024 + h * 64 + seg * 8);
        pg[j] = v;
    }
}

__device__ __forceinline__ void rg_item(const Args& a, LAS unsigned char* lds, int s, int h) {
    const int tid = threadIdx.x, lane = tid & 63, w = __builtin_amdgcn_readfirstlane(tid >> 6), fr = lane & 15, fq = lane >> 4;
    const bf16* XR = (const bf16*)(a.ws + WS_XR); const bf16* GR = (const bf16*)(a.ws + WS_GR); bf16* YCAT = (bf16*)(a.ws + WS_YCAT);
    int row0, T; const float* h0 = nullptr; const float* rgbuf = nullptr; float* hout;
    if (s < NB) { row0 = s * TP; T = TP; hout = a.out + O_RGH_P + (size_t)s * 1024; }
    else { const int q = s - NB; row0 = MP + q * DS; T = DS; h0 = a.in[2] + (size_t)q * 1024; rgbuf = a.in[3] + (size_t)q * 3 * 1024; hout = a.out + O_RGH_S + (size_t)q * 1024; }
    const int nch = (T + 127) >> 7;
    LAS float* cwl = (LAS float*)(lds + RG_CW);
    if (tid < 320) { const int k = tid >> 6, c = tid & 63; cwl[tid] = (k < 4) ? a.in[8][k * 1024 + h * 64 + c] : a.in[9][h * 64 + c]; }
    {
        const int mat = tid >> 8, i4 = tid & 255, k = i4 >> 2, nt = i4 & 3, ks = k >> 5, fqk = (k & 31) >> 3, e = k & 7;
        const float* wsrc = (mat ? a.in[12] : a.in[10]) + (size_t)h * 4096 + k * 64 + nt * 16;
        LAS unsigned short* dst = (LAS unsigned short*)(lds + RG_BF + ((mat * 8 + nt * 2 + ks) * 64 + fqk * 16) * 16 + e * 2);
#pragma unroll
        for (int q = 0; q < 4; ++q) { const f32x4 v = ((const f32x4*)wsrc)[q];
            dst[(4 * q + 0) * 8] = (unsigned short)(pk2(v.x, 0.f) & 0xffffu); dst[(4 * q + 1) * 8] = (unsigned short)(pk2(v.y, 0.f) & 0xffffu);
            dst[(4 * q + 2) * 8] = (unsigned short)(pk2(v.z, 0.f) & 0xffffu); dst[(4 * q + 3) * 8] = (unsigned short)(pk2(v.w, 0.f) & 0xffffu); }
    }
    float ba_[4], bx_[4], nsp[4], hc[4];
#pragma unroll
    for (int nt = 0; nt < 4; ++nt) { const int c = h * 64 + 16 * nt + fr; ba_[nt] = a.in[11][c]; bx_[nt] = a.in[13][c];
        const float x = -a.in[14][c]; const float sp = fmaxf(x, 0.f) + log1pf(expf(-fabsf(x)));
        nsp[nt] = -8.0f * sp * 1.4426950408889634f; hc[nt] = h0 ? h0[c] : 0.f; }

    v4u px[3], pg[2];
    rg_prefetch(px, pg, XR, GR, rgbuf, row0, T, h, 0, tid);
    LAS float* xcw = (LAS float*)(lds + RG_XC + w * (16 * XC_STRIDE * 4));
    LAS unsigned char* ysw = lds + RG_YS + w * (16 * XS_STRIDE);
    for (int ch = 0; ch < nch; ++ch) {
        const int c0 = ch * 128, par = ch & 1;
#pragma unroll
        for (int j = 0; j < 3; ++j) { const int idx = tid + 512 * j, row = idx >> 3, seg = idx & 7; if (row < 131) *(LAS v4u*)(lds + RG_XS + row * XS_STRIDE + seg * 16) = px[j]; }
#pragma unroll
        for (int j = 0; j < 2; ++j) { const int idx = tid + 512 * j, row = idx >> 3, seg = idx & 7; *(LAS v4u*)(lds + RG_GS + row * XS_STRIDE + seg * 16) = pg[j]; }
        __syncthreads();
        if (ch + 1 < nch) rg_prefetch(px, pg, XR, GR, rgbuf, row0, T, h, c0 + 128, tid);
        bf16x8 Af[2];
#pragma unroll
        for (int ks = 0; ks < 2; ++ks) {
            const int cb = 32 * ks + 8 * fq;
            f32x4 lo = *(const LAS f32x4*)(cwl + 256 + cb), hi = *(const LAS f32x4*)(cwl + 256 + cb + 4);
#pragma unroll
            for (int k = 0; k < 4; ++k) {
                const v4u xv = *(const LAS v4u*)(lds + RG_XS + (16 * w + fr + k) * XS_STRIDE + cb * 2);
                const f32x4 wl = *(const LAS f32x4*)(cwl + 64 * k + cb), wh = *(const LAS f32x4*)(cwl + 64 * k + cb + 4);
                lo.x += wl.x * bflo(xv.x); lo.y += wl.y * bfhi(xv.x); lo.z += wl.z * bflo(xv.y); lo.w += wl.w * bfhi(xv.y);
                hi.x += wh.x * bflo(xv.z); hi.y += wh.y * bfhi(xv.z); hi.z += wh.z * bflo(xv.w); hi.w += wh.w * bfhi(xv.w);
            }
            v4u u; u.x = pk2(lo.x, lo.y); u.y = pk2(lo.z, lo.w); u.z = pk2(hi.x, hi.y); u.w = pk2(hi.z, hi.w);
            Af[ks] = __builtin_bit_cast(bf16x8, u);
            *(LAS f32x4*)(xcw + fr * XC_STRIDE + cb) = lo; *(LAS f32x4*)(xcw + fr * XC_STRIDE + cb + 4) = hi;
        }
        f32x4 accA[4], accX[4];
#pragma unroll
        for (int nt = 0; nt < 4; ++nt) { accA[nt] = (f32x4){0.f, 0.f, 0.f, 0.f}; accX[nt] = (f32x4){0.f, 0.f, 0.f, 0.f};
#pragma unroll
            for (int ks = 0; ks < 2; ++ks) { const bf16x8 Ba = *(const LAS bf16x8*)(lds + RG_BF + ((nt * 2 + ks) * 64 + lane) * 16), Bx = *(const LAS bf16x8*)(lds + RG_BF + ((8 + nt * 2 + ks) * 64 + lane) * 16);
                                             accA[nt] = __builtin_amdgcn_mfma_f32_16x16x32_bf16(Af[ks], Ba, accA[nt], 0, 0, 0);
                                             accX[nt] = __builtin_amdgcn_mfma_f32_16x16x32_bf16(Af[ks], Bx, accX[nt], 0, 0, 0); } }
        LDS_WAIT();
        float hl[4][4], pl[4][4], sg[4][4], PE[4], HE[4];
#pragma unroll
        for (int nt = 0; nt < 4; ++nt) {
            float P = 1.f, H = 0.f;
#pragma unroll
            for (int j = 0; j < 4; ++j) {
                const int row = 4 * fq + j, cc = 16 * nt + fr;
                const float xc = xcw[row * XC_STRIDE + cc];
                const unsigned short gsv = *(const LAS unsigned short*)(lds + RG_GS + (16 * w + row) * XS_STRIDE + cc * 2);
                sg[nt][j] = __builtin_bit_cast(float, (unsigned)gsv << 16);
                const float r = fsigmoid(accA[nt][j] + ba_[nt]), ig = fsigmoid(accX[nt][j] + bx_[nt]);
                float av = __builtin_amdgcn_exp2f(r * nsp[nt]);
                float bv = __builtin_amdgcn_sqrtf(fmaxf(fmaf(-av, av, 1.0f), 0.f)) * (ig * xc);
                if (c0 + 16 * w + row >= T) { av = 1.f; bv = 0.f; }
                H = fmaf(av, H, bv); P *= av; hl[nt][j] = H; pl[nt][j] = P;
            }
            float Pi = P, Hi = H;
            { const float tp = __shfl_up(Pi, 16), th = __shfl_up(Hi, 16); if (fq >= 1) { Hi = fmaf(Pi, th, Hi); Pi *= tp; } }
            { const float tp = __shfl_up(Pi, 32), th = __shfl_up(Hi, 32); if (fq >= 2) { Hi = fmaf(Pi, th, Hi); Pi *= tp; } }
            { const float tp = __shfl_up(Pi, 16), th = __shfl_up(Hi, 16); PE[nt] = fq >= 1 ? tp : 1.f; HE[nt] = fq >= 1 ? th : 0.f; }
            if (fq == 3) *(LAS f32x2*)(lds + RG_TOT + ((par * 8 + w) * 64 + 16 * nt + fr) * 8) = (f32x2){Pi, Hi};
        }
        __syncthreads();
#pragma unroll
        for (int nt = 0; nt < 4; ++nt) {
            float run = hc[nt], cin = 0.f;
#pragma unroll
            for (int ww = 0; ww < 8; ++ww) { const f32x2 t = *(const LAS f32x2*)(lds + RG_TOT + ((par * 8 + ww) * 64 + 16 * nt + fr) * 8);
                if (ww == w) cin = run; run = fmaf(t.x, run, t.y); }
            hc[nt] = run;
            const float G = fmaf(PE[nt], cin, HE[nt]);
#pragma unroll
            for (int j = 0; j < 4; ++j) { const float hv = fmaf(pl[nt][j], G, hl[nt][j]); const float y = hv * sg[nt][j];
                *(LAS unsigned short*)(ysw + (4 * fq + j) * XS_STRIDE + (16 * nt + fr) * 2) = (unsigned short)(pk2(y, 0.f) & 0xffffu); }
        }
        LDS_WAIT();
        { const int row = lane >> 2, q = lane & 3, t = c0 + 16 * w + row;
          const v4u y0 = *(const LAS v4u*)(ysw + row * XS_STRIDE + q * 32), y1 = *(const LAS v4u*)(ysw + row * XS_STRIDE + q * 32 + 16);
          if (t < T) { bf16* dst = YCAT + (size_t)(row0 + t) * 2048 + h * 64 + q * 16; *(v4u*)dst = y0; *(v4u*)(dst + 8) = y1; } }
    }
    if (w == 0 && fq == 0) {
#pragma unroll
        for (int nt = 0; nt < 4; ++nt) hout[h * 64 + 16 * nt + fr] = hc[nt];
    }
    __syncthreads();
}

__device__ __forceinline__ void cv_item(const Args& a, LAS unsigned char* lds, int s, int t0, const f32x2 (&cw)[31], f32x2 cb) {
    const int tid = threadIdx.x, lane = tid & 63, w = __builtin_amdgcn_readfirstlane(tid >> 6);
    const bf16* V = (const bf16*)(a.ws + WS_V); bf16* VN = (bf16*)(a.ws + WS_XN);
    int row0; const float* cvbuf = nullptr;
    if (s < NB) row0 = s * TP; else { const int q = s - NB; row0 = MP + q * DS; cvbuf = a.in[4] + (size_t)q * 30 * 1024; }
    unsigned vin[46];
#pragma unroll
    for (int i = 0; i < 46; ++i) {
        const int j = t0 + i;
        if (j < 30) { if (cvbuf) { const f32x2 f = *(const f32x2*)(cvbuf + j * 1024 + 2 * tid); vin[i] = pk2(f.x, f.y); } else vin[i] = 0u; }
        else vin[i] = *(const unsigned*)(V + (size_t)(row0 + j - 30) * 1024 + 2 * tid);
    }
    f32x2 o[16];
#pragma unroll
    for (int k = 0; k < 16; ++k) o[k] = cb;
#pragma unroll
    for (int i = 0; i < 46; ++i) {
        const f32x2 x = (f32x2){bflo(vin[i]), bfhi(vin[i])};
#pragma unroll
        for (int k = 0; k < 16; ++k) { const int tap = i - k; if (tap >= 0 && tap <= 30) o[k] = cw[tap] * x + o[k]; }
    }
    LAS float* cbuf = (LAS float*)lds;
#pragma unroll
    for (int k = 0; k < 16; ++k) *(LAS f32x2*)(cbuf + k * 1024 + 2 * tid) = o[k];
    __syncthreads();
#pragma unroll
    for (int rr = 0; rr < 2; ++rr) {
        const int row = 2 * w + rr;
        f32x4 v[4]; float sum = 0.f;
#pragma unroll
        for (int j = 0; j < 4; ++j) { v[j] = *(const LAS f32x4*)(cbuf + row * 1024 + 4 * lane + 256 * j); sum += (v[j].x + v[j].y) + (v[j].z + v[j].w); }
        const float mean = wave_sum(sum) * (1.f / 1024.f); float q = 0.f;
#pragma unroll
        for (int j = 0; j < 4; ++j) { v[j] = v[j] - mean; q += (v[j].x * v[j].x + v[j].y * v[j].y) + (v[j].z * v[j].z + v[j].w * v[j].w); }
        const float rstd = 1.0f / sqrtf(wave_sum(q) * (1.f / 1024.f) + EPS);
        v2u* dst = (v2u*)(VN + (size_t)(row0 + t0 + row) * 1024) + lane;
#pragma unroll
        for (int j = 0; j < 4; ++j) {
            const f32x4 g = *((const f32x4*)a.in[17] + lane + 64 * j), b = *((const f32x4*)a.in[18] + lane + 64 * j);
            const f32x4 y = v[j] * rstd * g + b;
            v2u ov; ov.x = pk2(fsilu(y.x), fsilu(y.y)); ov.y = pk2(fsilu(y.z), fsilu(y.w)); dst[64 * j] = ov;
        }
    }
    __syncthreads();
}

__global__ void __launch_bounds__(512, 2) hymba_fwd(Args args) {
    extern __shared__ __attribute__((aligned(16))) unsigned char lds_raw[];
    cg::grid_group grid = cg::this_grid();
    LAS unsigned char* lds = (LAS unsigned char*)lds_raw;
    const int tid = threadIdx.x, lane = tid & 63, wave = __builtin_amdgcn_readfirstlane(tid >> 6);
    const int G = gridDim.x, bx = blockIdx.x;
    const int vcu = (G % 8 == 0) ? (bx % 8) * (G / 8) + bx / 8 : bx;
    const int gw = vcu * 8 + wave, NGW = G * 8;
    const int lo = args.ph_lo, hi = args.ph_hi;
#define IN(k) (lo <= (k) && (k) < hi)
#define BOTH(k) (IN(k) && IN((k) + 1))
    unsigned char* ws = args.ws;

    if (IN(0)) { p0_prologue(args, lds, gw, NGW, wave, lane); if (BOTH(0)) grid.sync(); }

    if (IN(1)) {
        pg8::Gemm g{(const bf16*)(ws + WS_XN), (const bf16*)(ws + WS_WIN), M, DIN, 1024}; pg8::StaticOrder S; S.init(M, DIN, G, bx);
        Epi1 E{(bf16*)(ws + WS_XR), (bf16*)(ws + WS_GR), (bf16*)(ws + WS_V), (bf16*)(ws + WS_GC)};
        pg8::gemm_phase<Epi1, pg8::StaticOrder, PG8_ALIGN, PG8_SP2>(lds, g, S, E);
        if (BOTH(1)) grid.sync();
    }

    if (IN(2)) {
        __syncthreads();
        for (int it = bx; it < NB * 16; it += G) rg_item(args, lds, it >> 4, it & 15);
        {
            f32x2 cw[31];
#pragma unroll
            for (int k = 0; k < 31; ++k) cw[k] = *(const f32x2*)(args.in[15] + k * 1024 + 2 * tid);
            const f32x2 cb = *(const f32x2*)(args.in[16] + 2 * tid);
            constexpr int NCV_P = NB * (TP / 16), NCV = NCV_P + DB * (DS / 16);
            for (int it = bx; it < NCV; it += G) {
                int s, t0;
                if (it < NCV_P) { s = it / (TP / 16); t0 = (it - s * (TP / 16)) * 16; } else { const int r = it - NCV_P; s = NB + (r >> 1); t0 = (r & 1) * 16; }
                cv_item(args, lds, s, t0, cw, cb);
            }
        }
        for (int it = bx; it < DB * 16; it += G) rg_item(args, lds, NB + (it >> 4), it & 15);
        {
            const bf16* XR = (const bf16*)(ws + WS_XR); const bf16* V = (const bf16*)(ws + WS_V);
            const int gt = vcu * 512 + tid, NGT = G * 512;
            for (int i = gt; i < NSEQ * 33 * 512; i += NGT) {
                const int c2 = i & 511, rr = (i >> 9) % 33, s = (i >> 9) / 33;
                int row0, T; float* o3; float* o30;
                if (s < NB) { row0 = s * TP; T = TP; o3 = args.out + O_RGC_P + (size_t)s * 3 * 1024; o30 = args.out + O_CVC_P + (size_t)s * 30 * 1024; }
                else { const int q = s - NB; row0 = MP + q * DS; T = DS; o3 = args.out + O_RGC_S + (size_t)q * 3 * 1024; o30 = args.out + O_CVC_S + (size_t)q * 30 * 1024; }
                if (rr < 3) { const unsigned u = *(const unsigned*)(XR + (size_t)(row0 + T - 3 + rr) * 1024 + 2 * c2); *(f32x2*)(o3 + rr * 1024 + 2 * c2) = (f32x2){bflo(u), bfhi(u)}; }
                else { const int r2 = rr - 3; const unsigned u = *(const unsigned*)(V + (size_t)(row0 + T - 30 + r2) * 1024 + 2 * c2); *(f32x2*)(o30 + r2 * 1024 + 2 * c2) = (f32x2){bflo(u), bfhi(u)}; }
            }
        }
        if (BOTH(2)) grid.sync();
    }

    if (IN(3)) {
        pg8::Gemm g{(const bf16*)(ws + WS_XN), (const bf16*)(ws + WS_W2), M, 1024, 1024}; pg8::StaticOrder S; S.init(M, 1024, G, bx);
        Epi2 E{(bf16*)(ws + WS_YCAT), (const bf16*)(ws + WS_GC), args.in[20]};
        pg8::gemm_phase<Epi2, pg8::StaticOrder, PG8_ALIGN, PG8_SP2>(lds, g, S, E);
        if (BOTH(3)) grid.sync();
    }

    if (IN(4)) {
        pg8::Gemm g{(const bf16*)(ws + WS_YCAT), (const bf16*)(ws + WS_WOUT), M, 1024, 2048}; OrderP4 S; S.init(M, G, vcu);
        EpiFinal E{args.in[0], args.in[1], args.out, args.in[22], (float*)(ws + CTL_SLOTS), (unsigned*)(ws + CTL_CNT), (LAS float*)(lds + 131072)};
        pg8::gemm_phase<EpiFinal, OrderP4, true, PG8_SP2>(lds, g, S, E);
    }
#undef IN
#undef BOTH
}

extern "C" void kernel_launch(void* const* d_in, const int* in_sizes, int n_in, void* d_out, int out_size, void* d_ws, size_t ws_size, hipStream_t stream) {
    static int grid = 0;
    if (grid == 0) {
        if (n_in != 23 || out_size != (int)O_END || ws_size < WS_END) { fprintf(stderr, "kernel_launch: unexpected problem (n_in %d, out %d, ws %zu; need ws >= %zu)\n", n_in, out_size, ws_size, (size_t)WS_END); grid = -1; return; }
        int dev = 0, cus = 0, per_cu = 0;
        if (hipGetDevice(&dev) != hipSuccess || hipDeviceGetAttribute(&cus, hipDeviceAttributeMultiprocessorCount, dev) != hipSuccess) { grid = -1; return; }
        if (hipFuncSetAttribute((const void*)hymba_fwd, hipFuncAttributeMaxDynamicSharedMemorySize, LDS_BYTES) != hipSuccess) { fprintf(stderr, "kernel_launch: hipFuncSetAttribute failed\n"); grid = -1; return; }
        if (hipOccupancyMaxActiveBlocksPerMultiprocessor(&per_cu, (const void*)hymba_fwd, 512, LDS_BYTES) != hipSuccess || per_cu < 1) { fprintf(stderr, "kernel_launch: occupancy query says %d\n", per_cu); per_cu = 1; }
        (void)hipGetLastError();
        grid = cus - (cus % 8);
    }
    if (grid < 0) return;
    Args a{};
    for (int i = 0; i < 23; ++i) a.in[i] = (const float*)d_in[i];
    a.out = (float*)d_out; a.ws = (unsigned char*)d_ws;
    void* kargs[] = {&a};
#ifdef PROBE_DBL
    const int cuts[4] = {0, PROBE_DBL + 1, PROBE_DBL + 1, 5}; const int los[3] = {0, PROBE_DBL, PROBE_DBL + 1};
    for (int li = 0; li < 3; ++li) { a.ph_lo = los[li]; a.ph_hi = cuts[li + 1]; if (a.ph_lo >= a.ph_hi) continue;
        hipError_t e = hipLaunchCooperativeKernel((const void*)hymba_fwd, dim3(grid), dim3(512), kargs, LDS_BYTES, stream);
        if (e != hipSuccess) fprintf(stderr, "kernel_launch: cooperative launch failed: %s (grid %d)\n", hipGetErrorString(e), grid); }
#else
    a.ph_lo = 0; a.ph_hi = 5;
    hipError_t e = hipLaunchCooperativeKernel((const void*)hymba_fwd, dim3(grid), dim3(512), kargs, LDS_BYTES, stream);
    if (e != hipSuccess) fprintf(stderr, "kernel_launch: cooperative launch failed: %s (grid %d)\n", hipGetErrorString(e), grid);
#endif
}
```

```cpp
#include <hip/hip_runtime.h>
#include <hip/hip_cooperative_groups.h>
#include <cstdio>
#include <cstdint>
namespace cg = cooperative_groups;
namespace pg8 {
#define PG8_LAS __attribute__((address_space(3)))
typedef unsigned short bf16_t;
typedef short bf16x8 __attribute__((ext_vector_type(8)));
typedef float f32x4 __attribute__((ext_vector_type(4)));
typedef unsigned u32x4 __attribute__((ext_vector_type(4)));
constexpr int BM = 256, BK = 64, HALF = 128, HTB = HALF * BK * 2  , STAGE_BYTES = 8 * HTB, NXCD = 8, WGM = 8;

__host__ __device__ __forceinline__ int lds_byte(int r, int c) { const int st = (r >> 4) * 2 + (c >> 5), rr = r & 15, cc = c & 31, ob = rr * 64 + cc * 2; return st * 1024 + (ob ^ (((ob >> 9) & 1) << 5)); }
__host__ __device__ __forceinline__ void stage_rc(int b, int& R, int& C) { const int st = b / 1024, sb = b % 1024, swz = sb ^ (((sb >> 9) & 1) << 5); R = (st >> 1) * 16 + swz / 64; C = (st & 1) * 32 + (swz % 64) / 2; }
__host__ __device__ __forceinline__ int perm32(int rho) { const int n = rho >> 4, i = rho & 15; return 8 * (i >> 2) + 4 * n + (i & 3); }

struct Unit { int pm, pn; };
struct Gemm { const bf16_t* A; const bf16_t* Bt; int M, N, K; };

struct StaticOrder {
    int nM, nN, nwg, G, c;
    __host__ __device__ void init(int M, int N, int G_, int c_) { nM = M / BM; nN = N / BM; nwg = nM * nN; G = G_; c = c_; }
    __host__ __device__ bool next(int i, Unit& u) const {
        const long L = (long)i * G + c; if (L >= nwg) return false;
        int wgid = (int)L; { const int q = nwg / NXCD, r = nwg % NXCD, xcd = wgid % NXCD, off = wgid / NXCD; wgid = (xcd < r ? xcd * (q + 1) : r * (q + 1) + (xcd - r) * q) + off; }
        const int nig = WGM * nN, gid = wgid / nig, fm = gid * WGM, gsz = (nM - fm) < WGM ? (nM - fm) : WGM;
        u.pm = fm + ((wgid % nig) % gsz); u.pn = (wgid % nig) / gsz; return true;
    }
    __device__ __forceinline__ void a_ready(const Unit&) const {}
    __device__ __forceinline__ void done(const Unit&) const {}
};

__device__ __forceinline__ unsigned cvt_pk_bf16(float lo, float hi) { unsigned r; asm volatile("v_cvt_pk_bf16_f32 %0, %1, %2" : "=v"(r) : "v"(lo), "v"(hi)); return r; }
template <class Epi, class Sched, bool ALIGN_EPI = false, bool SP2 = false>
__device__ __forceinline__ void gemm_phase(PG8_LAS unsigned char* lds, const Gemm g, const Sched& S, const Epi& E) {
    const int tid = threadIdx.x, wid = __builtin_amdgcn_readfirstlane(tid >> 6), lane = tid & 63, wr = wid >> 2, wc = wid & 3, fr = lane & 15, fq = lane >> 4;
    const int K = g.K, nt = K / BK;
    unsigned voffA[2], voffB[2];
#pragma unroll
    for (int i = 0; i < 2; ++i) { int R, C; stage_rc(tid * 16 + i * 8192, R, C); const int Rb = Epi::PERM ? ((R & ~31) + perm32(R & 31)) : R;
        voffA[i] = (unsigned)(R * K + C) * 2u; voffB[i] = (unsigned)(Rb * K + C) * 2u; }
    const size_t kstep = (size_t)(BK * 2);
    const size_t hstep = (size_t)HALF * K * 2;
    const size_t tstep = 2 * hstep;
    const unsigned ldsw = (unsigned)wid * 1024u;
    const int aoff = lds_byte(wr * 64 + fr, fq * 8), boff = lds_byte(wc * 32 + fr, fq * 8);
#define PG8_SA(b, h) (((b) * 2 + (h)) * HTB)
#define PG8_SB(b, h) ((4 + (b) * 2 + (h)) * HTB)
#define PG8_STAGE(bufoff, gbase, voff) do { _Pragma("unroll") for (int _i = 0; _i < 2; ++_i) \
        __builtin_amdgcn_global_load_lds((const unsigned*)((const char*)(gbase) + (voff)[_i]), (PG8_LAS unsigned*)(lds + (bufoff) + ldsw + _i * 8192), 16, 0, 0); } while (0)
#define PG8_LDA(dst, b, h) do { _Pragma("unroll") for (int m = 0; m < 4; ++m) _Pragma("unroll") for (int k = 0; k < 2; ++k) dst[m][k] = *(const PG8_LAS bf16x8*)(lds + PG8_SA(b, h) + aoff + m * 2048 + k * 1024); } while (0)
#define PG8_LDB(dst, b, h) do { _Pragma("unroll") for (int n = 0; n < 2; ++n) _Pragma("unroll") for (int k = 0; k < 2; ++k) dst[n][k] = *(const PG8_LAS bf16x8*)(lds + PG8_SB(b, h) + boff + n * 2048 + k * 1024); } while (0)
#define PG8_MMA(ai, bj, At, Bt) do { __builtin_amdgcn_s_setprio(1); _Pragma("unroll") for (int m = 0; m < 4; ++m) _Pragma("unroll") for (int n = 0; n < 2; ++n) _Pragma("unroll") for (int k = 0; k < 2; ++k) \
        acc[ai][bj][m][n] = __builtin_amdgcn_mfma_f32_16x16x32_bf16(Bt[n][k], At[m][k], acc[ai][bj][m][n], 0, 0, 0); __builtin_amdgcn_s_setprio(0); } while (0)
#define PG8_WAIT_V(n) asm volatile("s_waitcnt vmcnt(" #n ")" ::: "memory")
#define PG8_WAIT_L(n) asm volatile("s_waitcnt lgkmcnt(" #n ")" ::: "memory")
#define PG8_BAR __builtin_amdgcn_s_barrier()
#define PG8_SCHED __builtin_amdgcn_sched_barrier(0)
    Unit cur, nxt; int ui = 0;
    if (!S.next(0, cur)) return;
    f32x4 acc[2][2][4][2];
#pragma unroll
    for (int a = 0; a < 2; ++a)
#pragma unroll
        for (int b = 0; b < 2; ++b)
#pragma unroll
            for (int m = 0; m < 4; ++m)
#pragma unroll
                for (int n = 0; n < 2; ++n) acc[a][b][m][n] = (f32x4){0.f, 0.f, 0.f, 0.f};
    bf16x8 At[4][2], B0[2][2], B1[2][2];
    const char* cA = (const char*)g.A + (size_t)cur.pm * tstep; const char* cB = (const char*)g.Bt + (size_t)cur.pn * tstep;
    S.a_ready(cur);
    if constexpr (SP2) {
        PG8_STAGE(PG8_SB(0, 0), cB, voffB); PG8_STAGE(PG8_SB(0, 1), cB + hstep, voffB); PG8_STAGE(PG8_SA(0, 0), cA, voffA); PG8_STAGE(PG8_SA(0, 1), cA + hstep, voffA);
        if (wr == 1) PG8_BAR;
        PG8_WAIT_V(2); PG8_BAR;
        PG8_STAGE(PG8_SB(1, 0), cB + kstep, voffB); PG8_STAGE(PG8_SA(1, 0), cA + kstep, voffA); PG8_STAGE(PG8_SB(1, 1), cB + hstep + kstep, voffB);
        PG8_WAIT_V(6); PG8_BAR;
    } else {
        PG8_STAGE(PG8_SB(0, 0), cB, voffB); PG8_STAGE(PG8_SA(0, 0), cA, voffA); PG8_STAGE(PG8_SB(0, 1), cB + hstep, voffB); PG8_STAGE(PG8_SA(0, 1), cA + hstep, voffA);
        if (wr == 1) PG8_BAR;
        PG8_WAIT_V(4); PG8_BAR;
        PG8_STAGE(PG8_SB(1, 0), cB + kstep, voffB); PG8_STAGE(PG8_SA(1, 0), cA + kstep, voffA); PG8_STAGE(PG8_SB(1, 1), cB + hstep + kstep, voffB);
        PG8_WAIT_V(6); PG8_BAR;
    }
    for (;;) {
        const bool has_next = S.next(ui + 1, nxt);
        const char* nA = has_next ? (const char*)g.A + (size_t)nxt.pm * tstep : cA; const char* nB = has_next ? (const char*)g.Bt + (size_t)nxt.pn * tstep : cB;
        for (int t = 0; t < nt; t += 2) {
            const bool last = (t == nt - 2);
            const char* a1 = cA + (size_t)(t + 1) * kstep;
            const char* a2 = last ? nA : cA + (size_t)(t + 2) * kstep; const char* b2 = last ? nB : cB + (size_t)(t + 2) * kstep;
            const char* a3 = a2 + kstep; const char* b3 = b2 + kstep;
            if (last && has_next) S.a_ready(nxt);
            if constexpr (SP2) {
            PG8_LDB(B0, 0, 0); PG8_LDB(B1, 0, 1); PG8_SCHED; PG8_LDA(At, 0, 0); PG8_STAGE(PG8_SA(1, 1), a1 + hstep, voffA);
            PG8_WAIT_V(8); PG8_WAIT_L(0); PG8_BAR; PG8_MMA(0, 0, At, B0); PG8_MMA(0, 1, At, B1); PG8_BAR; PG8_SCHED;
            PG8_LDA(At, 0, 1); PG8_STAGE(PG8_SB(0, 0), b2, voffB); PG8_STAGE(PG8_SB(0, 1), b2 + hstep, voffB); PG8_STAGE(PG8_SA(0, 0), a2, voffA);
            PG8_WAIT_V(8); PG8_WAIT_L(0); PG8_BAR; PG8_MMA(1, 0, At, B0); PG8_MMA(1, 1, At, B1); PG8_BAR; PG8_SCHED;
            PG8_LDB(B0, 1, 0); PG8_LDB(B1, 1, 1); PG8_SCHED; PG8_LDA(At, 1, 0); PG8_STAGE(PG8_SA(0, 1), a2 + hstep, voffA);
            PG8_WAIT_V(8); PG8_WAIT_L(0); PG8_BAR; PG8_MMA(0, 0, At, B0); PG8_MMA(0, 1, At, B1); PG8_BAR; PG8_SCHED;
            PG8_LDA(At, 1, 1); PG8_STAGE(PG8_SB(1, 0), b3, voffB); PG8_STAGE(PG8_SB(1, 1), b3 + hstep, voffB); PG8_STAGE(PG8_SA(1, 0), a3, voffA);
            PG8_WAIT_V(8); PG8_WAIT_L(0); PG8_BAR; PG8_MMA(1, 0, At, B0); PG8_MMA(1, 1, At, B1); PG8_BAR; PG8_SCHED;
            } else {
            PG8_LDB(B0, 0, 0); PG8_SCHED; PG8_LDA(At, 0, 0); PG8_STAGE(PG8_SA(1, 1), a1 + hstep, voffA);
            PG8_WAIT_L(8); PG8_BAR; PG8_WAIT_L(0); PG8_MMA(0, 0, At, B0); PG8_BAR; PG8_SCHED;
            PG8_LDB(B1, 0, 1); PG8_STAGE(PG8_SB(0, 0), b2, voffB);
            PG8_BAR; PG8_WAIT_L(0); PG8_MMA(0, 1, At, B1); PG8_BAR;
            PG8_LDA(At, 0, 1); PG8_STAGE(PG8_SA(0, 0), a2, voffA);
            PG8_BAR; PG8_WAIT_L(0); PG8_MMA(1, 0, At, B0); PG8_BAR; PG8_SCHED;
            PG8_STAGE(PG8_SB(0, 1), b2 + hstep, voffB);
            PG8_WAIT_V(6); PG8_BAR; PG8_MMA(1, 1, At, B1); PG8_BAR;
            PG8_LDB(B0, 1, 0); PG8_SCHED; PG8_LDA(At, 1, 0); PG8_STAGE(PG8_SA(0, 1), a2 + hstep, voffA);
            PG8_WAIT_L(8); PG8_BAR; PG8_WAIT_L(0); PG8_MMA(0, 0, At, B0); PG8_BAR; PG8_SCHED;
            PG8_LDB(B1, 1, 1); PG8_STAGE(PG8_SB(1, 0), b3, voffB);
            PG8_BAR; PG8_WAIT_L(0); PG8_MMA(0, 1, At, B1); PG8_BAR;
            PG8_LDA(At, 1, 1); PG8_STAGE(PG8_SA(1, 0), a3, voffA);
            PG8_BAR; PG8_WAIT_L(0); PG8_MMA(1, 0, At, B0); PG8_BAR; PG8_SCHED;
            PG8_STAGE(PG8_SB(1, 1), b3 + hstep, voffB);
            PG8_WAIT_V(6); PG8_BAR; PG8_MMA(1, 1, At, B1); PG8_BAR;
            }
        }
        if constexpr (ALIGN_EPI) { if (wr == 0) PG8_BAR; }
        if constexpr (!Epi::AFTER_DRAIN) { E(acc, cur, wr, wc, fr, fq); S.done(cur); }
        if (!has_next) break;
#pragma unroll
        for (int a = 0; a < 2; ++a)
#pragma unroll
            for (int b = 0; b < 2; ++b)
#pragma unroll
                for (int m = 0; m < 4; ++m)
#pragma unroll
                    for (int n = 0; n < 2; ++n) acc[a][b][m][n] = (f32x4){0.f, 0.f, 0.f, 0.f};
        cur = nxt; cA = nA; cB = nB; ++ui;
        if constexpr (ALIGN_EPI) { if (wr == 1) PG8_BAR; }
    }
    PG8_WAIT_V(0);
    if constexpr (!ALIGN_EPI) { if (wr == 0) PG8_BAR; }
    PG8_BAR;
    if constexpr (Epi::AFTER_DRAIN) { E.fused(acc, cur, wr, wc, fr, fq, lds, wid, lane); S.done(cur); }
#undef PG8_SA
#undef PG8_SB
#undef PG8_STAGE
#undef PG8_LDA
#undef PG8_LDB
#undef PG8_MMA
#undef PG8_WAIT_V
#undef PG8_WAIT_L
#undef PG8_BAR
#undef PG8_SCHED
}
}

#ifndef PG8_SP2
#define PG8_SP2 true
#endif
#ifndef PG8_ALIGN
#define PG8_ALIGN true
#endif

constexpr int DM = 1024, NB = 16, SEQ = 2048, NMETA = 16, TP = SEQ + NMETA;
constexpr int DB = 32, DS = 32;
constexpr int MP = NB * TP, MS = DB * DS, M = MP + MS;
constexpr int DIN = 5120, DMIX = 2048;
constexpr int NSEQ = NB + DB;
constexpr float EPS = 1e-6f;
static_assert(M % 256 == 0, "M tiles");

constexpr size_t MiB = 1u << 20;
constexpr size_t ACT = (size_t)M * 1024 * 2;
constexpr size_t WS_WIN = 1 * MiB, WS_W2 = 11 * MiB, WS_WOUT = 13 * MiB;
constexpr size_t WS_XN = 20 * MiB;
constexpr size_t WS_XR = WS_XN + ACT, WS_GR = WS_XR + ACT, WS_V = WS_GR + ACT, WS_GC = WS_V + ACT, WS_YCAT = WS_GC + ACT;
constexpr size_t WS_END = WS_YCAT + 2 * ACT;
constexpr size_t WS_Y = WS_XR;

constexpr size_t O_YP = 0, O_YS = (size_t)NB * SEQ * DM, O_RGH_P = O_YS + (size_t)MS * DM, O_RGC_P = O_RGH_P + NB * 1024,
                 O_CVC_P = O_RGC_P + NB * 3 * 1024, O_RGH_S = O_CVC_P + NB * 30 * 1024, O_RGC_S = O_RGH_S + DB * 1024,
                 O_CVC_S = O_RGC_S + DB * 3 * 1024, O_END = O_CVC_S + DB * 30 * 1024;

constexpr int LDS_BYTES = 147456;

#define GAS __attribute__((address_space(1)))
#define LAS __attribute__((address_space(3)))
typedef unsigned short bf16;
typedef unsigned v4u __attribute__((ext_vector_type(4)));
typedef unsigned v2u __attribute__((ext_vector_type(2)));
typedef float f32x4 __attribute__((ext_vector_type(4)));
typedef float f32x2 __attribute__((ext_vector_type(2)));
typedef short bf16x8 __attribute__((ext_vector_type(8)));
#define LDS_WAIT() asm volatile("s_waitcnt lgkmcnt(0)" ::: "memory")
__device__ __forceinline__ void lds_barrier() { asm volatile("s_waitcnt lgkmcnt(0)\n\ts_barrier" ::: "memory"); }

__device__ __forceinline__ unsigned pk2(float lo, float hi) { return pg8::cvt_pk_bf16(lo, hi); }
__device__ __forceinline__ float bflo(unsigned u) { return __builtin_bit_cast(float, u << 16); }
__device__ __forceinline__ float bfhi(unsigned u) { return __builtin_bit_cast(float, u & 0xffff0000u); }
__device__ __forceinline__ float fsigmoid(float x) { return __builtin_amdgcn_rcpf(1.0f + __builtin_amdgcn_exp2f(-1.4426950408889634f * x)); }
__device__ __forceinline__ float fsilu(float x) { return x * fsigmoid(x); }
__device__ __forceinline__ float wave_sum(float v) {
#pragma unroll
    for (int o = 1; o < 64; o <<= 1) v += __shfl_xor(v, o);
    return v;
}

struct Args { const float* in[23]; float* out; unsigned char* ws; int ph_lo, ph_hi, p2mask, pad; };

struct Epi1 {
    static constexpr bool PERM = true, AFTER_DRAIN = false;
    bf16 *XR, *GR, *V, *GC;
    __device__ __forceinline__ void operator()(const pg8::f32x4 (&acc)[2][2][4][2], const pg8::Unit& u, int wr, int wc, int fr, int fq) const {
        const int row0 = u.pm * 256 + wr * 64 + fr; const int pn = u.pn;
        if (pn >= 8 && pn < 16) {
            const int col0 = 128 * (pn - 8) + wc * 32 + 8 * fq;
#pragma unroll
            for (int ai = 0; ai < 2; ++ai)
#pragma unroll
                for (int m = 0; m < 4; ++m) {
                    float o[8];
#pragma unroll
                    for (int n = 0; n < 2; ++n)
#pragma unroll
                        for (int e = 0; e < 4; ++e) o[4 * n + e] = acc[ai][0][m][n][e] * fsigmoid(acc[ai][1][m][n][e]);
                    v4u w; w.x = pk2(o[0], o[1]); w.y = pk2(o[2], o[3]); w.z = pk2(o[4], o[5]); w.w = pk2(o[6], o[7]);
                    *(v4u*)(V + (size_t)(row0 + ai * 128 + m * 16) * 1024 + col0) = w;
                }
        } else {
            bf16* base; int colt; bool act;
            if (pn < 4) { base = XR; colt = pn * 256; act = false; }
            else if (pn < 8) { base = GR; colt = (pn - 4) * 256; act = true; }
            else { base = GC; colt = (pn - 16) * 256; act = true; }
            const int col0 = colt + wc * 32 + 8 * fq;
#pragma unroll
            for (int ai = 0; ai < 2; ++ai)
#pragma unroll
                for (int m = 0; m < 4; ++m) {
                    bf16* rowp = base + (size_t)(row0 + ai * 128 + m * 16) * 1024 + col0;
#pragma unroll
                    for (int bj = 0; bj < 2; ++bj) {
                        float o[8];
#pragma unroll
                        for (int n = 0; n < 2; ++n)
#pragma unroll
                            for (int e = 0; e < 4; ++e) { const float x = acc[ai][bj][m][n][e]; o[4 * n + e] = act ? fsilu(x) : x; }
                        v4u w; w.x = pk2(o[0], o[1]); w.y = pk2(o[2], o[3]); w.z = pk2(o[4], o[5]); w.w = pk2(o[6], o[7]);
                        *(v4u*)(rowp + bj * 128) = w;
                    }
                }
        }
    }
};
struct Epi2 {
    static constexpr bool PERM = true, AFTER_DRAIN = false;
    bf16* YCAT; const bf16* GC; const float* bias;
    __device__ __forceinline__ void operator()(const pg8::f32x4 (&acc)[2][2][4][2], const pg8::Unit& u, int wr, int wc, int fr, int fq) const {
        const int row0 = u.pm * 256 + wr * 64 + fr, col0 = u.pn * 256 + wc * 32 + 8 * fq;
        f32x4 bv[2][2];
#pragma unroll
        for (int bj = 0; bj < 2; ++bj)
#pragma unroll
            for (int n = 0; n < 2; ++n) bv[bj][n] = *(const f32x4*)(bias + col0 + bj * 128 + 4 * n);
#pragma unroll
        for (int ai = 0; ai < 2; ++ai)
#pragma unroll
            for (int m = 0; m < 4; ++m) {
                const size_t r = (size_t)(row0 + ai * 128 + m * 16);
#pragma unroll
                for (int bj = 0; bj < 2; ++bj) {
                    const v4u g = *(const v4u*)(GC + r * 1024 + col0 + bj * 128);
                    const f32x4 v0 = acc[ai][bj][m][0] + bv[bj][0], v1 = acc[ai][bj][m][1] + bv[bj][1];
                    v4u w; w.x = pk2(v0[0] * bflo(g.x), v0[1] * bfhi(g.x)); w.y = pk2(v0[2] * bflo(g.y), v0[3] * bfhi(g.y));
                    w.z = pk2(v1[0] * bflo(g.z), v1[1] * bfhi(g.z)); w.w = pk2(v1[2] * bflo(g.w), v1[3] * bfhi(g.w));
                    *(v4u*)(YCAT + r * 2048 + 1024 + col0 + bj * 128) = w;
                }
            }
    }
};
struct Epi3 {
    static constexpr bool PERM = false, AFTER_DRAIN = false;
    float* C;
    __device__ __forceinline__ void operator()(const pg8::f32x4 (&acc)[2][2][4][2], const pg8::Unit& u, int wr, int wc, int fr, int fq) const {
        const int row0 = u.pm * 256 + wr * 64 + fr, col0 = u.pn * 256 + wc * 32 + 4 * fq;
#pragma unroll
        for (int ai = 0; ai < 2; ++ai)
#pragma unroll
            for (int m = 0; m < 4; ++m) { float* rowp = C + (size_t)(row0 + ai * 128 + m * 16) * 1024 + col0;
#pragma unroll
                for (int bj = 0; bj < 2; ++bj)
#pragma unroll
                    for (int n = 0; n < 2; ++n) *(f32x4*)(rowp + bj * 128 + n * 16) = acc[ai][bj][m][n]; }
    }
};

constexpr size_t CTL_CNT = 0, CTL_SLOTS = 65536, CTL_BF = 655360, CTL_NSP = 917504;
struct OrderP4 {
    int nwg, G, c;
    __device__ void init(int M_, int G_, int c_) { nwg = (M_ / 256) * 4; G = G_; c = c_; }
    __device__ bool next(int i, pg8::Unit& u) const { const int L = i * G + c; if (L >= nwg) return false; u.pm = L >> 2; u.pn = L & 3; return true; }
    __device__ __forceinline__ void a_ready(const pg8::Unit&) const {}
    __device__ __forceinline__ void done(const pg8::Unit&) const {}
};
struct EpiFinal {
    static constexpr bool PERM = false, AFTER_DRAIN = false;
    const float* xp; const float* xs; float* out; const float* g; float* slots; unsigned* cnt; LAS float* scr;
    __device__ __forceinline__ void operator()(const pg8::f32x4 (&acc)[2][2][4][2], const pg8::Unit& u, int wr, int wc, int fr, int fq) const {
        const int tid = threadIdx.x, lane = tid & 63, wid = __builtin_amdgcn_readfirstlane(tid >> 6);
        LAS float* P = scr; LAS float* S = scr + 1024;
#pragma unroll
        for (int ai = 0; ai < 2; ++ai)
#pragma unroll
            for (int m = 0; m < 4; ++m) {
                float s = 0.f;
#pragma unroll
                for (int bj = 0; bj < 2; ++bj)
#pragma unroll
                    for (int n = 0; n < 2; ++n) { const pg8::f32x4 x = acc[ai][bj][m][n]; s += (x[0] * x[0] + x[1] * x[1]) + (x[2] * x[2] + x[3] * x[3]); }
                s += __shfl_xor(s, 16); s += __shfl_xor(s, 32);
                if (fq == 0) P[(ai * 128 + wr * 64 + m * 16 + fr) * 4 + wc] = s;
            }
        asm volatile("s_waitcnt lgkmcnt(0)" ::: "memory"); __builtin_amdgcn_s_barrier(); asm volatile("" ::: "memory");
        if (tid < 256) { const f32x4 p = *(const LAS f32x4*)(P + tid * 4);
            __hip_atomic_store(slots + ((size_t)(u.pm * 256 + tid) * 4 + u.pn), (p.x + p.y) + (p.z + p.w), __ATOMIC_RELAXED, __HIP_MEMORY_SCOPE_AGENT); }
        asm volatile("s_waitcnt vmcnt(0)" ::: "memory");
        if (wid < 4 && lane == 0) __hip_atomic_fetch_add(cnt + 64 * u.pm, 1u, __ATOMIC_RELAXED, __HIP_MEMORY_SCOPE_AGENT);
        if (wid == 0) {
            unsigned spins = 0;
            while ((unsigned)__builtin_amdgcn_readfirstlane(__hip_atomic_load(cnt + 64 * u.pm, __ATOMIC_RELAXED, __HIP_MEMORY_SCOPE_AGENT)) < 16u) { __builtin_amdgcn_s_sleep(2); if (++spins > (1u << 22)) break; }
            __builtin_amdgcn_fence(__ATOMIC_ACQUIRE, "agent");
        }
        asm volatile("s_waitcnt vmcnt(0) lgkmcnt(0)" ::: "memory"); __builtin_amdgcn_s_barrier(); asm volatile("" ::: "memory");
        if (tid < 256) { const float* sl = slots + (size_t)(u.pm * 256 + tid) * 4; float t = 0.f;
#pragma unroll
            for (int q = 0; q < 4; ++q) t += __hip_atomic_load(sl + q, __ATOMIC_RELAXED, __HIP_MEMORY_SCOPE_AGENT);
            S[tid] = 1.0f / sqrtf(t * (1.f / 1024.f) + EPS); }
        asm volatile("s_waitcnt lgkmcnt(0)" ::: "memory"); __builtin_amdgcn_s_barrier(); asm volatile("" ::: "memory");
        const int col0 = u.pn * 256 + wc * 32 + 4 * fq;
        f32x4 gv[2][2];
#pragma unroll
        for (int bj = 0; bj < 2; ++bj)
#pragma unroll
            for (int n = 0; n < 2; ++n) gv[bj][n] = *(const f32x4*)(g + col0 + bj * 128 + n * 16);
#pragma unroll
        for (int ai = 0; ai < 2; ++ai)
#pragma unroll
            for (int m = 0; m < 4; ++m) {
                const int rl = ai * 128 + wr * 64 + m * 16 + fr, r = u.pm * 256 + rl; const float rs = S[rl];
                const float* xrow; float* orow; bool ok = true;
                if (r < MP) { const int b = r / TP, t = r - b * TP; ok = t >= NMETA; const size_t o = ((size_t)b * SEQ + (ok ? t - NMETA : 0)) * DM; xrow = xp + o; orow = out + O_YP + o; }
                else { const size_t o = (size_t)(r - MP) * DM; xrow = xs + o; orow = out + O_YS + o; }
                if (ok) {
#pragma unroll
                    for (int bj = 0; bj < 2; ++bj)
#pragma unroll
                        for (int n = 0; n < 2; ++n) { const f32x4 xv = *(const f32x4*)(xrow + col0 + bj * 128 + n * 16);
                            *(f32x4*)(orow + col0 + bj * 128 + n * 16) = xv + acc[ai][bj][m][n] * rs * gv[bj][n]; }
                }
                asm volatile("" ::: "memory");
            }
    }
};

__device__ __forceinline__ void p0_transpose_item(const float* W, int K, int N, bf16* WT, int k0, int n0, int dst_row0, LAS float* scr, int lane) {
#pragma unroll 8
    for (int i = 0; i < 32; ++i) { const int kk = 2 * i + (lane >> 5); scr[kk * 33 + (lane & 31)] = W[(size_t)(k0 + kk) * N + n0 + (lane & 31)]; }
    LDS_WAIT();
    const int c = lane & 7;
#pragma unroll
    for (int j = 0; j < 4; ++j) { const int n = (lane >> 3) + 8 * j; const LAS float* s = scr + (8 * c) * 33 + n;
        v4u o; o.x = pk2(s[0 * 33], s[1 * 33]); o.y = pk2(s[2 * 33], s[3 * 33]); o.z = pk2(s[4 * 33], s[5 * 33]); o.w = pk2(s[6 * 33], s[7 * 33]);
        *(v4u*)(WT + (size_t)(dst_row0 + n) * K + k0 + 8 * c) = o; }
    LDS_WAIT();
}
__device__ __forceinline__ int win_dst_row(int n) {
    if (n < 2048 || n >= 4096) return n;
    if (n < 3072) { const int c = n - 2048; return 2048 + 256 * (c >> 7) + (c & 127); }
    const int c = n - 3072; return 2048 + 256 * (c >> 7) + 128 + (c & 127);
}
__device__ __forceinline__ const float* x_row_ptr(const float* xp, const float* xs, const float* meta, int r) {
    if (r < MP) { const int b = r / TP, t = r - b * TP; return t < NMETA ? meta + (size_t)t * DM : xp + ((size_t)b * SEQ + (t - NMETA)) * DM; }
    return xs + (size_t)(r - MP) * DM;
}
__device__ __forceinline__ void p0_prologue(const Args& a, LAS unsigned char* lds, int gw, int NGW, int wave, int lane) {
    LAS float* scr = (LAS float*)(lds + wave * 16384);
    constexpr int I_IN = 16 * 160, I_W2 = 16 * 32, I_WO = 32 * 32;
    bf16* WinT = (bf16*)(a.ws + WS_WIN); bf16* W2T = (bf16*)(a.ws + WS_W2); bf16* WoT = (bf16*)(a.ws + WS_WOUT);
    for (int it = gw; it < I_IN + I_W2 + I_WO; it += NGW) {
        int r = it;
        if (r < I_IN) { const int kb = r / 160, nb = r % 160; p0_transpose_item(a.in[7], 1024, DIN, WinT, 64 * kb, 32 * nb, win_dst_row(32 * nb), scr, lane); continue; } r -= I_IN;
        if (r < I_W2) { const int kb = r / 32, nb = r % 32; p0_transpose_item(a.in[19], 1024, 1024, W2T, 64 * kb, 32 * nb, 32 * nb, scr, lane); continue; } r -= I_W2;
        { const int kb = r / 32, nb = r % 32; p0_transpose_item(a.in[21], 2048, 1024, WoT, 64 * kb, 32 * nb, 32 * nb, scr, lane); }
    }
    if (gw < 133) { if (lane == 0) *((unsigned*)(a.ws + CTL_CNT) + 64 * gw) = 0u; }
    {
        bf16* BF = (bf16*)(a.ws + CTL_BF); float* NSP = (float*)(a.ws + CTL_NSP);
        for (int i = gw * 64 + lane; i < 2 * 16 * 4096; i += NGW * 64) {
            const int mat = i >> 16, r = i & 65535, h = r >> 12, k = (r >> 6) & 63, n = r & 63;
            const float v = (mat ? a.in[12] : a.in[10])[r];
            const int f = mat * 8 + (n >> 4) * 2 + (k >> 5), ln = ((k & 31) >> 3) * 16 + (n & 15), e = k & 7;
            BF[((size_t)(h * 16 + f) * 64 + ln) * 8 + e] = (bf16)(pk2(v, 0.f) & 0xffffu);
        }
        for (int c = gw * 64 + lane; c < 1024; c += NGW * 64) { const float x = -a.in[14][c]; const float sp = fmaxf(x, 0.f) + log1pf(expf(-fabsf(x))); NSP[c] = -8.0f * sp * 1.4426950408889634f; }
    }
    bf16* XN = (bf16*)(a.ws + WS_XN);
    const f32x4* gp = (const f32x4*)a.in[6] + lane;
    f32x4 g[4];
#pragma unroll
    for (int j = 0; j < 4; ++j) g[j] = gp[64 * j];
    for (int r = gw; r < M; r += NGW) {
        const f32x4* xr = (const f32x4*)x_row_ptr(a.in[0], a.in[1], a.in[5], r) + lane;
        f32x4 v[4]; float s = 0.f;
#pragma unroll
        for (int j = 0; j < 4; ++j) { v[j] = xr[64 * j]; s += (v[j].x * v[j].x + v[j].y * v[j].y) + (v[j].z * v[j].z + v[j].w * v[j].w); }
        const float rstd = 1.0f / sqrtf(wave_sum(s) * (1.f / DM) + EPS);
        v2u* o8 = (v2u*)(XN + (size_t)r * DM) + lane;
#pragma unroll
        for (int j = 0; j < 4; ++j) { v2u o; o.x = pk2(v[j].x * rstd * g[j].x, v[j].y * rstd * g[j].y); o.y = pk2(v[j].z * rstd * g[j].z, v[j].w * rstd * g[j].w); o8[64 * j] = o; }
    }
}

constexpr int RG_XS0 = 0, RG_XS_SZ = 20160, RG_GS0 = 40320, RG_GS_SZ = 18432, RG_XC = 77184, RG_TOT = 112000, RG_CW = 120192, RG_BF = 121472;
constexpr int XS_STRIDE = 144, XC_STRIDE = 68;

template <bool PACKED>
__device__ __forceinline__ void rg_prefetch(v4u (&px)[3], v4u (&pg)[2], const bf16* XR, const bf16* GR, const float* rgbuf, int row0, int T, int h, int c0, int tid) {
#pragma unroll
    for (int j = 0; j < 3; ++j) {
        const int idx = tid + 512 * j, row = idx >> 3, seg = idx & 7;
        int t;
        if (PACKED) { const int rc = row < 140 ? row : 139; const int q = rc / 35; t = 32 * q + (rc - 35 * q - 3 >= 0 ? rc - 35 * q - 3 : 0); }
        else { t = c0 - 3 + row; t = t < 0 ? 0 : (t > T - 1 ? T - 1 : t); }
        px[j] = *(const v4u*)(XR + (size_t)(row0 + t) * 1024 + h * 64 + seg * 8);
    }
#pragma unroll
    for (int j = 0; j < 2; ++j) {
        const int idx = tid + 512 * j, row = idx >> 3, seg = idx & 7; int t = c0 + row; t = t > T - 1 ? T - 1 : t;
        pg[j] = *(const v4u*)(GR + (size_t)(row0 + t) * 1024 + h * 64 + seg * 8);
    }
}
template <bool PACKED>
__device__ __forceinline__ void rg_stage(LAS unsigned char* lds, int buf, const v4u (&px)[3], const v4u (&pg)[2], const float* rgbuf, int T, int h, int c0, int tid) {
    const v4u z = (v4u){0u, 0u, 0u, 0u};
#pragma unroll
    for (int j = 0; j < 3; ++j) { const int idx = tid + 512 * j, row = idx >> 3, seg = idx & 7;
        v4u v = px[j];
        if (PACKED) {
            if (row < 140) { const int q = row / 35, t = row - 35 * q - 3;
                if (t < 0) { const f32x4* p = (const f32x4*)(rgbuf + (size_t)q * 3072 + (3 + t) * 1024 + h * 64 + seg * 8); const f32x4 a = p[0], b = p[1];
                    v.x = pk2(a.x, a.y); v.y = pk2(a.z, a.w); v.z = pk2(b.x, b.y); v.w = pk2(b.z, b.w); } }
        } else { const int t = c0 - 3 + row; v = (t >= 0 && t < T) ? v : z; }
        if (row < 140) *(LAS v4u*)(lds + RG_XS0 + buf * RG_XS_SZ + row * XS_STRIDE + seg * 16) = v; }
#pragma unroll
    for (int j = 0; j < 2; ++j) { const int idx = tid + 512 * j, row = idx >> 3, seg = idx & 7; const v4u v = (c0 + row < T) ? pg[j] : z;
        *(LAS v4u*)(lds + RG_GS0 + buf * RG_GS_SZ + row * XS_STRIDE + seg * 16) = v; }
}

template <bool PACKED>
__device__ __forceinline__ void rg_item(const Args& a, LAS unsigned char* lds, int sq, int h) {
    const int tid = threadIdx.x, lane = tid & 63, w = __builtin_amdgcn_readfirstlane(tid >> 6), fr = lane & 15, fq = lane >> 4;
    const bf16* XR = (const bf16*)(a.ws + WS_XR); const bf16* GR = (const bf16*)(a.ws + WS_GR); bf16* YCAT = (bf16*)(a.ws + WS_YCAT);
    const int row0 = PACKED ? MP + 128 * sq : sq * TP, T = PACKED ? 128 : TP, nch = PACKED ? 1 : (TP + 127) / 128;
    const float* rgbuf = PACKED ? a.in[3] + (size_t)(4 * sq) * 3072 : nullptr;
    LAS float* cwl = (LAS float*)(lds + RG_CW);
    if (tid < 320) { const int k = tid >> 6, c = tid & 63; cwl[tid] = (k < 4) ? a.in[8][k * 1024 + h * 64 + c] : a.in[9][h * 64 + c]; }
    { const v4u* src = (const v4u*)(a.ws + CTL_BF + (size_t)h * 16384) + tid * 2; LAS v4u* dst = (LAS v4u*)(lds + RG_BF) + tid * 2; dst[0] = src[0]; dst[1] = src[1]; }
    float ba_[4], bx_[4], nsp[4], hc[4];
#pragma unroll
    for (int nt = 0; nt < 4; ++nt) { const int c = h * 64 + 16 * nt + fr; ba_[nt] = a.in[11][c]; bx_[nt] = a.in[13][c]; nsp[nt] = ((const float*)(a.ws + CTL_NSP))[c];
        hc[nt] = PACKED ? a.in[2][(size_t)(4 * sq + (w >> 1)) * 1024 + c] : 0.f; }
    const int xrow_base = PACKED ? 35 * (w >> 1) + 16 * (w & 1) : 16 * w;

    v4u px[3], pg[2];
    rg_prefetch<PACKED>(px, pg, XR, GR, rgbuf, row0, T, h, 0, tid);
    rg_stage<PACKED>(lds, 0, px, pg, rgbuf, T, h, 0, tid);
    if (nch > 1) rg_prefetch<PACKED>(px, pg, XR, GR, rgbuf, row0, T, h, 128, tid);
    lds_barrier();
    LAS float* xcw = (LAS float*)(lds + RG_XC + w * (16 * XC_STRIDE * 4));
    LAS unsigned char* ysw = (LAS unsigned char*)xcw;
    for (int ch = 0; ch < nch; ++ch) {
        const int c0 = ch * 128, buf = ch & 1;
        if (ch + 1 < nch) { rg_stage<PACKED>(lds, buf ^ 1, px, pg, rgbuf, T, h, c0 + 128, tid); if (ch + 2 < nch) rg_prefetch<PACKED>(px, pg, XR, GR, rgbuf, row0, T, h, c0 + 256, tid); }
        const LAS unsigned char* xs = lds + RG_XS0 + buf * RG_XS_SZ; const LAS unsigned char* gs = lds + RG_GS0 + buf * RG_GS_SZ;
        if (a.p2mask & 32) { lds_barrier(); continue; }
        bf16x8 Af[2];
#pragma unroll
        for (int ks = 0; ks < 2; ++ks) {
            const int cb = 32 * ks + 8 * fq;
            f32x4 lo = *(const LAS f32x4*)(cwl + 256 + cb), hi = *(const LAS f32x4*)(cwl + 256 + cb + 4);
#pragma unroll
            for (int k = 0; k < 4; ++k) {
                const v4u xv = *(const LAS v4u*)(xs + (xrow_base + fr + k) * XS_STRIDE + cb * 2);
                const f32x4 wl = *(const LAS f32x4*)(cwl + 64 * k + cb), wh = *(const LAS f32x4*)(cwl + 64 * k + cb + 4);
                lo.x += wl.x * bflo(xv.x); lo.y += wl.y * bfhi(xv.x); lo.z += wl.z * bflo(xv.y); lo.w += wl.w * bfhi(xv.y);
                hi.x += wh.x * bflo(xv.z); hi.y += wh.y * bfhi(xv.z); hi.z += wh.z * bflo(xv.w); hi.w += wh.w * bfhi(xv.w);
            }
            v4u u; u.x = pk2(lo.x, lo.y); u.y = pk2(lo.z, lo.w); u.z = pk2(hi.x, hi.y); u.w = pk2(hi.z, hi.w);
            Af[ks] = __builtin_bit_cast(bf16x8, u);
            *(LAS f32x4*)(xcw + fr * XC_STRIDE + cb) = lo; *(LAS f32x4*)(xcw + fr * XC_STRIDE + cb + 4) = hi;
        }
        f32x4 accA[4], accX[4];
#pragma unroll
        for (int nt = 0; nt < 4; ++nt) { accA[nt] = (f32x4){0.f, 0.f, 0.f, 0.f}; accX[nt] = (f32x4){0.f, 0.f, 0.f, 0.f};
#pragma unroll
            for (int ks = 0; ks < 2; ++ks) { const bf16x8 Ba = *(const LAS bf16x8*)(lds + RG_BF + ((nt * 2 + ks) * 64 + lane) * 16), Bx = *(const LAS bf16x8*)(lds + RG_BF + ((8 + nt * 2 + ks) * 64 + lane) * 16);
                                             accA[nt] = __builtin_amdgcn_mfma_f32_16x16x32_bf16(Af[ks], Ba, accA[nt], 0, 0, 0);
                                             accX[nt] = __builtin_amdgcn_mfma_f32_16x16x32_bf16(Af[ks], Bx, accX[nt], 0, 0, 0); } }
        LDS_WAIT();
        float hl[4][4], pl[4][4], sg[4][4], PE[4], HE[4];
#pragma unroll
        for (int nt = 0; nt < 4; ++nt) {
            float P = 1.f, H = 0.f;
#pragma unroll
            for (int j = 0; j < 4; ++j) {
                const int row = 4 * fq + j, cc = 16 * nt + fr;
                const float xc = xcw[row * XC_STRIDE + cc];
                const unsigned short gsv = *(const LAS unsigned short*)(gs + (16 * w + row) * XS_STRIDE + cc * 2);
                sg[nt][j] = __builtin_bit_cast(float, (unsigned)gsv << 16);
                const float r = fsigmoid(accA[nt][j] + ba_[nt]), ig = fsigmoid(accX[nt][j] + bx_[nt]);
                float av = __builtin_amdgcn_exp2f(r * nsp[nt]);
                float bv = __builtin_amdgcn_sqrtf(fmaxf(fmaf(-av, av, 1.0f), 0.f)) * (ig * xc);
                if (!PACKED && c0 + 16 * w + row >= T) { av = 1.f; bv = 0.f; }
                H = fmaf(av, H, bv); P *= av; hl[nt][j] = H; pl[nt][j] = P;
            }
            float Pi = P, Hi = H;
            { const float tp = __shfl_up(Pi, 16), th = __shfl_up(Hi, 16); if (fq >= 1) { Hi = fmaf(Pi, th, Hi); Pi *= tp; } }
            { const float tp = __shfl_up(Pi, 32), th = __shfl_up(Hi, 32); if (fq >= 2) { Hi = fmaf(Pi, th, Hi); Pi *= tp; } }
            { const float tp = __shfl_up(Pi, 16), th = __shfl_up(Hi, 16); PE[nt] = fq >= 1 ? tp : 1.f; HE[nt] = fq >= 1 ? th : 0.f; }
            if (fq == 3) *(LAS f32x2*)(lds + RG_TOT + ((buf * 8 + w) * 64 + 16 * nt + fr) * 8) = (f32x2){Pi, Hi};
        }
        lds_barrier();
#pragma unroll
        for (int nt = 0; nt < 4; ++nt) {
            float cin;
            if (PACKED) {
                const f32x2 tp = *(const LAS f32x2*)(lds + RG_TOT + ((buf * 8 + (w & 6)) * 64 + 16 * nt + fr) * 8);
                const f32x2 tq = *(const LAS f32x2*)(lds + RG_TOT + ((buf * 8 + (w | 1)) * 64 + 16 * nt + fr) * 8);
                const float mid = fmaf(tp.x, hc[nt], tp.y);
                cin = (w & 1) ? mid : hc[nt];
                hc[nt] = fmaf(tq.x, mid, tq.y);
            } else {
                float run = hc[nt]; cin = 0.f;
#pragma unroll
                for (int ww = 0; ww < 8; ++ww) { const f32x2 t = *(const LAS f32x2*)(lds + RG_TOT + ((buf * 8 + ww) * 64 + 16 * nt + fr) * 8);
                    if (ww == w) cin = run; run = fmaf(t.x, run, t.y); }
                hc[nt] = run;
            }
            const float Gc = fmaf(PE[nt], cin, HE[nt]);
#pragma unroll
            for (int j = 0; j < 4; ++j) { const float hv = fmaf(pl[nt][j], Gc, hl[nt][j]); const float y = hv * sg[nt][j];
                *(LAS unsigned short*)(ysw + (4 * fq + j) * XS_STRIDE + (16 * nt + fr) * 2) = (unsigned short)(pk2(y, 0.f) & 0xffffu); }
        }
        LDS_WAIT();
        { const int row = lane >> 2, q = lane & 3, t = c0 + 16 * w + row;
          const v4u y0 = *(const LAS v4u*)(ysw + row * XS_STRIDE + q * 32), y1 = *(const LAS v4u*)(ysw + row * XS_STRIDE + q * 32 + 16);
          if (t < T && !(a.p2mask & 16)) { bf16* dst = YCAT + (size_t)(row0 + t) * 2048 + h * 64 + q * 16; *(v4u*)dst = y0; *(v4u*)(dst + 8) = y1; } }
        LDS_WAIT();
    }
    if (PACKED) { if ((w & 1) && fq == 0) {
#pragma unroll
        for (int nt = 0; nt < 4; ++nt) a.out[O_RGH_S + (size_t)(4 * sq + (w >> 1)) * 1024 + h * 64 + 16 * nt + fr] = hc[nt]; }
    } else { if (w == 0 && fq == 0 && !(a.p2mask & 32)) {
#pragma unroll
        for (int nt = 0; nt < 4; ++nt) a.out[O_RGH_P + (size_t)sq * 1024 + h * 64 + 16 * nt + fr] = hc[nt]; } }
    lds_barrier();
}

constexpr int CV_GB = 131072;
__device__ __forceinline__ void cv_unit(const Args& a, LAS unsigned char* lds, int s, int sb0, int sb1, const f32x2 (&cw)[31], f32x2 cb) {
    const int tid = threadIdx.x, lane = tid & 63, w = __builtin_amdgcn_readfirstlane(tid >> 6);
    const bf16* V = (const bf16*)(a.ws + WS_V); bf16* VN = (bf16*)(a.ws + WS_XN);
    int row0; const float* cvbuf = nullptr;
    if (s < NB) row0 = s * TP; else { const int q = s - NB; row0 = MP + q * DS; cvbuf = a.in[4] + (size_t)q * 30 * 1024; }
    unsigned win[30], cur[16], nxt[16];
    if (cvbuf) {
#pragma unroll
        for (int i = 0; i < 30; ++i) { const f32x2 f = *(const f32x2*)(cvbuf + i * 1024 + 2 * tid); win[i] = pk2(f.x, f.y); }
    } else {
#pragma unroll
        for (int i = 0; i < 30; ++i) { const int j = 16 * sb0 + i - 30; const unsigned u = *(const unsigned*)(V + (size_t)(row0 + (j < 0 ? 0 : j)) * 1024 + 2 * tid); win[i] = j < 0 ? 0u : u; }
    }
#pragma unroll
    for (int i = 0; i < 16; ++i) { cur[i] = *(const unsigned*)(V + (size_t)(row0 + 16 * sb0 + i) * 1024 + 2 * tid); nxt[i] = 0u; }
    const LAS f32x4* gl = (const LAS f32x4*)(lds + CV_GB) + lane; const LAS f32x4* bl = (const LAS f32x4*)(lds + CV_GB + 4096) + lane;
    for (int sb = sb0; sb < sb1; ++sb) {
        { const int sbn = sb + 1 < sb1 ? sb + 1 : sb;
#pragma unroll
            for (int i = 0; i < 16; ++i) nxt[i] = *(const unsigned*)(V + (size_t)(row0 + 16 * sbn + i) * 1024 + 2 * tid);
        }
        f32x2 o[16];
#pragma unroll
        for (int k = 0; k < 16; ++k) o[k] = cb;
#pragma unroll
        for (int i = 0; i < 46; ++i) {
            const unsigned u = i < 30 ? win[i] : cur[i - 30];
            const f32x2 x = (f32x2){bflo(u), bfhi(u)};
#pragma unroll
            for (int k = 0; k < 16; ++k) { const int tap = i - k; if (tap >= 0 && tap <= 30 && !(a.p2mask & 128)) o[k] = cw[tap] * x + o[k]; }
        }
        LAS float* cbuf = (LAS float*)(lds + ((sb - sb0) & 1) * 65536);
#pragma unroll
        for (int k = 0; k < 16; ++k) *(LAS f32x2*)(cbuf + k * 1024 + 2 * tid) = o[k];
#pragma unroll
        for (int i = 0; i < 14; ++i) win[i] = win[i + 16];
#pragma unroll
        for (int i = 0; i < 16; ++i) win[14 + i] = cur[i];
        lds_barrier();
#pragma unroll
        for (int rr = 0; rr < 2; ++rr) {
            const int row = 2 * w + rr;
            f32x4 v[4]; float sum = 0.f;
#pragma unroll
            for (int j = 0; j < 4; ++j) { v[j] = *(const LAS f32x4*)(cbuf + row * 1024 + 4 * lane + 256 * j); sum += (v[j].x + v[j].y) + (v[j].z + v[j].w); }
            const float mean = wave_sum(sum) * (1.f / 1024.f); float q = 0.f;
#pragma unroll
            for (int j = 0; j < 4; ++j) { v[j] = v[j] - mean; q += (v[j].x * v[j].x + v[j].y * v[j].y) + (v[j].z * v[j].z + v[j].w * v[j].w); }
            const float rstd = 1.0f / sqrtf(wave_sum(q) * (1.f / 1024.f) + EPS);
            v2u* dst = (v2u*)(VN + (size_t)(row0 + 16 * sb + row) * 1024) + lane;
#pragma unroll
            for (int j = 0; j < 4; ++j) {
                const f32x4 y = v[j] * rstd * gl[64 * j] + bl[64 * j];
                v2u ov; ov.x = pk2(fsilu(y.x), fsilu(y.y)); ov.y = pk2(fsilu(y.z), fsilu(y.w)); if (!(a.p2mask & 64)) dst[64 * j] = ov;
            }
        }
#pragma unroll
        for (int i = 0; i < 16; ++i) cur[i] = nxt[i];
    }
    lds_barrier();
}

constexpr size_t CTL_BAR = 36864;
constexpr int LDS_BARST = 143360;
#define XB_TMO      128
#define XB_XCNT(j)  (256  + 64 * (j))
#define XB_XSUB(j)  (1280 + 64 * (j))
#define XB_XGEN(j)  (2304 + 64 * (j))
#define XB_TOP      3328
#define XB_TOPGEN   3392
#define XCD_BAR_WORDS 3456
#define XB_SPIN_CAP (1u << 18)

__device__ __forceinline__ unsigned xb_ld(unsigned* p)              { return __hip_atomic_load(p, __ATOMIC_RELAXED, __HIP_MEMORY_SCOPE_AGENT); }
__device__ __forceinline__ unsigned xb_add(unsigned* p, unsigned v) { return __hip_atomic_fetch_add(p, v, __ATOMIC_RELAXED, __HIP_MEMORY_SCOPE_AGENT); }
__device__ __forceinline__ unsigned xb_xcc_id() { return (unsigned)__builtin_amdgcn_s_getreg((3 << 11) | 20) & 0xFu; }
#define XB_SPIN(cond, bar) do { unsigned _sp = 0; while (cond) { __builtin_amdgcn_s_sleep(1); \
    if ((++_sp & 255u) == 0u) { if (xb_ld(&(bar)[XB_TMO])) break; if (_sp > XB_SPIN_CAP) { atomicAdd(&(bar)[XB_TMO], 1u); break; } } } } while (0)

struct XcdBarrier {
    unsigned* bar; unsigned x;
    volatile LAS unsigned* st;
};

__device__ __forceinline__ XcdBarrier xcd_barrier_post(unsigned* bar, volatile LAS unsigned* st) {
    XcdBarrier b; b.bar = bar; b.x = xb_xcc_id(); b.st = st;
    if (threadIdx.x == 0) (void)xb_add(&bar[XB_XCNT(b.x)], 1u);
    return b;
}
__device__ __forceinline__ void xcd_barrier_complete(unsigned* bar, unsigned x, unsigned& nloc, unsigned& nx) {
    const unsigned G = gridDim.x * gridDim.y * gridDim.z;
    unsigned sum, cnt, mine, sp = 0u;
    for (;;) {
        sum = 0u; cnt = 0u; mine = 0u;
#pragma unroll
        for (unsigned j = 0; j < 16; ++j) { const unsigned c = xb_ld(&bar[XB_XCNT(j)]); sum += c; cnt += (c > 0u) ? 1u : 0u; mine = (j == x) ? c : mine; }
        if (sum == G) break;
        __builtin_amdgcn_s_sleep(1);
        if ((++sp & 255u) == 0u) { if (xb_ld(&bar[XB_TMO])) break; if (sp > XB_SPIN_CAP) { atomicAdd(&bar[XB_TMO], 1u); break; } }
    }
    nloc = mine > 0u ? mine : 1u; nx = cnt > 0u ? cnt : 1u;
}

__device__ __forceinline__ void xcd_barrier(const XcdBarrier& b) {
    asm volatile("s_waitcnt vmcnt(0)" ::: "memory");
    __syncthreads();
    if (threadIdx.x == 0) {
        unsigned* bar = b.bar;
        __builtin_amdgcn_s_waitcnt(0);
        unsigned nloc = b.st[0], nx = b.st[1];
        if (nloc == 0u) { xcd_barrier_complete(bar, b.x, nloc, nx); b.st[0] = nloc; b.st[1] = nx; }
        const unsigned old = xb_add(&bar[XB_XSUB(b.x)], 1u);
        const unsigned gen = old / nloc;
        if (old + 1u == (gen + 1u) * nloc) {
            __builtin_amdgcn_fence(__ATOMIC_RELEASE, "agent");
            asm volatile("s_waitcnt vmcnt(0)" ::: "memory");
            const unsigned og = xb_add(&bar[XB_TOP], 1u);
            const unsigned tg = og / nx;
            if (og + 1u == (tg + 1u) * nx) xb_add(&bar[XB_TOPGEN], 1u);
            else XB_SPIN(xb_ld(&bar[XB_TOPGEN]) == tg, bar);
            __builtin_amdgcn_fence(__ATOMIC_ACQUIRE, "agent");
            xb_add(&bar[XB_XGEN(b.x)], 1u);
            asm volatile("s_waitcnt vmcnt(0)" ::: "memory");
        } else {
            XB_SPIN(xb_ld(&bar[XB_XGEN(b.x)]) == gen, bar);
            __builtin_amdgcn_fence(__ATOMIC_ACQUIRE, "agent");
            asm volatile("s_waitcnt vmcnt(0)" ::: "memory");
        }
    }
    __syncthreads();
}

__global__ void __launch_bounds__(512, 2) hymba_fwd(Args args) {
    extern __shared__ __attribute__((aligned(16))) unsigned char lds_raw[];
    cg::grid_group grid = cg::this_grid();
    LAS unsigned char* lds = (LAS unsigned char*)lds_raw;
    const int tid = threadIdx.x, lane = tid & 63, wave = __builtin_amdgcn_readfirstlane(tid >> 6);
    const int G = gridDim.x, bx = blockIdx.x;
    const int vcu = (G % 8 == 0) ? (bx % 8) * (G / 8) + bx / 8 : bx;
    const int gw = vcu * 8 + wave, NGW = G * 8;
    const int lo = args.ph_lo, hi = args.ph_hi;
#define IN(k) (lo <= (k) && (k) < hi)
#define BOTH(k) (IN(k) && IN((k) + 1))
    unsigned char* ws = args.ws;
    if (tid < 2) ((volatile LAS unsigned*)(lds + LDS_BARST))[tid] = 0u;
    __syncthreads();
    const XcdBarrier bar = xcd_barrier_post((unsigned*)(ws + CTL_BAR), (volatile LAS unsigned*)(lds + LDS_BARST));
    if (args.ph_lo < 0) grid.sync();

    if (IN(0)) { p0_prologue(args, lds, gw, NGW, wave, lane); if (BOTH(0)) xcd_barrier(bar); }

    if (IN(1)) {
        pg8::Gemm g{(const bf16*)(ws + WS_XN), (const bf16*)(ws + WS_WIN), M, DIN, 1024}; pg8::StaticOrder S; S.init(M, DIN, G, bx);
        Epi1 E{(bf16*)(ws + WS_XR), (bf16*)(ws + WS_GR), (bf16*)(ws + WS_V), (bf16*)(ws + WS_GC)};
        pg8::gemm_phase<Epi1, pg8::StaticOrder, PG8_ALIGN, PG8_SP2>(lds, g, S, E);
        if (BOTH(1)) xcd_barrier(bar);
    }

    if (IN(2)) {
        __syncthreads();
        if (args.p2mask & 1) for (int it = bx; it < NB * 16; it += G) rg_item<false>(args, lds, it >> 4, it & 15);
        if (args.p2mask & 2) {
            for (int i = tid; i < 2048; i += 512) ((LAS float*)(lds + CV_GB))[i] = (i < 1024) ? args.in[17][i] : args.in[18][i - 1024];
            f32x2 cw[31];
#pragma unroll
            for (int k = 0; k < 31; ++k) cw[k] = *(const f32x2*)(args.in[15] + k * 1024 + 2 * tid);
            const f32x2 cb = *(const f32x2*)(args.in[16] + 2 * tid);
            __syncthreads();
            for (int it = bx; it < NB * 16 + DB; it += G) {
                int s, sb0, sb1;
                if (it < NB * 16) { s = it >> 4; const int j = it & 15; sb0 = j ? 8 * j + 1 : 0; sb1 = 8 * j + 9; } else { s = NB + (it - NB * 16); sb0 = 0; sb1 = 2; }
                cv_unit(args, lds, s, sb0, sb1, cw, cb);
            }
        }
        if (args.p2mask & 4) for (int it = G - 1 - bx; it < 128; it += G) rg_item<true>(args, lds, it >> 4, it & 15);
        if (args.p2mask & 8) {
            const bf16* XR = (const bf16*)(ws + WS_XR); const bf16* V = (const bf16*)(ws + WS_V);
            const int gt = vcu * 512 + tid, NGT = G * 512;
            for (int i = gt; i < NSEQ * 33 * 512; i += NGT) {
                const int c2 = i & 511, rr = (i >> 9) % 33, s = (i >> 9) / 33;
                int row0, T; float* o3; float* o30;
                if (s < NB) { row0 = s * TP; T = TP; o3 = args.out + O_RGC_P + (size_t)s * 3 * 1024; o30 = args.out + O_CVC_P + (size_t)s * 30 * 1024; }
                else { const int q = s - NB; row0 = MP + q * DS; T = DS; o3 = args.out + O_RGC_S + (size_t)q * 3 * 1024; o30 = args.out + O_CVC_S + (size_t)q * 30 * 1024; }
                if (rr < 3) { const unsigned u = *(const unsigned*)(XR + (size_t)(row0 + T - 3 + rr) * 1024 + 2 * c2); *(f32x2*)(o3 + rr * 1024 + 2 * c2) = (f32x2){bflo(u), bfhi(u)}; }
                else { const int r2 = rr - 3; const unsigned u = *(const unsigned*)(V + (size_t)(row0 + T - 30 + r2) * 1024 + 2 * c2); *(f32x2*)(o30 + r2 * 1024 + 2 * c2) = (f32x2){bflo(u), bfhi(u)}; }
            }
        }
        if (BOTH(2)) xcd_barrier(bar);
    }

    if (IN(3)) {
        pg8::Gemm g{(const bf16*)(ws + WS_XN), (const bf16*)(ws + WS_W2), M, 1024, 1024}; pg8::StaticOrder S; S.init(M, 1024, G, bx);
        Epi2 E{(bf16*)(ws + WS_YCAT), (const bf16*)(ws + WS_GC), args.in[20]};
        pg8::gemm_phase<Epi2, pg8::StaticOrder, PG8_ALIGN, PG8_SP2>(lds, g, S, E);
        if (BOTH(3)) xcd_barrier(bar);
    }

    if (IN(4)) {
        pg8::Gemm g{(const bf16*)(ws + WS_YCAT), (const bf16*)(ws + WS_WOUT), M, 1024, 2048}; OrderP4 S; S.init(M, G, vcu);
        EpiFinal E{args.in[0], args.in[1], args.out, args.in[22], (float*)(ws + CTL_SLOTS), (unsigned*)(ws + CTL_CNT), (LAS float*)(lds + 131072)};
        pg8::gemm_phase<EpiFinal, OrderP4, true, PG8_SP2>(lds, g, S, E);
    }
#undef IN
#undef BOTH
}

extern "C" void kernel_launch(void* const* d_in, const int* in_sizes, int n_in, void* d_out, int out_size, void* d_ws, size_t ws_size, hipStream_t stream) {
    static int grid = 0;
    if (grid == 0) {
        if (n_in != 23 || out_size != (int)O_END || ws_size < WS_END) { fprintf(stderr, "kernel_launch: unexpected problem (n_in %d, out %d, ws %zu; need ws >= %zu)\n", n_in, out_size, ws_size, (size_t)WS_END); grid = -1; return; }
        int dev = 0, cus = 0, per_cu = 0;
        if (hipGetDevice(&dev) != hipSuccess || hipDeviceGetAttribute(&cus, hipDeviceAttributeMultiprocessorCount, dev) != hipSuccess) { grid = -1; return; }
        if (hipFuncSetAttribute((const void*)hymba_fwd, hipFuncAttributeMaxDynamicSharedMemorySize, LDS_BYTES) != hipSuccess) { fprintf(stderr, "kernel_launch: hipFuncSetAttribute failed\n"); grid = -1; return; }
        if (hipOccupancyMaxActiveBlocksPerMultiprocessor(&per_cu, (const void*)hymba_fwd, 512, LDS_BYTES) != hipSuccess || per_cu < 1) { fprintf(stderr, "kernel_launch: occupancy query says %d\n", per_cu); per_cu = 1; }
        (void)hipGetLastError();
        grid = cus - (cus % 8);
    }
    if (grid < 0) return;
    Args a{};
    for (int i = 0; i < 23; ++i) a.in[i] = (const float*)d_in[i];
    a.out = (float*)d_out; a.ws = (unsigned char*)d_ws; a.p2mask = 15;
    void* kargs[] = {&a};
#define ZERO_CTL() (void)hipMemsetAsync(d_ws, 0, 65536, stream)
#ifdef PROBE_DBL
    const int cuts[4] = {0, PROBE_DBL + 1, PROBE_DBL + 1, 5}; const int los[3] = {0, PROBE_DBL, PROBE_DBL + 1};
    for (int li = 0; li < 3; ++li) { a.ph_lo = los[li]; a.ph_hi = cuts[li + 1]; if (a.ph_lo >= a.ph_hi) continue; ZERO_CTL();
#ifdef PROBE_P2MASK
        a.p2mask = (li == 1) ? PROBE_P2MASK : 15;
#endif
        hipError_t e = hipLaunchCooperativeKernel((const void*)hymba_fwd, dim3(grid), dim3(512), kargs, LDS_BYTES, stream);
        if (e != hipSuccess) fprintf(stderr, "kernel_launch: cooperative launch failed: %s (grid %d)\n", hipGetErrorString(e), grid); }
#else
    a.ph_lo = 0; a.ph_hi = 5; ZERO_CTL();
    hipError_t e = hipLaunchCooperativeKernel((const void*)hymba_fwd, dim3(grid), dim3(512), kargs, LDS_BYTES, stream);
    if (e != hipSuccess) fprintf(stderr, "kernel_launch: cooperative launch failed: %s (grid %d)\n", hipGetErrorString(e), grid);
#endif
}
```

```cpp
#include <hip/hip_runtime.h>
#include <hip/hip_cooperative_groups.h>
#include <cstdio>
#include <cstdint>
namespace cg = cooperative_groups;
namespace pg8 {
#define PG8_LAS __attribute__((address_space(3)))
typedef unsigned short bf16_t;
typedef short bf16x8 __attribute__((ext_vector_type(8)));
typedef float f32x4 __attribute__((ext_vector_type(4)));
typedef unsigned u32x4 __attribute__((ext_vector_type(4)));
constexpr int BM = 256, BK = 64, HALF = 128, HTB = HALF * BK * 2  , STAGE_BYTES = 8 * HTB, NXCD = 8, WGM = 8;

__host__ __device__ __forceinline__ int lds_byte(int r, int c) { const int st = (r >> 4) * 2 + (c >> 5), rr = r & 15, cc = c & 31, ob = rr * 64 + cc * 2; return st * 1024 + (ob ^ (((ob >> 9) & 1) << 5)); }
__host__ __device__ __forceinline__ void stage_rc(int b, int& R, int& C) { const int st = b / 1024, sb = b % 1024, swz = sb ^ (((sb >> 9) & 1) << 5); R = (st >> 1) * 16 + swz / 64; C = (st & 1) * 32 + (swz % 64) / 2; }
__host__ __device__ __forceinline__ int perm32(int rho) { const int n = rho >> 4, i = rho & 15; return 8 * (i >> 2) + 4 * n + (i & 3); }

struct Unit { int pm, pn; };
struct Gemm { const bf16_t* A; const bf16_t* Bt; int M, N, K, lda, ldb; };

struct StaticOrder {
    int nM, nN, nwg, G, c;
    __host__ __device__ void init(int M, int N, int G_, int c_) { nM = M / BM; nN = N / BM; nwg = nM * nN; G = G_; c = c_; }
    __host__ __device__ bool next(int i, Unit& u) const {
        const long L = (long)i * G + c; if (L >= nwg) return false;
        int wgid = (int)L; { const int q = nwg / NXCD, r = nwg % NXCD, xcd = wgid % NXCD, off = wgid / NXCD; wgid = (xcd < r ? xcd * (q + 1) : r * (q + 1) + (xcd - r) * q) + off; }
        const int nig = WGM * nN, gid = wgid / nig, fm = gid * WGM, gsz = (nM - fm) < WGM ? (nM - fm) : WGM;
        u.pm = fm + ((wgid % nig) % gsz); u.pn = (wgid % nig) / gsz; return true;
    }
    __device__ __forceinline__ void a_ready(const Unit&) const {}
    __device__ __forceinline__ void done(const Unit&) const {}
};

__device__ __forceinline__ unsigned cvt_pk_bf16(float lo, float hi) { unsigned r; asm volatile("v_cvt_pk_bf16_f32 %0, %1, %2" : "=v"(r) : "v"(lo), "v"(hi)); return r; }
template <class Epi, class Sched, bool ALIGN_EPI = false, bool SP2 = false>
__device__ __forceinline__ void gemm_phase(PG8_LAS unsigned char* lds, const Gemm g, const Sched& S, const Epi& E) {
    const int tid = threadIdx.x, wid = __builtin_amdgcn_readfirstlane(tid >> 6), lane = tid & 63, wr = wid >> 2, wc = wid & 3, fr = lane & 15, fq = lane >> 4;
    const int K = g.K, nt = K / BK;
    unsigned voffA[2], voffB[2];
#pragma unroll
    for (int i = 0; i < 2; ++i) { int R, C; stage_rc(tid * 16 + i * 8192, R, C); const int Rb = Epi::PERM ? ((R & ~31) + perm32(R & 31)) : R;
        voffA[i] = (unsigned)(R * g.lda + C) * 2u; voffB[i] = (unsigned)(Rb * g.ldb + C) * 2u; }
    const size_t kstep = (size_t)(BK * 2);
    const size_t hstepA = (size_t)HALF * g.lda * 2, hstepB = (size_t)HALF * g.ldb * 2;
    const size_t tstepA = 2 * hstepA, tstepB = 2 * hstepB;
    const unsigned ldsw = (unsigned)wid * 1024u;
    const int aoff = lds_byte(wr * 64 + fr, fq * 8), boff = lds_byte(wc * 32 + fr, fq * 8);
#define PG8_SA(b, h) (((b) * 2 + (h)) * HTB)
#define PG8_SB(b, h) ((4 + (b) * 2 + (h)) * HTB)
#define PG8_STAGE(bufoff, gbase, voff) do { _Pragma("unroll") for (int _i = 0; _i < 2; ++_i) \
        __builtin_amdgcn_global_load_lds((const unsigned*)((const char*)(gbase) + (voff)[_i]), (PG8_LAS unsigned*)(lds + (bufoff) + ldsw + _i * 8192), 16, 0, 0); } while (0)
#define PG8_LDA(dst, b, h) do { _Pragma("unroll") for (int m = 0; m < 4; ++m) _Pragma("unroll") for (int k = 0; k < 2; ++k) dst[m][k] = *(const PG8_LAS bf16x8*)(lds + PG8_SA(b, h) + aoff + m * 2048 + k * 1024); } while (0)
#define PG8_LDB(dst, b, h) do { _Pragma("unroll") for (int n = 0; n < 2; ++n) _Pragma("unroll") for (int k = 0; k < 2; ++k) dst[n][k] = *(const PG8_LAS bf16x8*)(lds + PG8_SB(b, h) + boff + n * 2048 + k * 1024); } while (0)
#define PG8_MMA(ai, bj, At, Bt) do { __builtin_amdgcn_s_setprio(1); _Pragma("unroll") for (int m = 0; m < 4; ++m) _Pragma("unroll") for (int n = 0; n < 2; ++n) _Pragma("unroll") for (int k = 0; k < 2; ++k) \
        acc[ai][bj][m][n] = __builtin_amdgcn_mfma_f32_16x16x32_bf16(Bt[n][k], At[m][k], acc[ai][bj][m][n], 0, 0, 0); __builtin_amdgcn_s_setprio(0); } while (0)
#define PG8_WAIT_V(n) asm volatile("s_waitcnt vmcnt(" #n ")" ::: "memory")
#define PG8_WAIT_L(n) asm volatile("s_waitcnt lgkmcnt(" #n ")" ::: "memory")
#define PG8_BAR __builtin_amdgcn_s_barrier()
#define PG8_SCHED __builtin_amdgcn_sched_barrier(0)
    Unit cur, nxt; int ui = 0;
    if (!S.next(0, cur)) return;
    f32x4 acc[2][2][4][2];
#pragma unroll
    for (int a = 0; a < 2; ++a)
#pragma unroll
        for (int b = 0; b < 2; ++b)
#pragma unroll
            for (int m = 0; m < 4; ++m)
#pragma unroll
                for (int n = 0; n < 2; ++n) acc[a][b][m][n] = (f32x4){0.f, 0.f, 0.f, 0.f};
    bf16x8 At[4][2], B0[2][2], B1[2][2];
    const char* cA = (const char*)g.A + (size_t)cur.pm * tstepA; const char* cB = (const char*)g.Bt + (size_t)cur.pn * tstepB;
    S.a_ready(cur);
    if constexpr (SP2) {
        PG8_STAGE(PG8_SB(0, 0), cB, voffB); PG8_STAGE(PG8_SB(0, 1), cB + hstepB, voffB); PG8_STAGE(PG8_SA(0, 0), cA, voffA); PG8_STAGE(PG8_SA(0, 1), cA + hstepA, voffA);
        if (wr == 1) PG8_BAR;
        PG8_WAIT_V(2); PG8_BAR;
        PG8_STAGE(PG8_SB(1, 0), cB + kstep, voffB); PG8_STAGE(PG8_SA(1, 0), cA + kstep, voffA); PG8_STAGE(PG8_SB(1, 1), cB + hstepB + kstep, voffB);
        PG8_WAIT_V(6); PG8_BAR;
    } else {
        PG8_STAGE(PG8_SB(0, 0), cB, voffB); PG8_STAGE(PG8_SA(0, 0), cA, voffA); PG8_STAGE(PG8_SB(0, 1), cB + hstepB, voffB); PG8_STAGE(PG8_SA(0, 1), cA + hstepA, voffA);
        if (wr == 1) PG8_BAR;
        PG8_WAIT_V(4); PG8_BAR;
        PG8_STAGE(PG8_SB(1, 0), cB + kstep, voffB); PG8_STAGE(PG8_SA(1, 0), cA + kstep, voffA); PG8_STAGE(PG8_SB(1, 1), cB + hstepB + kstep, voffB);
        PG8_WAIT_V(6); PG8_BAR;
    }
    for (;;) {
        const bool has_next = S.next(ui + 1, nxt);
        const char* nA = has_next ? (const char*)g.A + (size_t)nxt.pm * tstepA : cA; const char* nB = has_next ? (const char*)g.Bt + (size_t)nxt.pn * tstepB : cB;
        for (int t = 0; t < nt; t += 2) {
            const bool last = (t == nt - 2);
            const char* a1 = cA + (size_t)(t + 1) * kstep;
            const char* a2 = last ? nA : cA + (size_t)(t + 2) * kstep; const char* b2 = last ? nB : cB + (size_t)(t + 2) * kstep;
            const char* a3 = a2 + kstep; const char* b3 = b2 + kstep;
            if (last && has_next) S.a_ready(nxt);
            if constexpr (SP2) {
            PG8_LDB(B0, 0, 0); PG8_LDB(B1, 0, 1); PG8_SCHED; PG8_LDA(At, 0, 0); PG8_STAGE(PG8_SA(1, 1), a1 + hstepA, voffA);
            PG8_WAIT_V(8); PG8_WAIT_L(0); PG8_BAR; PG8_MMA(0, 0, At, B0); PG8_MMA(0, 1, At, B1); PG8_BAR; PG8_SCHED;
            PG8_LDA(At, 0, 1); PG8_STAGE(PG8_SB(0, 0), b2, voffB); PG8_STAGE(PG8_SB(0, 1), b2 + hstepB, voffB); PG8_STAGE(PG8_SA(0, 0), a2, voffA);
            PG8_WAIT_V(8); PG8_WAIT_L(0); PG8_BAR; PG8_MMA(1, 0, At, B0); PG8_MMA(1, 1, At, B1); PG8_BAR; PG8_SCHED;
            PG8_LDB(B0, 1, 0); PG8_LDB(B1, 1, 1); PG8_SCHED; PG8_LDA(At, 1, 0); PG8_STAGE(PG8_SA(0, 1), a2 + hstepA, voffA);
            PG8_WAIT_V(8); PG8_WAIT_L(0); PG8_BAR; PG8_MMA(0, 0, At, B0); PG8_MMA(0, 1, At, B1); PG8_BAR; PG8_SCHED;
            PG8_LDA(At, 1, 1); PG8_STAGE(PG8_SB(1, 0), b3, voffB); PG8_STAGE(PG8_SB(1, 1), b3 + hstepB, voffB); PG8_STAGE(PG8_SA(1, 0), a3, voffA);
            PG8_WAIT_V(8); PG8_WAIT_L(0); PG8_BAR; PG8_MMA(1, 0, At, B0); PG8_MMA(1, 1, At, B1); PG8_BAR; PG8_SCHED;
            } else {
            PG8_LDB(B0, 0, 0); PG8_SCHED; PG8_LDA(At, 0, 0); PG8_STAGE(PG8_SA(1, 1), a1 + hstepA, voffA);
            PG8_WAIT_L(8); PG8_BAR; PG8_WAIT_L(0); PG8_MMA(0, 0, At, B0); PG8_BAR; PG8_SCHED;
            PG8_LDB(B1, 0, 1); PG8_STAGE(PG8_SB(0, 0), b2, voffB);
            PG8_BAR; PG8_WAIT_L(0); PG8_MMA(0, 1, At, B1); PG8_BAR;
            PG8_LDA(At, 0, 1); PG8_STAGE(PG8_SA(0, 0), a2, voffA);
            PG8_BAR; PG8_WAIT_L(0); PG8_MMA(1, 0, At, B0); PG8_BAR; PG8_SCHED;
            PG8_STAGE(PG8_SB(0, 1), b2 + hstepB, voffB);
            PG8_WAIT_V(6); PG8_BAR; PG8_MMA(1, 1, At, B1); PG8_BAR;
            PG8_LDB(B0, 1, 0); PG8_SCHED; PG8_LDA(At, 1, 0); PG8_STAGE(PG8_SA(0, 1), a2 + hstepA, voffA);
            PG8_WAIT_L(8); PG8_BAR; PG8_WAIT_L(0); PG8_MMA(0, 0, At, B0); PG8_BAR; PG8_SCHED;
            PG8_LDB(B1, 1, 1); PG8_STAGE(PG8_SB(1, 0), b3, voffB);
            PG8_BAR; PG8_WAIT_L(0); PG8_MMA(0, 1, At, B1); PG8_BAR;
            PG8_LDA(At, 1, 1); PG8_STAGE(PG8_SA(1, 0), a3, voffA);
            PG8_BAR; PG8_WAIT_L(0); PG8_MMA(1, 0, At, B0); PG8_BAR; PG8_SCHED;
            PG8_STAGE(PG8_SB(1, 1), b3 + hstepB, voffB);
            PG8_WAIT_V(6); PG8_BAR; PG8_MMA(1, 1, At, B1); PG8_BAR;
            }
        }
        if constexpr (ALIGN_EPI) { if (wr == 0) PG8_BAR; }
        if constexpr (!Epi::AFTER_DRAIN) { E(acc, cur, wr, wc, fr, fq); S.done(cur); }
        if (!has_next) break;
#pragma unroll
        for (int a = 0; a < 2; ++a)
#pragma unroll
            for (int b = 0; b < 2; ++b)
#pragma unroll
                for (int m = 0; m < 4; ++m)
#pragma unroll
                    for (int n = 0; n < 2; ++n) acc[a][b][m][n] = (f32x4){0.f, 0.f, 0.f, 0.f};
        cur = nxt; cA = nA; cB = nB; ++ui;
        if constexpr (ALIGN_EPI) { if (wr == 1) PG8_BAR; }
    }
    PG8_WAIT_V(0);
    if constexpr (!ALIGN_EPI) { if (wr == 0) PG8_BAR; }
    PG8_BAR;
    if constexpr (Epi::AFTER_DRAIN) { E.fused(acc, cur, wr, wc, fr, fq, lds, wid, lane); S.done(cur); }
#undef PG8_SA
#undef PG8_SB
#undef PG8_STAGE
#undef PG8_LDA
#undef PG8_LDB
#undef PG8_MMA
#undef PG8_WAIT_V
#undef PG8_WAIT_L
#undef PG8_BAR
#undef PG8_SCHED
}
}

#ifndef PG8_SP2
#define PG8_SP2 true
#endif
#ifndef PG8_ALIGN
#define PG8_ALIGN true
#endif

constexpr int DM = 1024, NB = 16, SEQ = 2048, NMETA = 16, TP = SEQ + NMETA;
constexpr int DB = 32, DS = 32;
constexpr int MP = NB * TP, MS = DB * DS, M = MP + MS;
constexpr int DIN = 5120, DMIX = 2048;
constexpr int NSEQ = NB + DB;
constexpr float EPS = 1e-6f;
static_assert(M % 256 == 0, "M tiles");

constexpr size_t MiB = 1u << 20;
constexpr size_t ACT = (size_t)M * 1024 * 2;
constexpr size_t WS_WIN = 1 * MiB, WS_W2 = 11 * MiB, WS_WOUT = 13 * MiB;
constexpr size_t WS_XN = 20 * MiB;
constexpr size_t WS_XR = WS_XN + ACT, WS_GR = WS_XR + ACT, WS_V = WS_GR + ACT, WS_GC = WS_V + ACT, WS_YCAT = WS_GC + ACT;
constexpr size_t WS_END = WS_YCAT + 2 * ACT;
constexpr size_t WS_PART = WS_XR;

constexpr size_t O_YP = 0, O_YS = (size_t)NB * SEQ * DM, O_RGH_P = O_YS + (size_t)MS * DM, O_RGC_P = O_RGH_P + NB * 1024,
                 O_CVC_P = O_RGC_P + NB * 3 * 1024, O_RGH_S = O_CVC_P + NB * 30 * 1024, O_RGC_S = O_RGH_S + DB * 1024,
                 O_CVC_S = O_RGC_S + DB * 3 * 1024, O_END = O_CVC_S + DB * 30 * 1024;

constexpr int LDS_BYTES = 147456;

#define GAS __attribute__((address_space(1)))
#define LAS __attribute__((address_space(3)))
typedef unsigned short bf16;
typedef unsigned v4u __attribute__((ext_vector_type(4)));
typedef unsigned v2u __attribute__((ext_vector_type(2)));
typedef float f32x4 __attribute__((ext_vector_type(4)));
typedef float f32x2 __attribute__((ext_vector_type(2)));
typedef short bf16x8 __attribute__((ext_vector_type(8)));
#define LDS_WAIT() asm volatile("s_waitcnt lgkmcnt(0)" ::: "memory")
__device__ __forceinline__ void lds_barrier() { asm volatile("s_waitcnt lgkmcnt(0)\n\ts_barrier" ::: "memory"); }

__device__ __forceinline__ unsigned pk2(float lo, float hi) { return pg8::cvt_pk_bf16(lo, hi); }
__device__ __forceinline__ float bflo(unsigned u) { return __builtin_bit_cast(float, u << 16); }
__device__ __forceinline__ float bfhi(unsigned u) { return __builtin_bit_cast(float, u & 0xffff0000u); }
__device__ __forceinline__ float fsigmoid(float x) { return __builtin_amdgcn_rcpf(1.0f + __builtin_amdgcn_exp2f(-1.4426950408889634f * x)); }
__device__ __forceinline__ float fsilu(float x) { return x * fsigmoid(x); }
__device__ __forceinline__ float wave_sum(float v) {
    v += __builtin_bit_cast(float, __builtin_amdgcn_update_dpp(0, __builtin_bit_cast(int, v), 0xB1, 0xf, 0xf, true));
    v += __builtin_bit_cast(float, __builtin_amdgcn_update_dpp(0, __builtin_bit_cast(int, v), 0x4E, 0xf, 0xf, true));
    v += __builtin_bit_cast(float, __builtin_amdgcn_update_dpp(0, __builtin_bit_cast(int, v), 0x141, 0xf, 0xf, true));
    v += __builtin_bit_cast(float, __builtin_amdgcn_update_dpp(0, __builtin_bit_cast(int, v), 0x140, 0xf, 0xf, true));
    const int iv = __builtin_bit_cast(int, v);
    const float r0 = __builtin_bit_cast(float, __builtin_amdgcn_readlane(iv, 0)), r1 = __builtin_bit_cast(float, __builtin_amdgcn_readlane(iv, 16));
    const float r2 = __builtin_bit_cast(float, __builtin_amdgcn_readlane(iv, 32)), r3 = __builtin_bit_cast(float, __builtin_amdgcn_readlane(iv, 48));
    return (r0 + r1) + (r2 + r3);
}

struct Args { const float* in[23]; float* out; unsigned char* ws; int ph_lo, ph_hi, p2mask, pad; };

struct Epi1 {
    static constexpr bool PERM = true, AFTER_DRAIN = false;
    bf16 *XR, *GR, *V, *GC;
    __device__ __forceinline__ void operator()(const pg8::f32x4 (&acc)[2][2][4][2], const pg8::Unit& u, int wr, int wc, int fr, int fq) const {
        const int row0 = u.pm * 256 + wr * 64 + fr; const int pn = u.pn;
        if (pn >= 8 && pn < 16) {
            const int col0 = 128 * (pn - 8) + wc * 32 + 8 * fq;
#pragma unroll
            for (int ai = 0; ai < 2; ++ai)
#pragma unroll
                for (int m = 0; m < 4; ++m) {
                    float o[8];
#pragma unroll
                    for (int n = 0; n < 2; ++n)
#pragma unroll
                        for (int e = 0; e < 4; ++e) o[4 * n + e] = acc[ai][0][m][n][e] * fsigmoid(acc[ai][1][m][n][e]);
                    v4u w; w.x = pk2(o[0], o[1]); w.y = pk2(o[2], o[3]); w.z = pk2(o[4], o[5]); w.w = pk2(o[6], o[7]);
                    *(v4u*)(V + (size_t)(row0 + ai * 128 + m * 16) * 1024 + col0) = w;
                }
        } else {
            bf16* base; int colt; bool act;
            if (pn < 4) { base = XR; colt = pn * 256; act = false; }
            else if (pn < 8) { base = GR; colt = (pn - 4) * 256; act = true; }
            else { base = GC; colt = (pn - 16) * 256; act = true; }
            const int col0 = colt + wc * 32 + 8 * fq;
#pragma unroll
            for (int ai = 0; ai < 2; ++ai)
#pragma unroll
                for (int m = 0; m < 4; ++m) {
                    bf16* rowp = base + (size_t)(row0 + ai * 128 + m * 16) * 1024 + col0;
#pragma unroll
                    for (int bj = 0; bj < 2; ++bj) {
                        float o[8];
#pragma unroll
                        for (int n = 0; n < 2; ++n)
#pragma unroll
                            for (int e = 0; e < 4; ++e) { const float x = acc[ai][bj][m][n][e]; o[4 * n + e] = act ? fsilu(x) : x; }
                        v4u w; w.x = pk2(o[0], o[1]); w.y = pk2(o[2], o[3]); w.z = pk2(o[4], o[5]); w.w = pk2(o[6], o[7]);
                        *(v4u*)(rowp + bj * 128) = w;
                    }
                }
        }
    }
};
struct Epi2 {
    static constexpr bool PERM = true, AFTER_DRAIN = false;
    bf16* YCAT; const bf16* GC; const float* bias;
    __device__ __forceinline__ void operator()(const pg8::f32x4 (&acc)[2][2][4][2], const pg8::Unit& u, int wr, int wc, int fr, int fq) const {
        const int row0 = u.pm * 256 + wr * 64 + fr, col0 = u.pn * 256 + wc * 32 + 8 * fq;
        f32x4 bv[2][2];
#pragma unroll
        for (int bj = 0; bj < 2; ++bj)
#pragma unroll
            for (int n = 0; n < 2; ++n) bv[bj][n] = *(const f32x4*)(bias + col0 + bj * 128 + 4 * n);
#pragma unroll
        for (int ai = 0; ai < 2; ++ai)
#pragma unroll
            for (int m = 0; m < 4; ++m) {
                const size_t r = (size_t)(row0 + ai * 128 + m * 16);
#pragma unroll
                for (int bj = 0; bj < 2; ++bj) {
                    const v4u g = *(const v4u*)(GC + r * 1024 + col0 + bj * 128);
                    const f32x4 v0 = acc[ai][bj][m][0] + bv[bj][0], v1 = acc[ai][bj][m][1] + bv[bj][1];
                    v4u w; w.x = pk2(v0[0] * bflo(g.x), v0[1] * bfhi(g.x)); w.y = pk2(v0[2] * bflo(g.y), v0[3] * bfhi(g.y));
                    w.z = pk2(v1[0] * bflo(g.z), v1[1] * bfhi(g.z)); w.w = pk2(v1[2] * bflo(g.w), v1[3] * bfhi(g.w));
                    *(v4u*)(YCAT + r * 2048 + 1024 + col0 + bj * 128) = w;
                }
            }
    }
};
struct Epi3 {
    static constexpr bool PERM = false, AFTER_DRAIN = false;
    float* C;
    __device__ __forceinline__ void operator()(const pg8::f32x4 (&acc)[2][2][4][2], const pg8::Unit& u, int wr, int wc, int fr, int fq) const {
        const int row0 = u.pm * 256 + wr * 64 + fr, col0 = u.pn * 256 + wc * 32 + 4 * fq;
#pragma unroll
        for (int ai = 0; ai < 2; ++ai)
#pragma unroll
            for (int m = 0; m < 4; ++m) { float* rowp = C + (size_t)(row0 + ai * 128 + m * 16) * 1024 + col0;
#pragma unroll
                for (int bj = 0; bj < 2; ++bj)
#pragma unroll
                    for (int n = 0; n < 2; ++n) *(f32x4*)(rowp + bj * 128 + n * 16) = acc[ai][bj][m][n]; }
    }
};

constexpr size_t CTL_CNT = 0, CTL_SLOTS = 65536, CTL_BF = 655360, CTL_NSP = 917504;
struct OrderP4 {
    int nwg, G, c;
    __device__ void init(int M_, int G_, int c_) { nwg = (M_ / 256) * 4; G = G_; c = c_; }
    __device__ bool next(int i, pg8::Unit& u) const { const int L = i * G + c; if (L >= nwg) return false; u.pm = L >> 2; u.pn = L & 3; return true; }
    __device__ __forceinline__ void a_ready(const pg8::Unit&) const {}
    __device__ __forceinline__ void done(const pg8::Unit&) const {}
};
struct TailOrder {
    int j;
    __device__ bool next(int i, pg8::Unit& u) const { if (i != 0 || j < 0 || j >= 20) return false; u.pm = 128 + (j >> 2); u.pn = j & 3; return true; }
    __device__ __forceinline__ void a_ready(const pg8::Unit&) const {}
    __device__ __forceinline__ void done(const pg8::Unit&) const {}
};
struct EpiFinal {
    static constexpr bool PERM = false, AFTER_DRAIN = false;
    const float* xp; const float* xs; float* out; const float* g; float* slots; unsigned* cnt; LAS float* scr;
    const float* part;
    __device__ __forceinline__ void operator()(pg8::f32x4 (&acc)[2][2][4][2], const pg8::Unit& u, int wr, int wc, int fr, int fq) const {
        const int tid = threadIdx.x, lane = tid & 63, wid = __builtin_amdgcn_readfirstlane(tid >> 6);
        if (part) {
            const float* pb = part + (size_t)(u.pm * 256 + wr * 64 + fr) * 1024 + u.pn * 256 + wc * 32 + 4 * fq;
#pragma unroll
            for (int ai = 0; ai < 2; ++ai)
#pragma unroll
                for (int m = 0; m < 4; ++m) {
#pragma unroll
                    for (int bj = 0; bj < 2; ++bj)
#pragma unroll
                        for (int n = 0; n < 2; ++n) acc[ai][bj][m][n] += *(const f32x4*)(pb + (size_t)(ai * 128 + m * 16) * 1024 + bj * 128 + n * 16);
                    asm volatile("" ::: "memory");
                }
        }
        LAS float* P = scr; LAS float* S = scr + 1024;
#pragma unroll
        for (int ai = 0; ai < 2; ++ai)
#pragma unroll
            for (int m = 0; m < 4; ++m) {
                float s = 0.f;
#pragma unroll
                for (int bj = 0; bj < 2; ++bj)
#pragma unroll
                    for (int n = 0; n < 2; ++n) { const pg8::f32x4 x = acc[ai][bj][m][n]; s += (x[0] * x[0] + x[1] * x[1]) + (x[2] * x[2] + x[3] * x[3]); }
                s += __shfl_xor(s, 16); s += __shfl_xor(s, 32);
                if (fq == 0) P[(ai * 128 + wr * 64 + m * 16 + fr) * 4 + wc] = s;
            }
        asm volatile("s_waitcnt lgkmcnt(0)" ::: "memory"); __builtin_amdgcn_s_barrier(); asm volatile("" ::: "memory");
        if (tid < 256) { const f32x4 p = *(const LAS f32x4*)(P + tid * 4);
            __hip_atomic_store(slots + ((size_t)(u.pm * 256 + tid) * 4 + u.pn), (p.x + p.y) + (p.z + p.w), __ATOMIC_RELAXED, __HIP_MEMORY_SCOPE_AGENT); }
        asm volatile("s_waitcnt vmcnt(0)" ::: "memory");
        if (wid < 4 && lane == 0) __hip_atomic_fetch_add(cnt + 64 * u.pm, 1u, __ATOMIC_RELAXED, __HIP_MEMORY_SCOPE_AGENT);
        if (wid == 0) {
            unsigned spins = 0;
            while ((unsigned)__builtin_amdgcn_readfirstlane(__hip_atomic_load(cnt + 64 * u.pm, __ATOMIC_RELAXED, __HIP_MEMORY_SCOPE_AGENT)) < 16u) { __builtin_amdgcn_s_sleep(2); if (++spins > (1u << 22)) break; }
            __builtin_amdgcn_fence(__ATOMIC_ACQUIRE, "agent");
        }
        asm volatile("s_waitcnt vmcnt(0) lgkmcnt(0)" ::: "memory"); __builtin_amdgcn_s_barrier(); asm volatile("" ::: "memory");
        if (tid < 256) { const float* sl = slots + (size_t)(u.pm * 256 + tid) * 4; float t = 0.f;
#pragma unroll
            for (int q = 0; q < 4; ++q) t += __hip_atomic_load(sl + q, __ATOMIC_RELAXED, __HIP_MEMORY_SCOPE_AGENT);
            S[tid] = 1.0f / sqrtf(t * (1.f / 1024.f) + EPS); }
        asm volatile("s_waitcnt lgkmcnt(0)" ::: "memory"); __builtin_amdgcn_s_barrier(); asm volatile("" ::: "memory");
        const int col0 = u.pn * 256 + wc * 32 + 4 * fq;
        f32x4 gv[2][2];
#pragma unroll
        for (int bj = 0; bj < 2; ++bj)
#pragma unroll
            for (int n = 0; n < 2; ++n) gv[bj][n] = *(const f32x4*)(g + col0 + bj * 128 + n * 16);
#pragma unroll
        for (int ai = 0; ai < 2; ++ai)
#pragma unroll
            for (int m = 0; m < 4; ++m) {
                const int rl = ai * 128 + wr * 64 + m * 16 + fr, r = u.pm * 256 + rl; const float rs = S[rl];
                const float* xrow; float* orow; bool ok = true;
                if (r < MP) { const int b = r / TP, t = r - b * TP; ok = t >= NMETA; const size_t o = ((size_t)b * SEQ + (ok ? t - NMETA : 0)) * DM; xrow = xp + o; orow = out + O_YP + o; }
                else { const size_t o = (size_t)(r - MP) * DM; xrow = xs + o; orow = out + O_YS + o; }
                if (ok) {
#pragma unroll
                    for (int bj = 0; bj < 2; ++bj)
#pragma unroll
                        for (int n = 0; n < 2; ++n) { const f32x4 xv = *(const f32x4*)(xrow + col0 + bj * 128 + n * 16);
                            *(f32x4*)(orow + col0 + bj * 128 + n * 16) = xv + acc[ai][bj][m][n] * rs * gv[bj][n]; }
                }
                asm volatile("" ::: "memory");
            }
    }
};

__device__ __forceinline__ void p0_transpose_item(const float* W, int K, int N, bf16* WT, int k0, int n0, int dst_row0, LAS float* scr, int lane) {
#pragma unroll 8
    for (int i = 0; i < 32; ++i) { const int kk = 2 * i + (lane >> 5); scr[kk * 33 + (lane & 31)] = W[(size_t)(k0 + kk) * N + n0 + (lane & 31)]; }
    LDS_WAIT();
    const int c = lane & 7;
#pragma unroll
    for (int j = 0; j < 4; ++j) { const int n = (lane >> 3) + 8 * j; const LAS float* s = scr + (8 * c) * 33 + n;
        v4u o; o.x = pk2(s[0 * 33], s[1 * 33]); o.y = pk2(s[2 * 33], s[3 * 33]); o.z = pk2(s[4 * 33], s[5 * 33]); o.w = pk2(s[6 * 33], s[7 * 33]);
        *(v4u*)(WT + (size_t)(dst_row0 + n) * K + k0 + 8 * c) = o; }
    LDS_WAIT();
}
__device__ __forceinline__ int win_dst_row(int n) {
    if (n < 2048 || n >= 4096) return n;
    if (n < 3072) { const int c = n - 2048; return 2048 + 256 * (c >> 7) + (c & 127); }
    const int c = n - 3072; return 2048 + 256 * (c >> 7) + 128 + (c & 127);
}
__device__ __forceinline__ const float* x_row_ptr(const float* xp, const float* xs, const float* meta, int r) {
    if (r < MP) { const int b = r / TP, t = r - b * TP; return t < NMETA ? meta + (size_t)t * DM : xp + ((size_t)b * SEQ + (t - NMETA)) * DM; }
    return xs + (size_t)(r - MP) * DM;
}
__device__ __forceinline__ void p0_prologue(const Args& a, LAS unsigned char* lds, int gw, int NGW, int wave, int lane) {
    LAS float* scr = (LAS float*)(lds + wave * 16384);
    constexpr int I_IN = 16 * 160, I_W2 = 16 * 32, I_WO = 32 * 32;
    bf16* WinT = (bf16*)(a.ws + WS_WIN); bf16* W2T = (bf16*)(a.ws + WS_W2); bf16* WoT = (bf16*)(a.ws + WS_WOUT);
    for (int it = gw; it < I_IN + I_W2 + I_WO; it += NGW) {
        int r = it;
        if (r < I_IN) { const int kb = r / 160, nb = r % 160; p0_transpose_item(a.in[7], 1024, DIN, WinT, 64 * kb, 32 * nb, win_dst_row(32 * nb), scr, lane); continue; } r -= I_IN;
        if (r < I_W2) { const int kb = r / 32, nb = r % 32; p0_transpose_item(a.in[19], 1024, 1024, W2T, 64 * kb, 32 * nb, 32 * nb, scr, lane); continue; } r -= I_W2;
        { const int kb = r / 32, nb = r % 32; p0_transpose_item(a.in[21], 2048, 1024, WoT, 64 * kb, 32 * nb, 32 * nb, scr, lane); }
    }
    if (gw < 133) { if (lane == 0) *((unsigned*)(a.ws + CTL_CNT) + 64 * gw) = 0u; }
    {
        bf16* BF = (bf16*)(a.ws + CTL_BF); float* NSP = (float*)(a.ws + CTL_NSP);
        for (int i = gw * 64 + lane; i < 2 * 16 * 4096; i += NGW * 64) {
            const int mat = i >> 16, r = i & 65535, h = r >> 12, k = (r >> 6) & 63, n = r & 63;
            const float v = (mat ? a.in[12] : a.in[10])[r];
            const int f = mat * 8 + (n >> 4) * 2 + (k >> 5), ln = ((k & 31) >> 3) * 16 + (n & 15), e = k & 7;
            BF[((size_t)(h * 16 + f) * 64 + ln) * 8 + e] = (bf16)(pk2(v, 0.f) & 0xffffu);
        }
        for (int c = gw * 64 + lane; c < 1024; c += NGW * 64) { const float x = -a.in[14][c]; const float sp = fmaxf(x, 0.f) + log1pf(expf(-fabsf(x))); NSP[c] = -8.0f * sp * 1.4426950408889634f; }
    }
    bf16* XN = (bf16*)(a.ws + WS_XN);
    const f32x4* gp = (const f32x4*)a.in[6] + lane;
    f32x4 g[4];
#pragma unroll
    for (int j = 0; j < 4; ++j) g[j] = gp[64 * j];
    for (int r = gw; r < M; r += NGW) {
        const f32x4* xr = (const f32x4*)x_row_ptr(a.in[0], a.in[1], a.in[5], r) + lane;
        f32x4 v[4]; float s = 0.f;
#pragma unroll
        for (int j = 0; j < 4; ++j) { v[j] = xr[64 * j]; s += (v[j].x * v[j].x + v[j].y * v[j].y) + (v[j].z * v[j].z + v[j].w * v[j].w); }
        const float rstd = 1.0f / sqrtf(wave_sum(s) * (1.f / DM) + EPS);
        v2u* o8 = (v2u*)(XN + (size_t)r * DM) + lane;
#pragma unroll
        for (int j = 0; j < 4; ++j) { v2u o; o.x = pk2(v[j].x * rstd * g[j].x, v[j].y * rstd * g[j].y); o.y = pk2(v[j].z * rstd * g[j].z, v[j].w * rstd * g[j].w); o8[64 * j] = o; }
    }
}

constexpr int RG_XS0 = 0, RG_XS_SZ = 20160, RG_GS0 = 40320, RG_GS_SZ = 18432, RG_XC = 77184, RG_TOT = 112000, RG_CW = 120192, RG_BF = 121472;
constexpr int XS_STRIDE = 144, XC_STRIDE = 68;

template <bool PACKED>
__device__ __forceinline__ void rg_prefetch(v4u (&px)[3], v4u (&pg)[2], const bf16* XR, const bf16* GR, const float* rgbuf, int row0, int T, int h, int c0, int tid) {
#pragma unroll
    for (int j = 0; j < 3; ++j) {
        const int idx = tid + 512 * j, row = idx >> 3, seg = idx & 7;
        int t;
        if (PACKED) { const int rc = row < 140 ? row : 139; const int q = rc / 35; t = 32 * q + (rc - 35 * q - 3 >= 0 ? rc - 35 * q - 3 : 0); }
        else { t = c0 - 3 + row; t = t < 0 ? 0 : (t > T - 1 ? T - 1 : t); }
        px[j] = *(const v4u*)(XR + (size_t)(row0 + t) * 1024 + h * 64 + seg * 8);
    }
#pragma unroll
    for (int j = 0; j < 2; ++j) {
        const int idx = tid + 512 * j, row = idx >> 3, seg = idx & 7; int t = c0 + row; t = t > T - 1 ? T - 1 : t;
        pg[j] = *(const v4u*)(GR + (size_t)(row0 + t) * 1024 + h * 64 + seg * 8);
    }
}
template <bool PACKED>
__device__ __forceinline__ void rg_stage(LAS unsigned char* lds, int buf, const v4u (&px)[3], const v4u (&pg)[2], const float* rgbuf, int T, int h, int c0, int tid) {
    const v4u z = (v4u){0u, 0u, 0u, 0u};
#pragma unroll
    for (int j = 0; j < 3; ++j) { const int idx = tid + 512 * j, row = idx >> 3, seg = idx & 7;
        v4u v = px[j];
        if (PACKED) {
            if (row < 140) { const int q = row / 35, t = row - 35 * q - 3;
                if (t < 0) { const f32x4* p = (const f32x4*)(rgbuf + (size_t)q * 3072 + (3 + t) * 1024 + h * 64 + seg * 8); const f32x4 a = p[0], b = p[1];
                    v.x = pk2(a.x, a.y); v.y = pk2(a.z, a.w); v.z = pk2(b.x, b.y); v.w = pk2(b.z, b.w); } }
        } else { const int t = c0 - 3 + row; v = (t >= 0 && t < T) ? v : z; }
        if (row < 140) *(LAS v4u*)(lds + RG_XS0 + buf * RG_XS_SZ + row * XS_STRIDE + seg * 16) = v; }
#pragma unroll
    for (int j = 0; j < 2; ++j) { const int idx = tid + 512 * j, row = idx >> 3, seg = idx & 7; const v4u v = (c0 + row < T) ? pg[j] : z;
        *(LAS v4u*)(lds + RG_GS0 + buf * RG_GS_SZ + row * XS_STRIDE + seg * 16) = v; }
}

template <bool PACKED>
__device__ __forceinline__ void rg_item(const Args& a, LAS unsigned char* lds, int sq, int h) {
    const int tid = threadIdx.x, lane = tid & 63, w = __builtin_amdgcn_readfirstlane(tid >> 6), fr = lane & 15, fq = lane >> 4;
    const bf16* XR = (const bf16*)(a.ws + WS_XR); const bf16* GR = (const bf16*)(a.ws + WS_GR); bf16* YCAT = (bf16*)(a.ws + WS_YCAT);
    const int row0 = PACKED ? MP + 128 * sq : sq * TP, T = PACKED ? 128 : TP, nch = PACKED ? 1 : (TP + 127) / 128;
    const float* rgbuf = PACKED ? a.in[3] + (size_t)(4 * sq) * 3072 : nullptr;
    LAS float* cwl = (LAS float*)(lds + RG_CW);
    if (tid < 320) { const int k = tid >> 6, c = tid & 63; cwl[tid] = (k < 4) ? a.in[8][k * 1024 + h * 64 + c] : a.in[9][h * 64 + c]; }
    { const v4u* src = (const v4u*)(a.ws + CTL_BF + (size_t)h * 16384) + tid * 2; LAS v4u* dst = (LAS v4u*)(lds + RG_BF) + tid * 2; dst[0] = src[0]; dst[1] = src[1]; }
    float ba_[4], bx_[4], nsp[4], hc[4];
#pragma unroll
    for (int nt = 0; nt < 4; ++nt) { const int c = h * 64 + 16 * nt + fr; ba_[nt] = a.in[11][c]; bx_[nt] = a.in[13][c]; nsp[nt] = ((const float*)(a.ws + CTL_NSP))[c];
        hc[nt] = PACKED ? a.in[2][(size_t)(4 * sq + (w >> 1)) * 1024 + c] : 0.f; }
    const int xrow_base = PACKED ? 35 * (w >> 1) + 16 * (w & 1) : 16 * w;

    v4u px[3], pg[2];
    rg_prefetch<PACKED>(px, pg, XR, GR, rgbuf, row0, T, h, 0, tid);
    rg_stage<PACKED>(lds, 0, px, pg, rgbuf, T, h, 0, tid);
    if (nch > 1) { rg_prefetch<PACKED>(px, pg, XR, GR, rgbuf, row0, T, h, 128, tid); rg_stage<PACKED>(lds, 1, px, pg, rgbuf, T, h, 128, tid); }
    lds_barrier();
    LAS float* xcw = (LAS float*)(lds + RG_XC + w * (16 * XC_STRIDE * 4));
    LAS unsigned char* ysw = (LAS unsigned char*)xcw;
    for (int ch = 0; ch < nch; ++ch) {
        const int c0 = ch * 128, buf = ch & 1;
        if (ch + 2 < nch) rg_prefetch<PACKED>(px, pg, XR, GR, rgbuf, row0, T, h, c0 + 256, tid);
        const LAS unsigned char* xs = lds + RG_XS0 + buf * RG_XS_SZ; const LAS unsigned char* gs = lds + RG_GS0 + buf * RG_GS_SZ;
        bf16x8 Af[2];
#pragma unroll
        for (int ks = 0; ks < 2; ++ks) {
            const int cb = 32 * ks + 8 * fq;
            f32x4 lo = *(const LAS f32x4*)(cwl + 256 + cb), hi = *(const LAS f32x4*)(cwl + 256 + cb + 4);
#pragma unroll
            for (int k = 0; k < 4; ++k) {
                const v4u xv = *(const LAS v4u*)(xs + (xrow_base + fr + k) * XS_STRIDE + cb * 2);
                const f32x4 wl = *(const LAS f32x4*)(cwl + 64 * k + cb), wh = *(const LAS f32x4*)(cwl + 64 * k + cb + 4);
                lo.x += wl.x * bflo(xv.x); lo.y += wl.y * bfhi(xv.x); lo.z += wl.z * bflo(xv.y); lo.w += wl.w * bfhi(xv.y);
                hi.x += wh.x * bflo(xv.z); hi.y += wh.y * bfhi(xv.z); hi.z += wh.z * bflo(xv.w); hi.w += wh.w * bfhi(xv.w);
            }
            v4u u; u.x = pk2(lo.x, lo.y); u.y = pk2(lo.z, lo.w); u.z = pk2(hi.x, hi.y); u.w = pk2(hi.z, hi.w);
            Af[ks] = __builtin_bit_cast(bf16x8, u);
            *(LAS f32x4*)(xcw + fr * XC_STRIDE + cb) = lo; *(LAS f32x4*)(xcw + fr * XC_STRIDE + cb + 4) = hi;
        }
        f32x4 accA[4], accX[4];
#pragma unroll
        for (int nt = 0; nt < 4; ++nt) { accA[nt] = (f32x4){0.f, 0.f, 0.f, 0.f}; accX[nt] = (f32x4){0.f, 0.f, 0.f, 0.f};
#pragma unroll
            for (int ks = 0; ks < 2; ++ks) { const bf16x8 Ba = *(const LAS bf16x8*)(lds + RG_BF + ((nt * 2 + ks) * 64 + lane) * 16), Bx = *(const LAS bf16x8*)(lds + RG_BF + ((8 + nt * 2 + ks) * 64 + lane) * 16);
                                             accA[nt] = __builtin_amdgcn_mfma_f32_16x16x32_bf16(Af[ks], Ba, accA[nt], 0, 0, 0);
                                             accX[nt] = __builtin_amdgcn_mfma_f32_16x16x32_bf16(Af[ks], Bx, accX[nt], 0, 0, 0); } }
        LDS_WAIT();
        float hl[4][4], pl[4][4], sg[4][4], PE[4], HE[4];
#pragma unroll
        for (int nt = 0; nt < 4; ++nt) {
            float P = 1.f, H = 0.f;
#pragma unroll
            for (int j = 0; j < 4; ++j) {
                const int row = 4 * fq + j, cc = 16 * nt + fr;
                const float xc = xcw[row * XC_STRIDE + cc];
                const unsigned short gsv = *(const LAS unsigned short*)(gs + (16 * w + row) * XS_STRIDE + cc * 2);
                sg[nt][j] = __builtin_bit_cast(float, (unsigned)gsv << 16);
                const float r = fsigmoid(accA[nt][j] + ba_[nt]), ig = fsigmoid(accX[nt][j] + bx_[nt]);
                float av = __builtin_amdgcn_exp2f(r * nsp[nt]);
                float bv = __builtin_amdgcn_sqrtf(fmaxf(fmaf(-av, av, 1.0f), 0.f)) * (ig * xc);
                if (!PACKED && c0 + 16 * w + row >= T) { av = 1.f; bv = 0.f; }
                H = fmaf(av, H, bv); P *= av; hl[nt][j] = H; pl[nt][j] = P;
            }
            float Pi = P, Hi = H;
            { const float tp = __shfl_up(Pi, 16), th = __shfl_up(Hi, 16); if (fq >= 1) { Hi = fmaf(Pi, th, Hi); Pi *= tp; } }
            { const float tp = __shfl_up(Pi, 32), th = __shfl_up(Hi, 32); if (fq >= 2) { Hi = fmaf(Pi, th, Hi); Pi *= tp; } }
            { const float tp = __shfl_up(Pi, 16), th = __shfl_up(Hi, 16); PE[nt] = fq >= 1 ? tp : 1.f; HE[nt] = fq >= 1 ? th : 0.f; }
            if (fq == 3) *(LAS f32x2*)(lds + RG_TOT + ((buf * 8 + w) * 64 + 16 * nt + fr) * 8) = (f32x2){Pi, Hi};
        }
        lds_barrier();
#pragma unroll
        for (int nt = 0; nt < 4; ++nt) {
            float cin;
            if (PACKED) {
                const f32x2 tp = *(const LAS f32x2*)(lds + RG_TOT + ((buf * 8 + (w & 6)) * 64 + 16 * nt + fr) * 8);
                const f32x2 tq = *(const LAS f32x2*)(lds + RG_TOT + ((buf * 8 + (w | 1)) * 64 + 16 * nt + fr) * 8);
                const float mid = fmaf(tp.x, hc[nt], tp.y);
                cin = (w & 1) ? mid : hc[nt];
                hc[nt] = fmaf(tq.x, mid, tq.y);
            } else {
                float run = hc[nt]; cin = 0.f;
#pragma unroll
                for (int ww = 0; ww < 8; ++ww) { const f32x2 t = *(const LAS f32x2*)(lds + RG_TOT + ((buf * 8 + ww) * 64 + 16 * nt + fr) * 8);
                    if (ww == w) cin = run; run = fmaf(t.x, run, t.y); }
                hc[nt] = run;
            }
            const float Gc = fmaf(PE[nt], cin, HE[nt]);
#pragma unroll
            for (int j = 0; j < 4; ++j) { const float hv = fmaf(pl[nt][j], Gc, hl[nt][j]); const float y = hv * sg[nt][j];
                *(LAS unsigned short*)(ysw + (4 * fq + j) * XS_STRIDE + (16 * nt + fr) * 2) = (unsigned short)(pk2(y, 0.f) & 0xffffu); }
        }
        LDS_WAIT();
        { const int row = lane >> 2, q = lane & 3, t = c0 + 16 * w + row;
          const v4u y0 = *(const LAS v4u*)(ysw + row * XS_STRIDE + q * 32), y1 = *(const LAS v4u*)(ysw + row * XS_STRIDE + q * 32 + 16);
          LDS_WAIT();
          if (ch + 2 < nch) { asm volatile("s_waitcnt vmcnt(0)" ::: "memory"); rg_stage<PACKED>(lds, buf, px, pg, rgbuf, T, h, c0 + 256, tid); asm volatile("" ::: "memory"); }
          if (t < T) { bf16* dst = YCAT + (size_t)(row0 + t) * 2048 + h * 64 + q * 16; *(v4u*)dst = y0; *(v4u*)(dst + 8) = y1; } }
    }
    if (PACKED) { if ((w & 1) && fq == 0) {
#pragma unroll
        for (int nt = 0; nt < 4; ++nt) a.out[O_RGH_S + (size_t)(4 * sq + (w >> 1)) * 1024 + h * 64 + 16 * nt + fr] = hc[nt]; }
    } else { if (w == 0 && fq == 0) {
#pragma unroll
        for (int nt = 0; nt < 4; ++nt) a.out[O_RGH_P + (size_t)sq * 1024 + h * 64 + 16 * nt + fr] = hc[nt]; } }
    lds_barrier();
}

constexpr int CV_GB = 131072;
__device__ __forceinline__ void cv_unit(const Args& a, LAS unsigned char* lds, int s, int sb0, int sb1, const f32x2 (&cw)[31], f32x2 cb) {
    const int tid = threadIdx.x, lane = tid & 63, w = __builtin_amdgcn_readfirstlane(tid >> 6);
    const bf16* V = (const bf16*)(a.ws + WS_V); bf16* VN = (bf16*)(a.ws + WS_XN);
    int row0; const float* cvbuf = nullptr;
    if (s < NB) row0 = s * TP; else { const int q = s - NB; row0 = MP + q * DS; cvbuf = a.in[4] + (size_t)q * 30 * 1024; }
    unsigned win[30], cur[16], nxt[16];
    if (cvbuf) {
#pragma unroll
        for (int i = 0; i < 30; ++i) { const f32x2 f = *(const f32x2*)(cvbuf + i * 1024 + 2 * tid); win[i] = pk2(f.x, f.y); }
    } else {
#pragma unroll
        for (int i = 0; i < 30; ++i) { const int j = 16 * sb0 + i - 30; const unsigned u = *(const unsigned*)(V + (size_t)(row0 + (j < 0 ? 0 : j)) * 1024 + 2 * tid); win[i] = j < 0 ? 0u : u; }
    }
#pragma unroll
    for (int i = 0; i < 16; ++i) { cur[i] = *(const unsigned*)(V + (size_t)(row0 + 16 * sb0 + i) * 1024 + 2 * tid); nxt[i] = 0u; }
    const LAS f32x4* gl = (const LAS f32x4*)(lds + CV_GB) + lane; const LAS f32x4* bl = (const LAS f32x4*)(lds + CV_GB + 4096) + lane;
    for (int sb = sb0; sb < sb1; ++sb) {
        { const int sbn = sb + 1 < sb1 ? sb + 1 : sb;
#pragma unroll
            for (int i = 0; i < 16; ++i) nxt[i] = *(const unsigned*)(V + (size_t)(row0 + 16 * sbn + i) * 1024 + 2 * tid);
        }
        f32x2 o[16];
#pragma unroll
        for (int k = 0; k < 16; ++k) o[k] = cb;
#pragma unroll
        for (int i = 0; i < 46; ++i) {
            const unsigned u = i < 30 ? win[i] : cur[i - 30];
            const f32x2 x = (f32x2){bflo(u), bfhi(u)};
#pragma unroll
            for (int k = 0; k < 16; ++k) { const int tap = i - k; if (tap >= 0 && tap <= 30) o[k] = cw[tap] * x + o[k]; }
        }
        LAS float* cbuf = (LAS float*)(lds + ((sb - sb0) & 1) * 65536);
#pragma unroll
        for (int k = 0; k < 16; ++k) *(LAS f32x2*)(cbuf + k * 1024 + 2 * tid) = o[k];
#pragma unroll
        for (int i = 0; i < 14; ++i) win[i] = win[i + 16];
#pragma unroll
        for (int i = 0; i < 16; ++i) win[14 + i] = cur[i];
        lds_barrier();
        f32x4 v[2][4]; float s1[2], s2[2];
#pragma unroll
        for (int rr = 0; rr < 2; ++rr) { s1[rr] = 0.f; s2[rr] = 0.f;
#pragma unroll
            for (int j = 0; j < 4; ++j) { const f32x4 x = *(const LAS f32x4*)(cbuf + (2 * w + rr) * 1024 + 4 * lane + 256 * j); v[rr][j] = x;
                s1[rr] += (x.x + x.y) + (x.z + x.w); s2[rr] += (x.x * x.x + x.y * x.y) + (x.z * x.z + x.w * x.w); } }
#pragma unroll
        for (int rr = 0; rr < 2; ++rr) { s1[rr] = wave_sum(s1[rr]); s2[rr] = wave_sum(s2[rr]); }
        v2u ov[2][4];
#pragma unroll
        for (int rr = 0; rr < 2; ++rr) {
            const float mean = s1[rr] * (1.f / 1024.f), var = fmaxf(s2[rr] * (1.f / 1024.f) - mean * mean, 0.f);
            const float rstd = 1.0f / sqrtf(var + EPS);
#pragma unroll
            for (int j = 0; j < 4; ++j) {
                const f32x4 y = (v[rr][j] - mean) * rstd * gl[64 * j] + bl[64 * j];
                ov[rr][j].x = pk2(fsilu(y.x), fsilu(y.y)); ov[rr][j].y = pk2(fsilu(y.z), fsilu(y.w));
            }
        }
        asm volatile("s_waitcnt vmcnt(0)" ::: "memory");
#pragma unroll
        for (int i = 0; i < 16; ++i) cur[i] = nxt[i];
        asm volatile("" ::: "memory");
#pragma unroll
        for (int rr = 0; rr < 2; ++rr) { v2u* dst = (v2u*)(VN + (size_t)(row0 + 16 * sb + 2 * w + rr) * 1024) + lane;
#pragma unroll
            for (int j = 0; j < 4; ++j) dst[64 * j] = ov[rr][j]; }
    }
    lds_barrier();
}

constexpr size_t CTL_BAR = 36864;
constexpr int LDS_BARST = 143360;
#define XB_TMO      128
#define XB_XCNT(j)  (256  + 64 * (j))
#define XB_XSUB(j)  (1280 + 64 * (j))
#define XB_XGEN(j)  (2304 + 64 * (j))
#define XB_TOP      3328
#define XB_TOPGEN   3392
#define XCD_BAR_WORDS 3456
#define XB_SPIN_CAP (1u << 18)

__device__ __forceinline__ unsigned xb_ld(unsigned* p)              { return __hip_atomic_load(p, __ATOMIC_RELAXED, __HIP_MEMORY_SCOPE_AGENT); }
__device__ __forceinline__ unsigned xb_add(unsigned* p, unsigned v) { return __hip_atomic_fetch_add(p, v, __ATOMIC_RELAXED, __HIP_MEMORY_SCOPE_AGENT); }
__device__ __forceinline__ unsigned xb_xcc_id() { return (unsigned)__builtin_amdgcn_s_getreg((3 << 11) | 20) & 0xFu; }
#define XB_SPIN(cond, bar) do { unsigned _sp = 0; while (cond) { __builtin_amdgcn_s_sleep(1); \
    if ((++_sp & 255u) == 0u) { if (xb_ld(&(bar)[XB_TMO])) break; if (_sp > XB_SPIN_CAP) { atomicAdd(&(bar)[XB_TMO], 1u); break; } } } } while (0)

struct XcdBarrier {
    unsigned* bar; unsigned x;
    volatile LAS unsigned* st;
};

__device__ __forceinline__ XcdBarrier xcd_barrier_post(unsigned* bar, volatile LAS unsigned* st) {
    XcdBarrier b; b.bar = bar; b.x = xb_xcc_id(); b.st = st;
    if (threadIdx.x == 0) (void)xb_add(&bar[XB_XCNT(b.x)], 1u);
    return b;
}
__device__ __forceinline__ void xcd_barrier_complete(unsigned* bar, unsigned x, unsigned& nloc, unsigned& nx) {
    const unsigned G = gridDim.x * gridDim.y * gridDim.z;
    unsigned sum, cnt, mine, sp = 0u;
    for (;;) {
        sum = 0u; cnt = 0u; mine = 0u;
#pragma unroll
        for (unsigned j = 0; j < 16; ++j) { const unsigned c = xb_ld(&bar[XB_XCNT(j)]); sum += c; cnt += (c > 0u) ? 1u : 0u; mine = (j == x) ? c : mine; }
        if (sum == G) break;
        __builtin_amdgcn_s_sleep(1);
        if ((++sp & 255u) == 0u) { if (xb_ld(&bar[XB_TMO])) break; if (sp > XB_SPIN_CAP) { atomicAdd(&bar[XB_TMO], 1u); break; } }
    }
    nloc = mine > 0u ? mine : 1u; nx = cnt > 0u ? cnt : 1u;
}

__device__ __forceinline__ void xcd_barrier(const XcdBarrier& b) {
    asm volatile("s_waitcnt vmcnt(0)" ::: "memory");
    __syncthreads();
    if (threadIdx.x == 0) {
        unsigned* bar = b.bar;
        __builtin_amdgcn_s_waitcnt(0);
        unsigned nloc = b.st[0], nx = b.st[1];
        if (nloc == 0u) { xcd_barrier_complete(bar, b.x, nloc, nx); b.st[0] = nloc; b.st[1] = nx; }
        const unsigned old = xb_add(&bar[XB_XSUB(b.x)], 1u);
        const unsigned gen = old / nloc;
        if (old + 1u == (gen + 1u) * nloc) {
            __builtin_amdgcn_fence(__ATOMIC_RELEASE, "agent");
            asm volatile("s_waitcnt vmcnt(0)" ::: "memory");
            const unsigned og = xb_add(&bar[XB_TOP], 1u);
            const unsigned tg = og / nx;
            if (og + 1u == (tg + 1u) * nx) xb_add(&bar[XB_TOPGEN], 1u);
            else XB_SPIN(xb_ld(&bar[XB_TOPGEN]) == tg, bar);
            __builtin_amdgcn_fence(__ATOMIC_ACQUIRE, "agent");
            xb_add(&bar[XB_XGEN(b.x)], 1u);
            asm volatile("s_waitcnt vmcnt(0)" ::: "memory");
        } else {
            XB_SPIN(xb_ld(&bar[XB_XGEN(b.x)]) == gen, bar);
            __builtin_amdgcn_fence(__ATOMIC_ACQUIRE, "agent");
            asm volatile("s_waitcnt vmcnt(0)" ::: "memory");
        }
    }
    __syncthreads();
}

__global__ void __launch_bounds__(512, 2) hymba_fwd(Args args) {
    extern __shared__ __attribute__((aligned(16))) unsigned char lds_raw[];
    cg::grid_group grid = cg::this_grid();
    LAS unsigned char* lds = (LAS unsigned char*)lds_raw;
    const int tid = threadIdx.x, lane = tid & 63, wave = __builtin_amdgcn_readfirstlane(tid >> 6);
    const int G = gridDim.x, bx = blockIdx.x;
    const int vcu = (G % 8 == 0) ? (bx % 8) * (G / 8) + bx / 8 : bx;
    const int gw = vcu * 8 + wave, NGW = G * 8;
    const int lo = args.ph_lo, hi = args.ph_hi;
#define IN(k) (lo <= (k) && (k) < hi)
#define BOTH(k) (IN(k) && IN((k) + 1))
    unsigned char* ws = args.ws;
    if (tid < 2) ((volatile LAS unsigned*)(lds + LDS_BARST))[tid] = 0u;
    __syncthreads();
    const XcdBarrier bar = xcd_barrier_post((unsigned*)(ws + CTL_BAR), (volatile LAS unsigned*)(lds + LDS_BARST));
    if (args.ph_lo < 0) grid.sync();

    if (IN(0)) { p0_prologue(args, lds, gw, NGW, wave, lane); if (BOTH(0)) xcd_barrier(bar); }

    if (IN(1)) {
        pg8::Gemm g{(const bf16*)(ws + WS_XN), (const bf16*)(ws + WS_WIN), M, DIN, 1024, 1024, 1024}; pg8::StaticOrder S; S.init(M, DIN, G, bx);
        Epi1 E{(bf16*)(ws + WS_XR), (bf16*)(ws + WS_GR), (bf16*)(ws + WS_V), (bf16*)(ws + WS_GC)};
        pg8::gemm_phase<Epi1, pg8::StaticOrder, PG8_ALIGN, PG8_SP2>(lds, g, S, E);
        if (BOTH(1)) xcd_barrier(bar);
    }

    if (IN(2)) {
        __syncthreads();
        if (args.p2mask & 1) for (int it = bx; it < NB * 16; it += G) rg_item<false>(args, lds, it >> 4, it & 15);
        if (args.p2mask & 2) {
            for (int i = tid; i < 2048; i += 512) ((LAS float*)(lds + CV_GB))[i] = (i < 1024) ? args.in[17][i] : args.in[18][i - 1024];
            f32x2 cw[31];
#pragma unroll
            for (int k = 0; k < 31; ++k) cw[k] = *(const f32x2*)(args.in[15] + k * 1024 + 2 * tid);
            const f32x2 cb = *(const f32x2*)(args.in[16] + 2 * tid);
            __syncthreads();
            for (int it = bx; it < NB * 16 + DB; it += G) {
                int s, sb0, sb1;
                if (it < NB * 16) { s = it >> 4; const int j = it & 15; sb0 = j ? 8 * j + 1 : 0; sb1 = 8 * j + 9; } else { s = NB + (it - NB * 16); sb0 = 0; sb1 = 2; }
                cv_unit(args, lds, s, sb0, sb1, cw, cb);
            }
        }
        if (args.p2mask & 4) for (int it = G - 1 - bx; it < 128; it += G) rg_item<true>(args, lds, it >> 4, it & 15);
        if (args.p2mask & 8) {
            const bf16* XR = (const bf16*)(ws + WS_XR); const bf16* V = (const bf16*)(ws + WS_V);
            const int gt = vcu * 512 + tid, NGT = G * 512;
            for (int i = gt; i < NSEQ * 33 * 512; i += NGT) {
                const int c2 = i & 511, rr = (i >> 9) % 33, s = (i >> 9) / 33;
                int row0, T; float* o3; float* o30;
                if (s < NB) { row0 = s * TP; T = TP; o3 = args.out + O_RGC_P + (size_t)s * 3 * 1024; o30 = args.out + O_CVC_P + (size_t)s * 30 * 1024; }
                else { const int q = s - NB; row0 = MP + q * DS; T = DS; o3 = args.out + O_RGC_S + (size_t)q * 3 * 1024; o30 = args.out + O_CVC_S + (size_t)q * 30 * 1024; }
                if (rr < 3) { const unsigned u = *(const unsigned*)(XR + (size_t)(row0 + T - 3 + rr) * 1024 + 2 * c2); *(f32x2*)(o3 + rr * 1024 + 2 * c2) = (f32x2){bflo(u), bfhi(u)}; }
                else { const int r2 = rr - 3; const unsigned u = *(const unsigned*)(V + (size_t)(row0 + T - 30 + r2) * 1024 + 2 * c2); *(f32x2*)(o30 + r2 * 1024 + 2 * c2) = (f32x2){bflo(u), bfhi(u)}; }
            }
        }
        if (BOTH(2)) xcd_barrier(bar);
    }

    if (IN(3)) {
        pg8::Gemm g{(const bf16*)(ws + WS_XN), (const bf16*)(ws + WS_W2), M, 1024, 1024, 1024, 1024}; pg8::StaticOrder S; S.init(M, 1024, G, bx);
        Epi2 E{(bf16*)(ws + WS_YCAT), (const bf16*)(ws + WS_GC), args.in[20]};
        pg8::gemm_phase<Epi2, pg8::StaticOrder, PG8_ALIGN, PG8_SP2>(lds, g, S, E);
        if (G == 256) {
            pg8::Gemm gp{(const bf16*)(ws + WS_YCAT), (const bf16*)(ws + WS_WOUT), M, 1024, 1024, 2048, 2048}; TailOrder Sp{bx - 20};
            Epi3 Ep{(float*)(ws + WS_PART)};
            pg8::gemm_phase<Epi3, TailOrder, PG8_ALIGN, PG8_SP2>(lds, gp, Sp, Ep);
        }
        if (BOTH(3)) xcd_barrier(bar);
    }

    if (IN(4)) {
        const bool ksplit = (G == 256);
        {
            pg8::Gemm g{(const bf16*)(ws + WS_YCAT), (const bf16*)(ws + WS_WOUT), M, 1024, 2048, 2048, 2048}; OrderP4 S; S.init(ksplit ? 128 * 256 : M, G, vcu);
            EpiFinal E{args.in[0], args.in[1], args.out, args.in[22], (float*)(ws + CTL_SLOTS), (unsigned*)(ws + CTL_CNT), (LAS float*)(lds + 131072), nullptr};
            pg8::gemm_phase<EpiFinal, OrderP4, true, PG8_SP2>(lds, g, S, E);
        }
        if (ksplit) {
            pg8::Gemm g{(const bf16*)(ws + WS_YCAT) + 1024, (const bf16*)(ws + WS_WOUT) + 1024, M, 1024, 1024, 2048, 2048}; TailOrder S{vcu};
            EpiFinal E{args.in[0], args.in[1], args.out, args.in[22], (float*)(ws + CTL_SLOTS), (unsigned*)(ws + CTL_CNT), (LAS float*)(lds + 131072), (const float*)(ws + WS_PART)};
            pg8::gemm_phase<EpiFinal, TailOrder, true, PG8_SP2>(lds, g, S, E);
        }
    }
#undef IN
#undef BOTH
}

extern "C" void kernel_launch(void* const* d_in, const int* in_sizes, int n_in, void* d_out, int out_size, void* d_ws, size_t ws_size, hipStream_t stream) {
    static int grid = 0;
    if (grid == 0) {
        if (n_in != 23 || out_size != (int)O_END || ws_size < WS_END) { fprintf(stderr, "kernel_launch: unexpected problem (n_in %d, out %d, ws %zu; need ws >= %zu)\n", n_in, out_size, ws_size, (size_t)WS_END); grid = -1; return; }
        int dev = 0, cus = 0, per_cu = 0;
        if (hipGetDevice(&dev) != hipSuccess || hipDeviceGetAttribute(&cus, hipDeviceAttributeMultiprocessorCount, dev) != hipSuccess) { grid = -1; return; }
        if (hipFuncSetAttribute((const void*)hymba_fwd, hipFuncAttributeMaxDynamicSharedMemorySize, LDS_BYTES) != hipSuccess) { fprintf(stderr, "kernel_launch: hipFuncSetAttribute failed\n"); grid = -1; return; }
        if (hipOccupancyMaxActiveBlocksPerMultiprocessor(&per_cu, (const void*)hymba_fwd, 512, LDS_BYTES) != hipSuccess || per_cu < 1) { fprintf(stderr, "kernel_launch: occupancy query says %d\n", per_cu); per_cu = 1; }
        (void)hipGetLastError();
        grid = cus - (cus % 8);
    }
    if (grid < 0) return;
    Args a{};
    for (int i = 0; i < 23; ++i) a.in[i] = (const float*)d_in[i];
    a.out = (float*)d_out; a.ws = (unsigned char*)d_ws; a.p2mask = 15;
    void* kargs[] = {&a};
#define ZERO_CTL() (void)hipMemsetAsync(d_ws, 0, 65536, stream)
#ifdef PROBE_DBL
    const int cuts[4] = {0, PROBE_DBL + 1, PROBE_DBL + 1, 5}; const int los[3] = {0, PROBE_DBL, PROBE_DBL + 1};
    for (int li = 0; li < 3; ++li) { a.ph_lo = los[li]; a.ph_hi = cuts[li + 1]; if (a.ph_lo >= a.ph_hi) continue; ZERO_CTL();
#ifdef PROBE_P2MASK
        a.p2mask = (li == 1) ? PROBE_P2MASK : 15;
#endif
        hipError_t e = hipLaunchCooperativeKernel((const void*)hymba_fwd, dim3(grid), dim3(512), kargs, LDS_BYTES, stream);
        if (e != hipSuccess) fprintf(stderr, "kernel_launch: cooperative launch failed: %s (grid %d)\n", hipGetErrorString(e), grid); }
#else
    a.ph_lo = 0; a.ph_hi = 5; ZERO_CTL();
    hipError_t e = hipLaunchCooperativeKernel((const void*)hymba_fwd, dim3(grid), dim3(512), kargs, LDS_BYTES, stream);
    if (e != hipSuccess) fprintf(stderr, "kernel_launch: cooperative launch failed: %s (grid %d)\n", hipGetErrorString(e), grid);
#endif
}
```

```cpp
#include <hip/hip_runtime.h>
#include <hip/hip_cooperative_groups.h>
#include <cstdio>
#include <cstdint>
namespace cg = cooperative_groups;
namespace pg8 {
#define PG8_LAS __attribute__((address_space(3)))
typedef unsigned short bf16_t;
typedef short bf16x8 __attribute__((ext_vector_type(8)));
typedef float f32x4 __attribute__((ext_vector_type(4)));
typedef unsigned u32x4 __attribute__((ext_vector_type(4)));
constexpr int BM = 256, BK = 64, HALF = 128, HTB = HALF * BK * 2  , STAGE_BYTES = 8 * HTB, NXCD = 8, WGM = 8;

__host__ __device__ __forceinline__ int lds_byte(int r, int c) { const int st = (r >> 4) * 2 + (c >> 5), rr = r & 15, cc = c & 31, ob = rr * 64 + cc * 2; return st * 1024 + (ob ^ (((ob >> 9) & 1) << 5)); }
__host__ __device__ __forceinline__ void stage_rc(int b, int& R, int& C) { const int st = b / 1024, sb = b % 1024, swz = sb ^ (((sb >> 9) & 1) << 5); R = (st >> 1) * 16 + swz / 64; C = (st & 1) * 32 + (swz % 64) / 2; }
__host__ __device__ __forceinline__ int perm32(int rho) { const int n = rho >> 4, i = rho & 15; return 8 * (i >> 2) + 4 * n + (i & 3); }

struct Unit { int pm, pn; };
struct Gemm { const bf16_t* A; const bf16_t* Bt; int M, N, K, lda, ldb; };

struct StaticOrder {
    int nM, nN, nwg, G, c;
    __host__ __device__ void init(int M, int N, int G_, int c_) { nM = M / BM; nN = N / BM; nwg = nM * nN; G = G_; c = c_; }
    __host__ __device__ bool next(int i, Unit& u) const {
        const long L = (long)i * G + c; if (L >= nwg) return false;
        int wgid = (int)L; { const int q = nwg / NXCD, r = nwg % NXCD, xcd = wgid % NXCD, off = wgid / NXCD; wgid = (xcd < r ? xcd * (q + 1) : r * (q + 1) + (xcd - r) * q) + off; }
        const int nig = WGM * nN, gid = wgid / nig, fm = gid * WGM, gsz = (nM - fm) < WGM ? (nM - fm) : WGM;
        u.pm = fm + ((wgid % nig) % gsz); u.pn = (wgid % nig) / gsz; return true;
    }
    __device__ __forceinline__ void a_ready(const Unit&) const {}
    __device__ __forceinline__ void done(const Unit&) const {}
};

__device__ __forceinline__ unsigned cvt_pk_bf16(float lo, float hi) { unsigned r; asm volatile("v_cvt_pk_bf16_f32 %0, %1, %2" : "=v"(r) : "v"(lo), "v"(hi)); return r; }
template <class Epi, class Sched, bool ALIGN_EPI = false, bool SP2 = false>
__device__ __forceinline__ void gemm_phase(PG8_LAS unsigned char* lds, const Gemm g, const Sched& S, const Epi& E) {
    const int tid = threadIdx.x, wid = __builtin_amdgcn_readfirstlane(tid >> 6), lane = tid & 63, wr = wid >> 2, wc = wid & 3, fr = lane & 15, fq = lane >> 4;
    const int K = g.K, nt = K / BK;
    unsigned voffA[2], voffB[2];
#pragma unroll
    for (int i = 0; i < 2; ++i) { int R, C; stage_rc(tid * 16 + i * 8192, R, C); const int Rb = Epi::PERM ? ((R & ~31) + perm32(R & 31)) : R;
        voffA[i] = (unsigned)(R * g.lda + C) * 2u; voffB[i] = (unsigned)(Rb * g.ldb + C) * 2u; }
    const size_t kstep = (size_t)(BK * 2);
    const size_t hstepA = (size_t)HALF * g.lda * 2, hstepB = (size_t)HALF * g.ldb * 2;
    const size_t tstepA = 2 * hstepA, tstepB = 2 * hstepB;
    const unsigned ldsw = (unsigned)wid * 1024u;
    const int aoff = lds_byte(wr * 64 + fr, fq * 8), boff = lds_byte(wc * 32 + fr, fq * 8);
#define PG8_SA(b, h) (((b) * 2 + (h)) * HTB)
#define PG8_SB(b, h) ((4 + (b) * 2 + (h)) * HTB)
#define PG8_STAGE(bufoff, gbase, voff) do { _Pragma("unroll") for (int _i = 0; _i < 2; ++_i) \
        __builtin_amdgcn_global_load_lds((const unsigned*)((const char*)(gbase) + (voff)[_i]), (PG8_LAS unsigned*)(lds + (bufoff) + ldsw + _i * 8192), 16, 0, 0); } while (0)
#define PG8_LDA(dst, b, h) do { _Pragma("unroll") for (int m = 0; m < 4; ++m) _Pragma("unroll") for (int k = 0; k < 2; ++k) dst[m][k] = *(const PG8_LAS bf16x8*)(lds + PG8_SA(b, h) + aoff + m * 2048 + k * 1024); } while (0)
#define PG8_LDB(dst, b, h) do { _Pragma("unroll") for (int n = 0; n < 2; ++n) _Pragma("unroll") for (int k = 0; k < 2; ++k) dst[n][k] = *(const PG8_LAS bf16x8*)(lds + PG8_SB(b, h) + boff + n * 2048 + k * 1024); } while (0)
#define PG8_MMA(ai, bj, At, Bt) do { __builtin_amdgcn_s_setprio(1); _Pragma("unroll") for (int m = 0; m < 4; ++m) _Pragma("unroll") for (int n = 0; n < 2; ++n) _Pragma("unroll") for (int k = 0; k < 2; ++k) \
        acc[ai][bj][m][n] = __builtin_amdgcn_mfma_f32_16x16x32_bf16(Bt[n][k], At[m][k], acc[ai][bj][m][n], 0, 0, 0); __builtin_amdgcn_s_setprio(0); } while (0)
#define PG8_WAIT_V(n) asm volatile("s_waitcnt vmcnt(" #n ")" ::: "memory")
#define PG8_WAIT_L(n) asm volatile("s_waitcnt lgkmcnt(" #n ")" ::: "memory")
#define PG8_BAR __builtin_amdgcn_s_barrier()
#define PG8_SCHED __builtin_amdgcn_sched_barrier(0)
    Unit cur, nxt; int ui = 0;
    if (!S.next(0, cur)) return;
    f32x4 acc[2][2][4][2];
#pragma unroll
    for (int a = 0; a < 2; ++a)
#pragma unroll
        for (int b = 0; b < 2; ++b)
#pragma unroll
            for (int m = 0; m < 4; ++m)
#pragma unroll
                for (int n = 0; n < 2; ++n) acc[a][b][m][n] = (f32x4){0.f, 0.f, 0.f, 0.f};
    bf16x8 At[4][2], B0[2][2], B1[2][2];
    const char* cA = (const char*)g.A + (size_t)cur.pm * tstepA; const char* cB = (const char*)g.Bt + (size_t)cur.pn * tstepB;
    S.a_ready(cur);
    if constexpr (SP2) {
        PG8_STAGE(PG8_SB(0, 0), cB, voffB); PG8_STAGE(PG8_SB(0, 1), cB + hstepB, voffB); PG8_STAGE(PG8_SA(0, 0), cA, voffA); PG8_STAGE(PG8_SA(0, 1), cA + hstepA, voffA);
        if (wr == 1) PG8_BAR;
        PG8_WAIT_V(2); PG8_BAR;
        PG8_STAGE(PG8_SB(1, 0), cB + kstep, voffB); PG8_STAGE(PG8_SA(1, 0), cA + kstep, voffA); PG8_STAGE(PG8_SB(1, 1), cB + hstepB + kstep, voffB);
        PG8_WAIT_V(6); PG8_BAR;
    } else {
        PG8_STAGE(PG8_SB(0, 0), cB, voffB); PG8_STAGE(PG8_SA(0, 0), cA, voffA); PG8_STAGE(PG8_SB(0, 1), cB + hstepB, voffB); PG8_STAGE(PG8_SA(0, 1), cA + hstepA, voffA);
        if (wr == 1) PG8_BAR;
        PG8_WAIT_V(4); PG8_BAR;
        PG8_STAGE(PG8_SB(1, 0), cB + kstep, voffB); PG8_STAGE(PG8_SA(1, 0), cA + kstep, voffA); PG8_STAGE(PG8_SB(1, 1), cB + hstepB + kstep, voffB);
        PG8_WAIT_V(6); PG8_BAR;
    }
    for (;;) {
        const bool has_next = S.next(ui + 1, nxt);
        const char* nA = has_next ? (const char*)g.A + (size_t)nxt.pm * tstepA : cA; const char* nB = has_next ? (const char*)g.Bt + (size_t)nxt.pn * tstepB : cB;
        for (int t = 0; t < nt; t += 2) {
            const bool last = (t == nt - 2);
            const char* a1 = cA + (size_t)(t + 1) * kstep;
            const char* a2 = last ? nA : cA + (size_t)(t + 2) * kstep; const char* b2 = last ? nB : cB + (size_t)(t + 2) * kstep;
            const char* a3 = a2 + kstep; const char* b3 = b2 + kstep;
            if (last && has_next) S.a_ready(nxt);
            if constexpr (SP2) {
            PG8_LDB(B0, 0, 0); PG8_LDB(B1, 0, 1); PG8_SCHED; PG8_LDA(At, 0, 0); PG8_STAGE(PG8_SA(1, 1), a1 + hstepA, voffA);
            PG8_WAIT_V(8); PG8_WAIT_L(0); PG8_BAR; PG8_MMA(0, 0, At, B0); PG8_MMA(0, 1, At, B1); PG8_BAR; PG8_SCHED;
            PG8_LDA(At, 0, 1); PG8_STAGE(PG8_SB(0, 0), b2, voffB); PG8_STAGE(PG8_SB(0, 1), b2 + hstepB, voffB); PG8_STAGE(PG8_SA(0, 0), a2, voffA);
            PG8_WAIT_V(8); PG8_WAIT_L(0); PG8_BAR; PG8_MMA(1, 0, At, B0); PG8_MMA(1, 1, At, B1); PG8_BAR; PG8_SCHED;
            PG8_LDB(B0, 1, 0); PG8_LDB(B1, 1, 1); PG8_SCHED; PG8_LDA(At, 1, 0); PG8_STAGE(PG8_SA(0, 1), a2 + hstepA, voffA);
            PG8_WAIT_V(8); PG8_WAIT_L(0); PG8_BAR; PG8_MMA(0, 0, At, B0); PG8_MMA(0, 1, At, B1); PG8_BAR; PG8_SCHED;
            PG8_LDA(At, 1, 1); PG8_STAGE(PG8_SB(1, 0), b3, voffB); PG8_STAGE(PG8_SB(1, 1), b3 + hstepB, voffB); PG8_STAGE(PG8_SA(1, 0), a3, voffA);
            PG8_WAIT_V(8); PG8_WAIT_L(0); PG8_BAR; PG8_MMA(1, 0, At, B0); PG8_MMA(1, 1, At, B1); PG8_BAR; PG8_SCHED;
            } else {
            PG8_LDB(B0, 0, 0); PG8_SCHED; PG8_LDA(At, 0, 0); PG8_STAGE(PG8_SA(1, 1), a1 + hstepA, voffA);
            PG8_WAIT_L(8); PG8_BAR; PG8_WAIT_L(0); PG8_MMA(0, 0, At, B0); PG8_BAR; PG8_SCHED;
            PG8_LDB(B1, 0, 1); PG8_STAGE(PG8_SB(0, 0), b2, voffB);
            PG8_BAR; PG8_WAIT_L(0); PG8_MMA(0, 1, At, B1); PG8_BAR;
            PG8_LDA(At, 0, 1); PG8_STAGE(PG8_SA(0, 0), a2, voffA);
            PG8_BAR; PG8_WAIT_L(0); PG8_MMA(1, 0, At, B0); PG8_BAR; PG8_SCHED;
            PG8_STAGE(PG8_SB(0, 1), b2 + hstepB, voffB);
            PG8_WAIT_V(6); PG8_BAR; PG8_MMA(1, 1, At, B1); PG8_BAR;
            PG8_LDB(B0, 1, 0); PG8_SCHED; PG8_LDA(At, 1, 0); PG8_STAGE(PG8_SA(0, 1), a2 + hstepA, voffA);
            PG8_WAIT_L(8); PG8_BAR; PG8_WAIT_L(0); PG8_MMA(0, 0, At, B0); PG8_BAR; PG8_SCHED;
            PG8_LDB(B1, 1, 1); PG8_STAGE(PG8_SB(1, 0), b3, voffB);
            PG8_BAR; PG8_WAIT_L(0); PG8_MMA(0, 1, At, B1); PG8_BAR;
            PG8_LDA(At, 1, 1); PG8_STAGE(PG8_SA(1, 0), a3, voffA);
            PG8_BAR; PG8_WAIT_L(0); PG8_MMA(1, 0, At, B0); PG8_BAR; PG8_SCHED;
            PG8_STAGE(PG8_SB(1, 1), b3 + hstepB, voffB);
            PG8_WAIT_V(6); PG8_BAR; PG8_MMA(1, 1, At, B1); PG8_BAR;
            }
        }
        if constexpr (ALIGN_EPI) { if (wr == 0) PG8_BAR; }
        if constexpr (!Epi::AFTER_DRAIN) { E(acc, cur, wr, wc, fr, fq); S.done(cur); }
        if (!has_next) break;
#pragma unroll
        for (int a = 0; a < 2; ++a)
#pragma unroll
            for (int b = 0; b < 2; ++b)
#pragma unroll
                for (int m = 0; m < 4; ++m)
#pragma unroll
                    for (int n = 0; n < 2; ++n) acc[a][b][m][n] = (f32x4){0.f, 0.f, 0.f, 0.f};
        cur = nxt; cA = nA; cB = nB; ++ui;
        if constexpr (ALIGN_EPI) { if (wr == 1) PG8_BAR; }
    }
    PG8_WAIT_V(0);
    if constexpr (!ALIGN_EPI) { if (wr == 0) PG8_BAR; }
    PG8_BAR;
    if constexpr (Epi::AFTER_DRAIN) { E.fused(acc, cur, wr, wc, fr, fq, lds, wid, lane); S.done(cur); }
#undef PG8_SA
#undef PG8_SB
#undef PG8_STAGE
#undef PG8_LDA
#undef PG8_LDB
#undef PG8_MMA
#undef PG8_WAIT_V
#undef PG8_WAIT_L
#undef PG8_BAR
#undef PG8_SCHED
}
}

#ifndef PG8_SP2
#define PG8_SP2 true
#endif
#ifndef PG8_ALIGN
#define PG8_ALIGN true
#endif

constexpr int DM = 1024, NB = 16, SEQ = 2048, NMETA = 16, TP = SEQ + NMETA;
constexpr int DB = 32, DS = 32;
constexpr int MP = NB * TP, MS = DB * DS, M = MP + MS;
constexpr int DIN = 5120, DMIX = 2048;
constexpr int NSEQ = NB + DB;
constexpr float EPS = 1e-6f;
static_assert(M % 256 == 0, "M tiles");

constexpr size_t MiB = 1u << 20;
constexpr size_t ACT = (size_t)M * 1024 * 2;
constexpr size_t WS_WIN = 1 * MiB, WS_W2 = 11 * MiB, WS_WOUT = 13 * MiB;
constexpr size_t WS_XN = 20 * MiB;
constexpr size_t WS_XR = WS_XN + ACT, WS_GR = WS_XR + ACT, WS_V = WS_GR + ACT, WS_GC = WS_V + ACT, WS_YCAT = WS_GC + ACT;
constexpr size_t WS_END = WS_YCAT + 2 * ACT;
constexpr size_t WS_PART = WS_XR;

constexpr size_t O_YP = 0, O_YS = (size_t)NB * SEQ * DM, O_RGH_P = O_YS + (size_t)MS * DM, O_RGC_P = O_RGH_P + NB * 1024,
                 O_CVC_P = O_RGC_P + NB * 3 * 1024, O_RGH_S = O_CVC_P + NB * 30 * 1024, O_RGC_S = O_RGH_S + DB * 1024,
                 O_CVC_S = O_RGC_S + DB * 3 * 1024, O_END = O_CVC_S + DB * 30 * 1024;

constexpr int LDS_BYTES = 147456;

#define GAS __attribute__((address_space(1)))
#define LAS __attribute__((address_space(3)))
typedef unsigned short bf16;
typedef unsigned v4u __attribute__((ext_vector_type(4)));
typedef unsigned v2u __attribute__((ext_vector_type(2)));
typedef float f32x4 __attribute__((ext_vector_type(4)));
typedef float f32x2 __attribute__((ext_vector_type(2)));
typedef short bf16x8 __attribute__((ext_vector_type(8)));
#define LDS_WAIT() asm volatile("s_waitcnt lgkmcnt(0)" ::: "memory")
__device__ __forceinline__ void lds_barrier() { asm volatile("s_waitcnt lgkmcnt(0)\n\ts_barrier" ::: "memory"); }

__device__ __forceinline__ unsigned pk2(float lo, float hi) { return pg8::cvt_pk_bf16(lo, hi); }
__device__ __forceinline__ float bflo(unsigned u) { return __builtin_bit_cast(float, u << 16); }
__device__ __forceinline__ float bfhi(unsigned u) { return __builtin_bit_cast(float, u & 0xffff0000u); }
__device__ __forceinline__ float fsigmoid(float x) { return __builtin_amdgcn_rcpf(1.0f + __builtin_amdgcn_exp2f(-1.4426950408889634f * x)); }
__device__ __forceinline__ float fsilu(float x) { return x * fsigmoid(x); }
__device__ __forceinline__ float wave_sum(float v) {
    v += __builtin_bit_cast(float, __builtin_amdgcn_update_dpp(0, __builtin_bit_cast(int, v), 0xB1, 0xf, 0xf, true));
    v += __builtin_bit_cast(float, __builtin_amdgcn_update_dpp(0, __builtin_bit_cast(int, v), 0x4E, 0xf, 0xf, true));
    v += __builtin_bit_cast(float, __builtin_amdgcn_update_dpp(0, __builtin_bit_cast(int, v), 0x141, 0xf, 0xf, true));
    v += __builtin_bit_cast(float, __builtin_amdgcn_update_dpp(0, __builtin_bit_cast(int, v), 0x140, 0xf, 0xf, true));
    const int iv = __builtin_bit_cast(int, v);
    const float r0 = __builtin_bit_cast(float, __builtin_amdgcn_readlane(iv, 0)), r1 = __builtin_bit_cast(float, __builtin_amdgcn_readlane(iv, 16));
    const float r2 = __builtin_bit_cast(float, __builtin_amdgcn_readlane(iv, 32)), r3 = __builtin_bit_cast(float, __builtin_amdgcn_readlane(iv, 48));
    return (r0 + r1) + (r2 + r3);
}

struct Args { const float* in[23]; float* out; unsigned char* ws; int ph_lo, ph_hi, p2mask, pad; };

struct Epi1 {
    static constexpr bool PERM = true, AFTER_DRAIN = false;
    bf16 *XR, *GR, *V, *GC;
    __device__ __forceinline__ void operator()(const pg8::f32x4 (&acc)[2][2][4][2], const pg8::Unit& u, int wr, int wc, int fr, int fq) const {
        const int row0 = u.pm * 256 + wr * 64 + fr; const int pn = u.pn;
        if (pn >= 8 && pn < 16) {
            const int col0 = 128 * (pn - 8) + wc * 32 + 8 * fq;
#pragma unroll
            for (int ai = 0; ai < 2; ++ai)
#pragma unroll
                for (int m = 0; m < 4; ++m) {
                    float o[8];
#pragma unroll
                    for (int n = 0; n < 2; ++n)
#pragma unroll
                        for (int e = 0; e < 4; ++e) o[4 * n + e] = acc[ai][0][m][n][e] * fsigmoid(acc[ai][1][m][n][e]);
                    v4u w; w.x = pk2(o[0], o[1]); w.y = pk2(o[2], o[3]); w.z = pk2(o[4], o[5]); w.w = pk2(o[6], o[7]);
                    *(v4u*)(V + (size_t)(row0 + ai * 128 + m * 16) * 1024 + col0) = w;
                }
        } else {
            bf16* base; int colt; bool act;
            if (pn < 4) { base = XR; colt = pn * 256; act = false; }
            else if (pn < 8) { base = GR; colt = (pn - 4) * 256; act = true; }
            else { base = GC; colt = (pn - 16) * 256; act = true; }
            const int col0 = colt + wc * 32 + 8 * fq;
#pragma unroll
            for (int ai = 0; ai < 2; ++ai)
#pragma unroll
                for (int m = 0; m < 4; ++m) {
                    bf16* rowp = base + (size_t)(row0 + ai * 128 + m * 16) * 1024 + col0;
#pragma unroll
                    for (int bj = 0; bj < 2; ++bj) {
                        float o[8];
#pragma unroll
                        for (int n = 0; n < 2; ++n)
#pragma unroll
                            for (int e = 0; e < 4; ++e) { const float x = acc[ai][bj][m][n][e]; o[4 * n + e] = act ? fsilu(x) : x; }
                        v4u w; w.x = pk2(o[0], o[1]); w.y = pk2(o[2], o[3]); w.z = pk2(o[4], o[5]); w.w = pk2(o[6], o[7]);
                        *(v4u*)(rowp + bj * 128) = w;
                    }
                }
        }
    }
};
struct Epi2 {
    static constexpr bool PERM = true, AFTER_DRAIN = false;
    bf16* YCAT; const bf16* GC; const float* bias;
    __device__ __forceinline__ void operator()(const pg8::f32x4 (&acc)[2][2][4][2], const pg8::Unit& u, int wr, int wc, int fr, int fq) const {
        const int row0 = u.pm * 256 + wr * 64 + fr, col0 = u.pn * 256 + wc * 32 + 8 * fq;
        f32x4 bv[2][2];
#pragma unroll
        for (int bj = 0; bj < 2; ++bj)
#pragma unroll
            for (int n = 0; n < 2; ++n) bv[bj][n] = *(const f32x4*)(bias + col0 + bj * 128 + 4 * n);
#pragma unroll
        for (int ai = 0; ai < 2; ++ai)
#pragma unroll
            for (int m = 0; m < 4; ++m) {
                const size_t r = (size_t)(row0 + ai * 128 + m * 16);
#pragma unroll
                for (int bj = 0; bj < 2; ++bj) {
                    const v4u g = *(const v4u*)(GC + r * 1024 + col0 + bj * 128);
                    const f32x4 v0 = acc[ai][bj][m][0] + bv[bj][0], v1 = acc[ai][bj][m][1] + bv[bj][1];
                    v4u w; w.x = pk2(v0[0] * bflo(g.x), v0[1] * bfhi(g.x)); w.y = pk2(v0[2] * bflo(g.y), v0[3] * bfhi(g.y));
                    w.z = pk2(v1[0] * bflo(g.z), v1[1] * bfhi(g.z)); w.w = pk2(v1[2] * bflo(g.w), v1[3] * bfhi(g.w));
                    *(v4u*)(YCAT + r * 2048 + 1024 + col0 + bj * 128) = w;
                }
            }
    }
};
struct Epi3 {
    static constexpr bool PERM = false, AFTER_DRAIN = false;
    float* C;
    __device__ __forceinline__ void operator()(const pg8::f32x4 (&acc)[2][2][4][2], const pg8::Unit& u, int wr, int wc, int fr, int fq) const {
        const int row0 = u.pm * 256 + wr * 64 + fr, col0 = u.pn * 256 + wc * 32 + 4 * fq;
#pragma unroll
        for (int ai = 0; ai < 2; ++ai)
#pragma unroll
            for (int m = 0; m < 4; ++m) { float* rowp = C + (size_t)(row0 + ai * 128 + m * 16) * 1024 + col0;
#pragma unroll
                for (int bj = 0; bj < 2; ++bj)
#pragma unroll
                    for (int n = 0; n < 2; ++n) *(f32x4*)(rowp + bj * 128 + n * 16) = acc[ai][bj][m][n]; }
    }
};

constexpr size_t CTL_CNT = 0, CTL_SLOTS = 65536, CTL_BF = 655360, CTL_NSP = 917504;
struct OrderP4 {
    int nwg, G, c;
    __device__ void init(int M_, int G_, int c_) { nwg = (M_ / 256) * 4; G = G_; c = c_; }
    __device__ bool next(int i, pg8::Unit& u) const { const int L = i * G + c; if (L >= nwg) return false; u.pm = L >> 2; u.pn = L & 3; return true; }
    __device__ __forceinline__ void a_ready(const pg8::Unit&) const {}
    __device__ __forceinline__ void done(const pg8::Unit&) const {}
};
struct TailOrder {
    int j;
    __device__ bool next(int i, pg8::Unit& u) const { if (i != 0 || j < 0 || j >= 20) return false; u.pm = 128 + (j >> 2); u.pn = j & 3; return true; }
    __device__ __forceinline__ void a_ready(const pg8::Unit&) const {}
    __device__ __forceinline__ void done(const pg8::Unit&) const {}
};
struct EpiFinal {
    static constexpr bool PERM = false, AFTER_DRAIN = false;
    const float* xp; const float* xs; float* out; const float* g; float* slots; unsigned* cnt; LAS float* scr;
    const float* part;
    __device__ __forceinline__ void operator()(pg8::f32x4 (&acc)[2][2][4][2], const pg8::Unit& u, int wr, int wc, int fr, int fq) const {
        const int tid = threadIdx.x, lane = tid & 63, wid = __builtin_amdgcn_readfirstlane(tid >> 6);
        if (part) {
            const float* pb = part + (size_t)(u.pm * 256 + wr * 64 + fr) * 1024 + u.pn * 256 + wc * 32 + 4 * fq;
#pragma unroll
            for (int ai = 0; ai < 2; ++ai)
#pragma unroll
                for (int m = 0; m < 4; ++m) {
#pragma unroll
                    for (int bj = 0; bj < 2; ++bj)
#pragma unroll
                        for (int n = 0; n < 2; ++n) acc[ai][bj][m][n] += *(const f32x4*)(pb + (size_t)(ai * 128 + m * 16) * 1024 + bj * 128 + n * 16);
                    asm volatile("" ::: "memory");
                }
        }
        LAS float* P = scr; LAS float* S = scr + 1024;
#pragma unroll
        for (int ai = 0; ai < 2; ++ai)
#pragma unroll
            for (int m = 0; m < 4; ++m) {
                float s = 0.f;
#pragma unroll
                for (int bj = 0; bj < 2; ++bj)
#pragma unroll
                    for (int n = 0; n < 2; ++n) { const pg8::f32x4 x = acc[ai][bj][m][n]; s += (x[0] * x[0] + x[1] * x[1]) + (x[2] * x[2] + x[3] * x[3]); }
                s += __shfl_xor(s, 16); s += __shfl_xor(s, 32);
                if (fq == 0) P[(ai * 128 + wr * 64 + m * 16 + fr) * 4 + wc] = s;
            }
        asm volatile("s_waitcnt lgkmcnt(0)" ::: "memory"); __builtin_amdgcn_s_barrier(); asm volatile("" ::: "memory");
        if (tid < 256) { const f32x4 p = *(const LAS f32x4*)(P + tid * 4);
            __hip_atomic_store(slots + ((size_t)(u.pm * 256 + tid) * 4 + u.pn), (p.x + p.y) + (p.z + p.w), __ATOMIC_RELAXED, __HIP_MEMORY_SCOPE_AGENT); }
        asm volatile("s_waitcnt vmcnt(0)" ::: "memory");
        if (wid < 4 && lane == 0) __hip_atomic_fetch_add(cnt + 64 * u.pm, 1u, __ATOMIC_RELAXED, __HIP_MEMORY_SCOPE_AGENT);
        if (wid == 0) {
            unsigned spins = 0;
            while ((unsigned)__builtin_amdgcn_readfirstlane(__hip_atomic_load(cnt + 64 * u.pm, __ATOMIC_RELAXED, __HIP_MEMORY_SCOPE_AGENT)) < 16u) { __builtin_amdgcn_s_sleep(2); if (++spins > (1u << 22)) break; }
            __builtin_amdgcn_fence(__ATOMIC_ACQUIRE, "agent");
        }
        asm volatile("s_waitcnt vmcnt(0) lgkmcnt(0)" ::: "memory"); __builtin_amdgcn_s_barrier(); asm volatile("" ::: "memory");
        if (tid < 256) { const float* sl = slots + (size_t)(u.pm * 256 + tid) * 4; float t = 0.f;
#pragma unroll
            for (int q = 0; q < 4; ++q) t += __hip_atomic_load(sl + q, __ATOMIC_RELAXED, __HIP_MEMORY_SCOPE_AGENT);
            S[tid] = 1.0f / sqrtf(t * (1.f / 1024.f) + EPS); }
        asm volatile("s_waitcnt lgkmcnt(0)" ::: "memory"); __builtin_amdgcn_s_barrier(); asm volatile("" ::: "memory");
        const int col0 = u.pn * 256 + wc * 32 + 4 * fq;
        f32x4 gv[2][2];
#pragma unroll
        for (int bj = 0; bj < 2; ++bj)
#pragma unroll
            for (int n = 0; n < 2; ++n) gv[bj][n] = *(const f32x4*)(g + col0 + bj * 128 + n * 16);
#pragma unroll
        for (int ai = 0; ai < 2; ++ai)
#pragma unroll
            for (int m = 0; m < 4; ++m) {
                const int rl = ai * 128 + wr * 64 + m * 16 + fr, r = u.pm * 256 + rl; const float rs = S[rl];
                const float* xrow; float* orow; bool ok = true;
                if (r < MP) { const int b = r / TP, t = r - b * TP; ok = t >= NMETA; const size_t o = ((size_t)b * SEQ + (ok ? t - NMETA : 0)) * DM; xrow = xp + o; orow = out + O_YP + o; }
                else { const size_t o = (size_t)(r - MP) * DM; xrow = xs + o; orow = out + O_YS + o; }
                if (ok) {
#pragma unroll
                    for (int bj = 0; bj < 2; ++bj)
#pragma unroll
                        for (int n = 0; n < 2; ++n) { const f32x4 xv = *(const f32x4*)(xrow + col0 + bj * 128 + n * 16);
                            *(f32x4*)(orow + col0 + bj * 128 + n * 16) = xv + acc[ai][bj][m][n] * rs * gv[bj][n]; }
                }
                asm volatile("" ::: "memory");
            }
    }
};

__device__ __forceinline__ void p0_transpose_item(const float* W, int K, int N, bf16* WT, int k0, int n0, int dst_row0, LAS float* scr, int lane) {
#pragma unroll 8
    for (int i = 0; i < 32; ++i) { const int kk = 2 * i + (lane >> 5); scr[kk * 33 + (lane & 31)] = W[(size_t)(k0 + kk) * N + n0 + (lane & 31)]; }
    LDS_WAIT();
    const int c = lane & 7;
#pragma unroll
    for (int j = 0; j < 4; ++j) { const int n = (lane >> 3) + 8 * j; const LAS float* s = scr + (8 * c) * 33 + n;
        v4u o; o.x = pk2(s[0 * 33], s[1 * 33]); o.y = pk2(s[2 * 33], s[3 * 33]); o.z = pk2(s[4 * 33], s[5 * 33]); o.w = pk2(s[6 * 33], s[7 * 33]);
        *(v4u*)(WT + (size_t)(dst_row0 + n) * K + k0 + 8 * c) = o; }
    LDS_WAIT();
}
__device__ __forceinline__ int win_dst_row(int n) {
    if (n < 2048 || n >= 4096) return n;
    if (n < 3072) { const int c = n - 2048; return 2048 + 256 * (c >> 7) + (c & 127); }
    const int c = n - 3072; return 2048 + 256 * (c >> 7) + 128 + (c & 127);
}
__device__ __forceinline__ const float* x_row_ptr(const float* xp, const float* xs, const float* meta, int r) {
    if (r < MP) { const int b = r / TP, t = r - b * TP; return t < NMETA ? meta + (size_t)t * DM : xp + ((size_t)b * SEQ + (t - NMETA)) * DM; }
    return xs + (size_t)(r - MP) * DM;
}
__device__ __forceinline__ void p0_prologue(const Args& a, LAS unsigned char* lds, int gw, int NGW, int wave, int lane) {
    LAS float* scr = (LAS float*)(lds + wave * 16384);
    constexpr int I_IN = 16 * 160, I_W2 = 16 * 32, I_WO = 32 * 32;
    bf16* WinT = (bf16*)(a.ws + WS_WIN); bf16* W2T = (bf16*)(a.ws + WS_W2); bf16* WoT = (bf16*)(a.ws + WS_WOUT);
    for (int it = gw; it < I_IN + I_W2 + I_WO; it += NGW) {
        int r = it;
        if (r < I_IN) { const int kb = r / 160, nb = r % 160; p0_transpose_item(a.in[7], 1024, DIN, WinT, 64 * kb, 32 * nb, win_dst_row(32 * nb), scr, lane); continue; } r -= I_IN;
        if (r < I_W2) { const int kb = r / 32, nb = r % 32; p0_transpose_item(a.in[19], 1024, 1024, W2T, 64 * kb, 32 * nb, 32 * nb, scr, lane); continue; } r -= I_W2;
        { const int kb = r / 32, nb = r % 32; p0_transpose_item(a.in[21], 2048, 1024, WoT, 64 * kb, 32 * nb, 32 * nb, scr, lane); }
    }
    if (gw < 133) { if (lane == 0) *((unsigned*)(a.ws + CTL_CNT) + 64 * gw) = 0u; }
    {
        bf16* BF = (bf16*)(a.ws + CTL_BF); float* NSP = (float*)(a.ws + CTL_NSP);
        for (int i = gw * 64 + lane; i < 2 * 16 * 4096; i += NGW * 64) {
            const int mat = i >> 16, r = i & 65535, h = r >> 12, k = (r >> 6) & 63, n = r & 63;
            const float v = (mat ? a.in[12] : a.in[10])[r];
            const int f = mat * 8 + (n >> 4) * 2 + (k >> 5), ln = ((k & 31) >> 3) * 16 + (n & 15), e = k & 7;
            BF[((size_t)(h * 16 + f) * 64 + ln) * 8 + e] = (bf16)(pk2(v, 0.f) & 0xffffu);
        }
        for (int c = gw * 64 + lane; c < 1024; c += NGW * 64) { const float x = -a.in[14][c]; const float sp = fmaxf(x, 0.f) + log1pf(expf(-fabsf(x))); NSP[c] = -8.0f * sp * 1.4426950408889634f; }
    }
    bf16* XN = (bf16*)(a.ws + WS_XN);
    const f32x4* gp = (const f32x4*)a.in[6] + lane;
    f32x4 g[4];
#pragma unroll
    for (int j = 0; j < 4; ++j) g[j] = gp[64 * j];
    for (int r = gw; r < M; r += NGW) {
        const f32x4* xr = (const f32x4*)x_row_ptr(a.in[0], a.in[1], a.in[5], r) + lane;
        f32x4 v[4]; float s = 0.f;
#pragma unroll
        for (int j = 0; j < 4; ++j) { v[j] = xr[64 * j]; s += (v[j].x * v[j].x + v[j].y * v[j].y) + (v[j].z * v[j].z + v[j].w * v[j].w); }
        const float rstd = 1.0f / sqrtf(wave_sum(s) * (1.f / DM) + EPS);
        v2u* o8 = (v2u*)(XN + (size_t)r * DM) + lane;
#pragma unroll
        for (int j = 0; j < 4; ++j) { v2u o; o.x = pk2(v[j].x * rstd * g[j].x, v[j].y * rstd * g[j].y); o.y = pk2(v[j].z * rstd * g[j].z, v[j].w * rstd * g[j].w); o8[64 * j] = o; }
    }
}

constexpr int RG_XS0 = 0, RG_XS_SZ = 20160, RG_GS0 = 40320, RG_GS_SZ = 18432, RG_XC = 77184, RG_TOT = 112000, RG_CW = 120192, RG_BF = 121472;
constexpr int XS_STRIDE = 144, XC_STRIDE = 68;

template <bool PACKED>
__device__ __forceinline__ void rg_prefetch(v4u (&px)[3], v4u (&pg)[2], const bf16* XR, const bf16* GR, const float* rgbuf, int row0, int T, int h, int c0, int tid) {
#pragma unroll
    for (int j = 0; j < 3; ++j) {
        const int idx = tid + 512 * j, row = idx >> 3, seg = idx & 7;
        int t;
        if (PACKED) { const int rc = row < 140 ? row : 139; const int q = rc / 35; t = 32 * q + (rc - 35 * q - 3 >= 0 ? rc - 35 * q - 3 : 0); }
        else { t = c0 - 3 + row; t = t < 0 ? 0 : (t > T - 1 ? T - 1 : t); }
        px[j] = *(const v4u*)(XR + (size_t)(row0 + t) * 1024 + h * 64 + seg * 8);
    }
#pragma unroll
    for (int j = 0; j < 2; ++j) {
        const int idx = tid + 512 * j, row = idx >> 3, seg = idx & 7; int t = c0 + row; t = t > T - 1 ? T - 1 : t;
        pg[j] = *(const v4u*)(GR + (size_t)(row0 + t) * 1024 + h * 64 + seg * 8);
    }
}
template <bool PACKED>
__device__ __forceinline__ void rg_stage(LAS unsigned char* lds, int buf, const v4u (&px)[3], const v4u (&pg)[2], const float* rgbuf, int T, int h, int c0, int tid) {
    const v4u z = (v4u){0u, 0u, 0u, 0u};
#pragma unroll
    for (int j = 0; j < 3; ++j) { const int idx = tid + 512 * j, row = idx >> 3, seg = idx & 7;
        v4u v = px[j];
        if (PACKED) {
            if (row < 140) { const int q = row / 35, t = row - 35 * q - 3;
                if (t < 0) { const f32x4* p = (const f32x4*)(rgbuf + (size_t)q * 3072 + (3 + t) * 1024 + h * 64 + seg * 8); const f32x4 a = p[0], b = p[1];
                    v.x = pk2(a.x, a.y); v.y = pk2(a.z, a.w); v.z = pk2(b.x, b.y); v.w = pk2(b.z, b.w); } }
        } else { const int t = c0 - 3 + row; v = (t >= 0 && t < T) ? v : z; }
        if (row < 140) *(LAS v4u*)(lds + RG_XS0 + buf * RG_XS_SZ + row * XS_STRIDE + seg * 16) = v; }
#pragma unroll
    for (int j = 0; j < 2; ++j) { const int idx = tid + 512 * j, row = idx >> 3, seg = idx & 7; const v4u v = (c0 + row < T) ? pg[j] : z;
        *(LAS v4u*)(lds + RG_GS0 + buf * RG_GS_SZ + row * XS_STRIDE + seg * 16) = v; }
}

template <bool PACKED>
__device__ __forceinline__ void rg_item(const Args& a, LAS unsigned char* lds, int sq, int h) {
    const int tid = threadIdx.x, lane = tid & 63, w = __builtin_amdgcn_readfirstlane(tid >> 6), fr = lane & 15, fq = lane >> 4;
    const bf16* XR = (const bf16*)(a.ws + WS_XR); const bf16* GR = (const bf16*)(a.ws + WS_GR); bf16* YCAT = (bf16*)(a.ws + WS_YCAT);
    const int row0 = PACKED ? MP + 128 * sq : sq * TP, T = PACKED ? 128 : TP, nch = PACKED ? 1 : (TP + 127) / 128;
    const float* rgbuf = PACKED ? a.in[3] + (size_t)(4 * sq) * 3072 : nullptr;
    LAS float* cwl = (LAS float*)(lds + RG_CW);
    if (tid < 320) { const int k = tid >> 6, c = tid & 63; cwl[tid] = (k < 4) ? a.in[8][k * 1024 + h * 64 + c] : a.in[9][h * 64 + c]; }
    { const v4u* src = (const v4u*)(a.ws + CTL_BF + (size_t)h * 16384) + tid * 2; LAS v4u* dst = (LAS v4u*)(lds + RG_BF) + tid * 2; dst[0] = src[0]; dst[1] = src[1]; }
    float ba_[4], bx_[4], nsp[4], hc[4];
#pragma unroll
    for (int nt = 0; nt < 4; ++nt) { const int c = h * 64 + 16 * nt + fr; ba_[nt] = a.in[11][c]; bx_[nt] = a.in[13][c]; nsp[nt] = ((const float*)(a.ws + CTL_NSP))[c];
        hc[nt] = PACKED ? a.in[2][(size_t)(4 * sq + (w >> 1)) * 1024 + c] : 0.f; }
    const int xrow_base = PACKED ? 35 * (w >> 1) + 16 * (w & 1) : 16 * w;

    v4u px[3], pg[2];
    rg_prefetch<PACKED>(px, pg, XR, GR, rgbuf, row0, T, h, 0, tid);
    rg_stage<PACKED>(lds, 0, px, pg, rgbuf, T, h, 0, tid);
    if (nch > 1) { rg_prefetch<PACKED>(px, pg, XR, GR, rgbuf, row0, T, h, 128, tid); rg_stage<PACKED>(lds, 1, px, pg, rgbuf, T, h, 128, tid); }
    lds_barrier();
    LAS float* xcw = (LAS float*)(lds + RG_XC + w * (16 * XC_STRIDE * 4));
    LAS unsigned char* ysw = (LAS unsigned char*)xcw;
    for (int ch = 0; ch < nch; ++ch) {
        const int c0 = ch * 128, buf = ch & 1;
        if (ch + 2 < nch) rg_prefetch<PACKED>(px, pg, XR, GR, rgbuf, row0, T, h, c0 + 256, tid);
        const LAS unsigned char* xs = lds + RG_XS0 + buf * RG_XS_SZ; const LAS unsigned char* gs = lds + RG_GS0 + buf * RG_GS_SZ;
        bf16x8 Af[2];
#pragma unroll
        for (int ks = 0; ks < 2; ++ks) {
            const int cb = 32 * ks + 8 * fq;
            f32x4 lo = *(const LAS f32x4*)(cwl + 256 + cb), hi = *(const LAS f32x4*)(cwl + 256 + cb + 4);
#pragma unroll
            for (int k = 0; k < 4; ++k) {
                const v4u xv = *(const LAS v4u*)(xs + (xrow_base + fr + k) * XS_STRIDE + cb * 2);
                const f32x4 wl = *(const LAS f32x4*)(cwl + 64 * k + cb), wh = *(const LAS f32x4*)(cwl + 64 * k + cb + 4);
                lo.x += wl.x * bflo(xv.x); lo.y += wl.y * bfhi(xv.x); lo.z += wl.z * bflo(xv.y); lo.w += wl.w * bfhi(xv.y);
                hi.x += wh.x * bflo(xv.z); hi.y += wh.y * bfhi(xv.z); hi.z += wh.z * bflo(xv.w); hi.w += wh.w * bfhi(xv.w);
            }
            v4u u; u.x = pk2(lo.x, lo.y); u.y = pk2(lo.z, lo.w); u.z = pk2(hi.x, hi.y); u.w = pk2(hi.z, hi.w);
            Af[ks] = __builtin_bit_cast(bf16x8, u);
            *(LAS f32x4*)(xcw + fr * XC_STRIDE + cb) = lo; *(LAS f32x4*)(xcw + fr * XC_STRIDE + cb + 4) = hi;
        }
        f32x4 accA[4], accX[4];
#pragma unroll
        for (int nt = 0; nt < 4; ++nt) { accA[nt] = (f32x4){0.f, 0.f, 0.f, 0.f}; accX[nt] = (f32x4){0.f, 0.f, 0.f, 0.f};
#pragma unroll
            for (int ks = 0; ks < 2; ++ks) { const bf16x8 Ba = *(const LAS bf16x8*)(lds + RG_BF + ((nt * 2 + ks) * 64 + lane) * 16), Bx = *(const LAS bf16x8*)(lds + RG_BF + ((8 + nt * 2 + ks) * 64 + lane) * 16);
                                             accA[nt] = __builtin_amdgcn_mfma_f32_16x16x32_bf16(Af[ks], Ba, accA[nt], 0, 0, 0);
                                             accX[nt] = __builtin_amdgcn_mfma_f32_16x16x32_bf16(Af[ks], Bx, accX[nt], 0, 0, 0); } }
        LDS_WAIT();
        float hl[4][4], pl[4][4], sg[4][4], PE[4], HE[4];
#pragma unroll
        for (int nt = 0; nt < 4; ++nt) {
            float P = 1.f, H = 0.f;
#pragma unroll
            for (int j = 0; j < 4; ++j) {
                const int row = 4 * fq + j, cc = 16 * nt + fr;
                const float xc = xcw[row * XC_STRIDE + cc];
                const unsigned short gsv = *(const LAS unsigned short*)(gs + (16 * w + row) * XS_STRIDE + cc * 2);
                sg[nt][j] = __builtin_bit_cast(float, (unsigned)gsv << 16);
                const float r = fsigmoid(accA[nt][j] + ba_[nt]), ig = fsigmoid(accX[nt][j] + bx_[nt]);
                float av = __builtin_amdgcn_exp2f(r * nsp[nt]);
                float bv = __builtin_amdgcn_sqrtf(fmaxf(fmaf(-av, av, 1.0f), 0.f)) * (ig * xc);
                if (!PACKED && c0 + 16 * w + row >= T) { av = 1.f; bv = 0.f; }
                H = fmaf(av, H, bv); P *= av; hl[nt][j] = H; pl[nt][j] = P;
            }
            float Pi = P, Hi = H;
            { const float tp = __shfl_up(Pi, 16), th = __shfl_up(Hi, 16); if (fq >= 1) { Hi = fmaf(Pi, th, Hi); Pi *= tp; } }
            { const float tp = __shfl_up(Pi, 32), th = __shfl_up(Hi, 32); if (fq >= 2) { Hi = fmaf(Pi, th, Hi); Pi *= tp; } }
            { const float tp = __shfl_up(Pi, 16), th = __shfl_up(Hi, 16); PE[nt] = fq >= 1 ? tp : 1.f; HE[nt] = fq >= 1 ? th : 0.f; }
            if (fq == 3) *(LAS f32x2*)(lds + RG_TOT + ((buf * 8 + w) * 64 + 16 * nt + fr) * 8) = (f32x2){Pi, Hi};
        }
        lds_barrier();
#pragma unroll
        for (int nt = 0; nt < 4; ++nt) {
            float cin;
            if (PACKED) {
                const f32x2 tp = *(const LAS f32x2*)(lds + RG_TOT + ((buf * 8 + (w & 6)) * 64 + 16 * nt + fr) * 8);
                const f32x2 tq = *(const LAS f32x2*)(lds + RG_TOT + ((buf * 8 + (w | 1)) * 64 + 16 * nt + fr) * 8);
                const float mid = fmaf(tp.x, hc[nt], tp.y);
                cin = (w & 1) ? mid : hc[nt];
                hc[nt] = fmaf(tq.x, mid, tq.y);
            } else {
                float run = hc[nt]; cin = 0.f;
#pragma unroll
                for (int ww = 0; ww < 8; ++ww) { const f32x2 t = *(const LAS f32x2*)(lds + RG_TOT + ((buf * 8 + ww) * 64 + 16 * nt + fr) * 8);
                    if (ww == w) cin = run; run = fmaf(t.x, run, t.y); }
                hc[nt] = run;
            }
            const float Gc = fmaf(PE[nt], cin, HE[nt]);
#pragma unroll
            for (int j = 0; j < 4; ++j) { const float hv = fmaf(pl[nt][j], Gc, hl[nt][j]); const float y = hv * sg[nt][j];
                *(LAS unsigned short*)(ysw + (4 * fq + j) * XS_STRIDE + (16 * nt + fr) * 2) = (unsigned short)(pk2(y, 0.f) & 0xffffu); }
        }
        LDS_WAIT();
        { const int row = lane >> 2, q = lane & 3, t = c0 + 16 * w + row;
          const v4u y0 = *(const LAS v4u*)(ysw + row * XS_STRIDE + q * 32), y1 = *(const LAS v4u*)(ysw + row * XS_STRIDE + q * 32 + 16);
          LDS_WAIT();
          if (ch + 2 < nch) { asm volatile("s_waitcnt vmcnt(0)" ::: "memory"); rg_stage<PACKED>(lds, buf, px, pg, rgbuf, T, h, c0 + 256, tid); asm volatile("" ::: "memory"); }
          if (t < T) { bf16* dst = YCAT + (size_t)(row0 + t) * 2048 + h * 64 + q * 16; *(v4u*)dst = y0; *(v4u*)(dst + 8) = y1; } }
    }
    if (PACKED) { if ((w & 1) && fq == 0) {
#pragma unroll
        for (int nt = 0; nt < 4; ++nt) a.out[O_RGH_S + (size_t)(4 * sq + (w >> 1)) * 1024 + h * 64 + 16 * nt + fr] = hc[nt]; }
    } else { if (w == 0 && fq == 0) {
#pragma unroll
        for (int nt = 0; nt < 4; ++nt) a.out[O_RGH_P + (size_t)sq * 1024 + h * 64 + 16 * nt + fr] = hc[nt]; } }
    lds_barrier();
}

constexpr int CV_GB = 131072;
__device__ __forceinline__ void cv_unit(const Args& a, LAS unsigned char* lds, int s, int sb0, int sb1, const f32x2 (&cw)[31], f32x2 cb) {
    const int tid = threadIdx.x, lane = tid & 63, w = __builtin_amdgcn_readfirstlane(tid >> 6);
    const bf16* V = (const bf16*)(a.ws + WS_V); bf16* VN = (bf16*)(a.ws + WS_XN);
    int row0; const float* cvbuf = nullptr;
    if (s < NB) row0 = s * TP; else { const int q = s - NB; row0 = MP + q * DS; cvbuf = a.in[4] + (size_t)q * 30 * 1024; }
    unsigned win[30], cur[16], nxt[16];
    if (cvbuf) {
#pragma unroll
        for (int i = 0; i < 30; ++i) { const f32x2 f = *(const f32x2*)(cvbuf + i * 1024 + 2 * tid); win[i] = pk2(f.x, f.y); }
    } else {
#pragma unroll
        for (int i = 0; i < 30; ++i) { const int j = 16 * sb0 + i - 30; const unsigned u = *(const unsigned*)(V + (size_t)(row0 + (j < 0 ? 0 : j)) * 1024 + 2 * tid); win[i] = j < 0 ? 0u : u; }
    }
#pragma unroll
    for (int i = 0; i < 16; ++i) { cur[i] = *(const unsigned*)(V + (size_t)(row0 + 16 * sb0 + i) * 1024 + 2 * tid); nxt[i] = 0u; }
    const LAS f32x4* gl = (const LAS f32x4*)(lds + CV_GB) + lane; const LAS f32x4* bl = (const LAS f32x4*)(lds + CV_GB + 4096) + lane;
    for (int sb = sb0; sb < sb1; ++sb) {
        { const int sbn = sb + 1 < sb1 ? sb + 1 : sb;
#pragma unroll
            for (int i = 0; i < 16; ++i) nxt[i] = *(const unsigned*)(V + (size_t)(row0 + 16 * sbn + i) * 1024 + 2 * tid);
        }
        f32x2 o[16];
#pragma unroll
        for (int k = 0; k < 16; ++k) o[k] = cb;
#pragma unroll
        for (int i = 0; i < 46; ++i) {
            const unsigned u = i < 30 ? win[i] : cur[i - 30];
            const f32x2 x = (f32x2){bflo(u), bfhi(u)};
#pragma unroll
            for (int k = 0; k < 16; ++k) { const int tap = i - k; if (tap >= 0 && tap <= 30) o[k] = cw[tap] * x + o[k]; }
        }
        LAS float* cbuf = (LAS float*)(lds + ((sb - sb0) & 1) * 65536);
#pragma unroll
        for (int k = 0; k < 16; ++k) *(LAS f32x2*)(cbuf + k * 1024 + 2 * tid) = o[k];
#pragma unroll
        for (int i = 0; i < 14; ++i) win[i] = win[i + 16];
#pragma unroll
        for (int i = 0; i < 16; ++i) win[14 + i] = cur[i];
        lds_barrier();
        f32x4 v[2][4]; float s1[2], s2[2];
#pragma unroll
        for (int rr = 0; rr < 2; ++rr) { s1[rr] = 0.f; s2[rr] = 0.f;
#pragma unroll
            for (int j = 0; j < 4; ++j) { const f32x4 x = *(const LAS f32x4*)(cbuf + (2 * w + rr) * 1024 + 4 * lane + 256 * j); v[rr][j] = x;
                s1[rr] += (x.x + x.y) + (x.z + x.w); s2[rr] += (x.x * x.x + x.y * x.y) + (x.z * x.z + x.w * x.w); } }
#pragma unroll
        for (int rr = 0; rr < 2; ++rr) { s1[rr] = wave_sum(s1[rr]); s2[rr] = wave_sum(s2[rr]); }
        v2u ov[2][4];
#pragma unroll
        for (int rr = 0; rr < 2; ++rr) {
            const float mean = s1[rr] * (1.f / 1024.f), var = fmaxf(s2[rr] * (1.f / 1024.f) - mean * mean, 0.f);
            const float rstd = 1.0f / sqrtf(var + EPS);
#pragma unroll
            for (int j = 0; j < 4; ++j) {
                const f32x4 y = (v[rr][j] - mean) * rstd * gl[64 * j] + bl[64 * j];
                ov[rr][j].x = pk2(fsilu(y.x), fsilu(y.y)); ov[rr][j].y = pk2(fsilu(y.z), fsilu(y.w));
            }
        }
        asm volatile("s_waitcnt vmcnt(0)" ::: "memory");
#pragma unroll
        for (int i = 0; i < 16; ++i) cur[i] = nxt[i];
        asm volatile("" ::: "memory");
#pragma unroll
        for (int rr = 0; rr < 2; ++rr) { v2u* dst = (v2u*)(VN + (size_t)(row0 + 16 * sb + 2 * w + rr) * 1024) + lane;
#pragma unroll
            for (int j = 0; j < 4; ++j) dst[64 * j] = ov[rr][j]; }
    }
    lds_barrier();
}

constexpr size_t CTL_BAR = 36864;
constexpr int LDS_BARST = 143360;
#define XB_TMO      128
#define XB_XCNT(j)  (256  + 64 * (j))
#define XB_XSUB(j)  (1280 + 64 * (j))
#define XB_XGEN(j)  (2304 + 64 * (j))
#define XB_TOP      3328
#define XB_TOPGEN   3392
#define XCD_BAR_WORDS 3456
#define XB_SPIN_CAP (1u << 18)

__device__ __forceinline__ unsigned xb_ld(unsigned* p)              { return __hip_atomic_load(p, __ATOMIC_RELAXED, __HIP_MEMORY_SCOPE_AGENT); }
__device__ __forceinline__ unsigned xb_add(unsigned* p, unsigned v) { return __hip_atomic_fetch_add(p, v, __ATOMIC_RELAXED, __HIP_MEMORY_SCOPE_AGENT); }
__device__ __forceinline__ unsigned xb_xcc_id() { return (unsigned)__builtin_amdgcn_s_getreg((3 << 11) | 20) & 0xFu; }
#define XB_SPIN(cond, bar) do { unsigned _sp = 0; while (cond) { __builtin_amdgcn_s_sleep(1); \
    if ((++_sp & 255u) == 0u) { if (xb_ld(&(bar)[XB_TMO])) break; if (_sp > XB_SPIN_CAP) { atomicAdd(&(bar)[XB_TMO], 1u); break; } } } } while (0)

struct XcdBarrier {
    unsigned* bar; unsigned x;
    volatile LAS unsigned* st;
};

__device__ __forceinline__ XcdBarrier xcd_barrier_post(unsigned* bar, volatile LAS unsigned* st) {
    XcdBarrier b; b.bar = bar; b.x = xb_xcc_id(); b.st = st;
    if (threadIdx.x == 0) (void)xb_add(&bar[XB_XCNT(b.x)], 1u);
    return b;
}
__device__ __forceinline__ void xcd_barrier_complete(unsigned* bar, unsigned x, unsigned& nloc, unsigned& nx) {
    const unsigned G = gridDim.x * gridDim.y * gridDim.z;
    unsigned sum, cnt, mine, sp = 0u;
    for (;;) {
        sum = 0u; cnt = 0u; mine = 0u;
#pragma unroll
        for (unsigned j = 0; j < 16; ++j) { const unsigned c = xb_ld(&bar[XB_XCNT(j)]); sum += c; cnt += (c > 0u) ? 1u : 0u; mine = (j == x) ? c : mine; }
        if (sum == G) break;
        __builtin_amdgcn_s_sleep(1);
        if ((++sp & 255u) == 0u) { if (xb_ld(&bar[XB_TMO])) break; if (sp > XB_SPIN_CAP) { atomicAdd(&bar[XB_TMO], 1u); break; } }
    }
    nloc = mine > 0u ? mine : 1u; nx = cnt > 0u ? cnt : 1u;
}

__device__ __forceinline__ void xcd_barrier(const XcdBarrier& b) {
    asm volatile("s_waitcnt vmcnt(0)" ::: "memory");
    __syncthreads();
    if (threadIdx.x == 0) {
        unsigned* bar = b.bar;
        __builtin_amdgcn_s_waitcnt(0);
        unsigned nloc = b.st[0], nx = b.st[1];
        if (nloc == 0u) { xcd_barrier_complete(bar, b.x, nloc, nx); b.st[0] = nloc; b.st[1] = nx; }
        const unsigned old = xb_add(&bar[XB_XSUB(b.x)], 1u);
        const unsigned gen = old / nloc;
        if (old + 1u == (gen + 1u) * nloc) {
            __builtin_amdgcn_fence(__ATOMIC_RELEASE, "agent");
            asm volatile("s_waitcnt vmcnt(0)" ::: "memory");
            const unsigned og = xb_add(&bar[XB_TOP], 1u);
            const unsigned tg = og / nx;
            if (og + 1u == (tg + 1u) * nx) xb_add(&bar[XB_TOPGEN], 1u);
            else XB_SPIN(xb_ld(&bar[XB_TOPGEN]) == tg, bar);
            __builtin_amdgcn_fence(__ATOMIC_ACQUIRE, "agent");
            xb_add(&bar[XB_XGEN(b.x)], 1u);
            asm volatile("s_waitcnt vmcnt(0)" ::: "memory");
        } else {
            XB_SPIN(xb_ld(&bar[XB_XGEN(b.x)]) == gen, bar);
            __builtin_amdgcn_fence(__ATOMIC_ACQUIRE, "agent");
            asm volatile("s_waitcnt vmcnt(0)" ::: "memory");
        }
    }
    __syncthreads();
}

__global__ void __launch_bounds__(512, 2) hymba_fwd(Args args) {
    extern __shared__ __attribute__((aligned(16))) unsigned char lds_raw[];
    cg::grid_group grid = cg::this_grid();
    LAS unsigned char* lds = (LAS unsigned char*)lds_raw;
    const int tid = threadIdx.x, lane = tid & 63, wave = __builtin_amdgcn_readfirstlane(tid >> 6);
    const int G = gridDim.x, bx = blockIdx.x;
    const int vcu = (G % 8 == 0) ? (bx % 8) * (G / 8) + bx / 8 : bx;
    const int gw = vcu * 8 + wave, NGW = G * 8;
    const int lo = args.ph_lo, hi = args.ph_hi;
#define IN(k) (lo <= (k) && (k) < hi)
#define BOTH(k) (IN(k) && IN((k) + 1))
    unsigned char* ws = args.ws;
    if (tid < 2) ((volatile LAS unsigned*)(lds + LDS_BARST))[tid] = 0u;
    __syncthreads();
    const XcdBarrier bar = xcd_barrier_post((unsigned*)(ws + CTL_BAR), (volatile LAS unsigned*)(lds + LDS_BARST));
    if (args.ph_lo < 0) grid.sync();

    if (IN(0)) { p0_prologue(args, lds, gw, NGW, wave, lane); if (BOTH(0)) xcd_barrier(bar); }

    if (IN(1)) {
        pg8::Gemm g{(const bf16*)(ws + WS_XN), (const bf16*)(ws + WS_WIN), M, DIN, 1024, 1024, 1024}; pg8::StaticOrder S; S.init(M, DIN, G, bx);
        Epi1 E{(bf16*)(ws + WS_XR), (bf16*)(ws + WS_GR), (bf16*)(ws + WS_V), (bf16*)(ws + WS_GC)};
        pg8::gemm_phase<Epi1, pg8::StaticOrder, PG8_ALIGN, PG8_SP2>(lds, g, S, E);
        if (BOTH(1)) xcd_barrier(bar);
    }

    if (IN(2)) {
        __syncthreads();
        if (args.p2mask & 1) for (int it = bx; it < NB * 16; it += G) rg_item<false>(args, lds, it >> 4, it & 15);
        if (args.p2mask & 2) {
            for (int i = tid; i < 2048; i += 512) ((LAS float*)(lds + CV_GB))[i] = (i < 1024) ? args.in[17][i] : args.in[18][i - 1024];
            f32x2 cw[31];
#pragma unroll
            for (int k = 0; k < 31; ++k) cw[k] = *(const f32x2*)(args.in[15] + k * 1024 + 2 * tid);
            const f32x2 cb = *(const f32x2*)(args.in[16] + 2 * tid);
            __syncthreads();
            for (int it = bx; it < NB * 16; it += G) {
                const int q = it >> 4, j = it & 15, nrep = (j == 15) ? 2 : 1;
                for (int r = 0; r < nrep; ++r) {
                    int s, sb0, sb1;
                    if (j < 15) { s = q; sb0 = 9 * j; sb1 = (j == 14) ? TP / 16 : 9 * j + 9; } else { s = NB + 2 * q + r; sb0 = 0; sb1 = 2; }
                    cv_unit(args, lds, s, sb0, sb1, cw, cb);
                }
            }
        }
        if (args.p2mask & 4) for (int it = G - 1 - bx; it < 128; it += G) rg_item<true>(args, lds, it >> 4, it & 15);
        if (args.p2mask & 8) {
            const bf16* XR = (const bf16*)(ws + WS_XR); const bf16* V = (const bf16*)(ws + WS_V);
            const int gt = vcu * 512 + tid, NGT = G * 512;
            for (int i = gt; i < NSEQ * 33 * 512; i += NGT) {
                const int c2 = i & 511, rr = (i >> 9) % 33, s = (i >> 9) / 33;
                int row0, T; float* o3; float* o30;
                if (s < NB) { row0 = s * TP; T = TP; o3 = args.out + O_RGC_P + (size_t)s * 3 * 1024; o30 = args.out + O_CVC_P + (size_t)s * 30 * 1024; }
                else { const int q = s - NB; row0 = MP + q * DS; T = DS; o3 = args.out + O_RGC_S + (size_t)q * 3 * 1024; o30 = args.out + O_CVC_S + (size_t)q * 30 * 1024; }
                if (rr < 3) { const unsigned u = *(const unsigned*)(XR + (size_t)(row0 + T - 3 + rr) * 1024 + 2 * c2); *(f32x2*)(o3 + rr * 1024 + 2 * c2) = (f32x2){bflo(u), bfhi(u)}; }
                else { const int r2 = rr - 3; const unsigned u = *(const unsigned*)(V + (size_t)(row0 + T - 30 + r2) * 1024 + 2 * c2); *(f32x2*)(o30 + r2 * 1024 + 2 * c2) = (f32x2){bflo(u), bfhi(u)}; }
            }
        }
        if (BOTH(2)) xcd_barrier(bar);
    }

    if (IN(3)) {
        pg8::Gemm g{(const bf16*)(ws + WS_XN), (const bf16*)(ws + WS_W2), M, 1024, 1024, 1024, 1024}; pg8::StaticOrder S; S.init(M, 1024, G, bx);
        Epi2 E{(bf16*)(ws + WS_YCAT), (const bf16*)(ws + WS_GC), args.in[20]};
        pg8::gemm_phase<Epi2, pg8::StaticOrder, PG8_ALIGN, PG8_SP2>(lds, g, S, E);
        if (G == 256) {
            pg8::Gemm gp{(const bf16*)(ws + WS_YCAT), (const bf16*)(ws + WS_WOUT), M, 1024, 1024, 2048, 2048}; TailOrder Sp{bx - 20};
            Epi3 Ep{(float*)(ws + WS_PART)};
            pg8::gemm_phase<Epi3, TailOrder, PG8_ALIGN, PG8_SP2>(lds, gp, Sp, Ep);
        }
        if (BOTH(3)) xcd_barrier(bar);
    }

    if (IN(4)) {
        const bool ksplit = (G == 256);
        {
            pg8::Gemm g{(const bf16*)(ws + WS_YCAT), (const bf16*)(ws + WS_WOUT), M, 1024, 2048, 2048, 2048}; OrderP4 S; S.init(ksplit ? 128 * 256 : M, G, vcu);
            EpiFinal E{args.in[0], args.in[1], args.out, args.in[22], (float*)(ws + CTL_SLOTS), (unsigned*)(ws + CTL_CNT), (LAS float*)(lds + 131072), nullptr};
            pg8::gemm_phase<EpiFinal, OrderP4, true, PG8_SP2>(lds, g, S, E);
        }
        if (ksplit) {
            pg8::Gemm g{(const bf16*)(ws + WS_YCAT) + 1024, (const bf16*)(ws + WS_WOUT) + 1024, M, 1024, 1024, 2048, 2048}; TailOrder S{vcu};
            EpiFinal E{args.in[0], args.in[1], args.out, args.in[22], (float*)(ws + CTL_SLOTS), (unsigned*)(ws + CTL_CNT), (LAS float*)(lds + 131072), (const float*)(ws + WS_PART)};
            pg8::gemm_phase<EpiFinal, TailOrder, true, PG8_SP2>(lds, g, S, E);
        }
    }
#undef IN
#undef BOTH
}

extern "C" void kernel_launch(void* const* d_in, const int* in_sizes, int n_in, void* d_out, int out_size, void* d_ws, size_t ws_size, hipStream_t stream) {
    static int grid = 0;
    if (grid == 0) {
        if (n_in != 23 || out_size != (int)O_END || ws_size < WS_END) { fprintf(stderr, "kernel_launch: unexpected problem (n_in %d, out %d, ws %zu; need ws >= %zu)\n", n_in, out_size, ws_size, (size_t)WS_END); grid = -1; return; }
        int dev = 0, cus = 0, per_cu = 0;
        if (hipGetDevice(&dev) != hipSuccess || hipDeviceGetAttribute(&cus, hipDeviceAttributeMultiprocessorCount, dev) != hipSuccess) { grid = -1; return; }
        if (hipFuncSetAttribute((const void*)hymba_fwd, hipFuncAttributeMaxDynamicSharedMemorySize, LDS_BYTES) != hipSuccess) { fprintf(stderr, "kernel_launch: hipFuncSetAttribute failed\n"); grid = -1; return; }
        if (hipOccupancyMaxActiveBlocksPerMultiprocessor(&per_cu, (const void*)hymba_fwd, 512, LDS_BYTES) != hipSuccess || per_cu < 1) { fprintf(stderr, "kernel_launch: occupancy query says %d\n", per_cu); per_cu = 1; }
        (void)hipGetLastError();
        grid = cus - (cus % 8);
    }
    if (grid < 0) return;
    Args a{};
    for (int i = 0; i < 23; ++i) a.in[i] = (const float*)d_in[i];
    a.out = (float*)d_out; a.ws = (unsigned char*)d_ws; a.p2mask = 15;
    void* kargs[] = {&a};
#define ZERO_CTL() (void)hipMemsetAsync(d_ws, 0, 65536, stream)
#ifdef PROBE_DBL
    const int cuts[4] = {0, PROBE_DBL + 1, PROBE_DBL + 1, 5}; const int los[3] = {0, PROBE_DBL, PROBE_DBL + 1};
    for (int li = 0; li < 3; ++li) { a.ph_lo = los[li]; a.ph_hi = cuts[li + 1]; if (a.ph_lo >= a.ph_hi) continue; ZERO_CTL();
#ifdef PROBE_P2MASK
        a.p2mask = (li == 1) ? PROBE_P2MASK : 15;
#endif
        hipError_t e = hipLaunchCooperativeKernel((const void*)hymba_fwd, dim3(grid), dim3(512), kargs, LDS_BYTES, stream);
        if (e != hipSuccess) fprintf(stderr, "kernel_launch: cooperative launch failed: %s (grid %d)\n", hipGetErrorString(e), grid); }
#else
    a.ph_lo = 0; a.ph_hi = 5; ZERO_CTL();
    hipError_t e = hipLaunchCooperativeKernel((const void*)hymba_fwd, dim3(grid), dim3(512), kargs, LDS_BYTES, stream);
    if (e != hipSuccess) fprintf(stderr, "kernel_launch: cooperative launch failed: %s (grid %d)\n", hipGetErrorString(e), grid);
#endif
}
```

```cpp
#include <hip/hip_runtime.h>
#include <hip/hip_cooperative_groups.h>
#include <cstdio>
#include <cstdint>
namespace cg = cooperative_groups;
namespace pg8 {
#define PG8_LAS __attribute__((address_space(3)))
typedef unsigned short bf16_t;
typedef short bf16x8 __attribute__((ext_vector_type(8)));
typedef float f32x4 __attribute__((ext_vector_type(4)));
typedef unsigned u32x4 __attribute__((ext_vector_type(4)));
constexpr int BM = 256, BK = 64, HALF = 128, HTB = HALF * BK * 2  , STAGE_BYTES = 8 * HTB, NXCD = 8, WGM = 8;

__host__ __device__ __forceinline__ int lds_byte(int r, int c) { const int st = (r >> 4) * 2 + (c >> 5), rr = r & 15, cc = c & 31, ob = rr * 64 + cc * 2; return st * 1024 + (ob ^ (((ob >> 9) & 1) << 5)); }
__host__ __device__ __forceinline__ void stage_rc(int b, int& R, int& C) { const int st = b / 1024, sb = b % 1024, swz = sb ^ (((sb >> 9) & 1) << 5); R = (st >> 1) * 16 + swz / 64; C = (st & 1) * 32 + (swz % 64) / 2; }
__host__ __device__ __forceinline__ int perm32(int rho) { const int n = rho >> 4, i = rho & 15; return 8 * (i >> 2) + 4 * n + (i & 3); }

struct Unit { int pm, pn; };
struct Gemm { const bf16_t* A; const bf16_t* Bt; int M, N, K, lda, ldb; };

struct StaticOrder {
    int nM, nN, nwg, G, c;
    __host__ __device__ void init(int M, int N, int G_, int c_) { nM = M / BM; nN = N / BM; nwg = nM * nN; G = G_; c = c_; }
    __host__ __device__ bool next(int i, Unit& u) const {
        const long L = (long)i * G + c; if (L >= nwg) return false;
        int wgid = (int)L; { const int q = nwg / NXCD, r = nwg % NXCD, xcd = wgid % NXCD, off = wgid / NXCD; wgid = (xcd < r ? xcd * (q + 1) : r * (q + 1) + (xcd - r) * q) + off; }
        const int nig = WGM * nN, gid = wgid / nig, fm = gid * WGM, gsz = (nM - fm) < WGM ? (nM - fm) : WGM;
        u.pm = fm + ((wgid % nig) % gsz); u.pn = (wgid % nig) / gsz; return true;
    }
    __device__ __forceinline__ void a_ready(const Unit&) const {}
    __device__ __forceinline__ void done(const Unit&) const {}
};

__device__ __forceinline__ unsigned cvt_pk_bf16(float lo, float hi) { unsigned r; asm volatile("v_cvt_pk_bf16_f32 %0, %1, %2" : "=v"(r) : "v"(lo), "v"(hi)); return r; }
template <class Epi, class Sched, bool ALIGN_EPI = false, bool SP2 = false>
__device__ __forceinline__ void gemm_phase(PG8_LAS unsigned char* lds, const Gemm g, const Sched& S, const Epi& E) {
    const int tid = threadIdx.x, wid = __builtin_amdgcn_readfirstlane(tid >> 6), lane = tid & 63, wr = wid >> 2, wc = wid & 3, fr = lane & 15, fq = lane >> 4;
    const int K = g.K, nt = K / BK;
    unsigned voffA[2], voffB[2];
#pragma unroll
    for (int i = 0; i < 2; ++i) { int R, C; stage_rc(tid * 16 + i * 8192, R, C); const int Rb = Epi::PERM ? ((R & ~31) + perm32(R & 31)) : R;
        voffA[i] = (unsigned)(R * g.lda + C) * 2u; voffB[i] = (unsigned)(Rb * g.ldb + C) * 2u; }
    const size_t kstep = (size_t)(BK * 2);
    const size_t hstepA = (size_t)HALF * g.lda * 2, hstepB = (size_t)HALF * g.ldb * 2;
    const size_t tstepA = 2 * hstepA, tstepB = 2 * hstepB;
    const unsigned ldsw = (unsigned)wid * 1024u;
    const int aoff = lds_byte(wr * 64 + fr, fq * 8), boff = lds_byte(wc * 32 + fr, fq * 8);
#define PG8_SA(b, h) (((b) * 2 + (h)) * HTB)
#define PG8_SB(b, h) ((4 + (b) * 2 + (h)) * HTB)
#define PG8_STAGE(bufoff, gbase, voff) do { _Pragma("unroll") for (int _i = 0; _i < 2; ++_i) \
        __builtin_amdgcn_global_load_lds((const unsigned*)((const char*)(gbase) + (voff)[_i]), (PG8_LAS unsigned*)(lds + (bufoff) + ldsw + _i * 8192), 16, 0, 0); } while (0)
#define PG8_LDA(dst, b, h) do { _Pragma("unroll") for (int m = 0; m < 4; ++m) _Pragma("unroll") for (int k = 0; k < 2; ++k) dst[m][k] = *(const PG8_LAS bf16x8*)(lds + PG8_SA(b, h) + aoff + m * 2048 + k * 1024); } while (0)
#define PG8_LDB(dst, b, h) do { _Pragma("unroll") for (int n = 0; n < 2; ++n) _Pragma("unroll") for (int k = 0; k < 2; ++k) dst[n][k] = *(const PG8_LAS bf16x8*)(lds + PG8_SB(b, h) + boff + n * 2048 + k * 1024); } while (0)
#define PG8_MMA(ai, bj, At, Bt) do { __builtin_amdgcn_s_setprio(1); _Pragma("unroll") for (int m = 0; m < 4; ++m) _Pragma("unroll") for (int n = 0; n < 2; ++n) _Pragma("unroll") for (int k = 0; k < 2; ++k) \
        acc[ai][bj][m][n] = __builtin_amdgcn_mfma_f32_16x16x32_bf16(Bt[n][k], At[m][k], acc[ai][bj][m][n], 0, 0, 0); __builtin_amdgcn_s_setprio(0); } while (0)
#define PG8_WAIT_V(n) asm volatile("s_waitcnt vmcnt(" #n ")" ::: "memory")
#define PG8_WAIT_L(n) asm volatile("s_waitcnt lgkmcnt(" #n ")" ::: "memory")
#define PG8_BAR __builtin_amdgcn_s_barrier()
#define PG8_SCHED __builtin_amdgcn_sched_barrier(0)
    Unit cur, nxt; int ui = 0;
    if (!S.next(0, cur)) return;
    f32x4 acc[2][2][4][2];
#pragma unroll
    for (int a = 0; a < 2; ++a)
#pragma unroll
        for (int b = 0; b < 2; ++b)
#pragma unroll
            for (int m = 0; m < 4; ++m)
#pragma unroll
                for (int n = 0; n < 2; ++n) acc[a][b][m][n] = (f32x4){0.f, 0.f, 0.f, 0.f};
    bf16x8 At[4][2], B0[2][2], B1[2][2];
    const char* cA = (const char*)g.A + (size_t)cur.pm * tstepA; const char* cB = (const char*)g.Bt + (size_t)cur.pn * tstepB;
    S.a_ready(cur);
    if constexpr (SP2) {
        PG8_STAGE(PG8_SB(0, 0), cB, voffB); PG8_STAGE(PG8_SB(0, 1), cB + hstepB, voffB); PG8_STAGE(PG8_SA(0, 0), cA, voffA); PG8_STAGE(PG8_SA(0, 1), cA + hstepA, voffA);
        if (wr == 1) PG8_BAR;
        PG8_WAIT_V(2); PG8_BAR;
        PG8_STAGE(PG8_SB(1, 0), cB + kstep, voffB); PG8_STAGE(PG8_SA(1, 0), cA + kstep, voffA); PG8_STAGE(PG8_SB(1, 1), cB + hstepB + kstep, voffB);
        PG8_WAIT_V(6); PG8_BAR;
    } else {
        PG8_STAGE(PG8_SB(0, 0), cB, voffB); PG8_STAGE(PG8_SA(0, 0), cA, voffA); PG8_STAGE(PG8_SB(0, 1), cB + hstepB, voffB); PG8_STAGE(PG8_SA(0, 1), cA + hstepA, voffA);
        if (wr == 1) PG8_BAR;
        PG8_WAIT_V(4); PG8_BAR;
        PG8_STAGE(PG8_SB(1, 0), cB + kstep, voffB); PG8_STAGE(PG8_SA(1, 0), cA + kstep, voffA); PG8_STAGE(PG8_SB(1, 1), cB + hstepB + kstep, voffB);
        PG8_WAIT_V(6); PG8_BAR;
    }
    for (;;) {
        const bool has_next = S.next(ui + 1, nxt);
        const char* nA = has_next ? (const char*)g.A + (size_t)nxt.pm * tstepA : cA; const char* nB = has_next ? (const char*)g.Bt + (size_t)nxt.pn * tstepB : cB;
        for (int t = 0; t < nt; t += 2) {
            const bool last = (t == nt - 2);
            const char* a1 = cA + (size_t)(t + 1) * kstep;
            const char* a2 = last ? nA : cA + (size_t)(t + 2) * kstep; const char* b2 = last ? nB : cB + (size_t)(t + 2) * kstep;
            const char* a3 = a2 + kstep; const char* b3 = b2 + kstep;
            if (last && has_next) S.a_ready(nxt);
            if constexpr (SP2) {
            PG8_LDB(B0, 0, 0); PG8_LDB(B1, 0, 1); PG8_SCHED; PG8_LDA(At, 0, 0); PG8_STAGE(PG8_SA(1, 1), a1 + hstepA, voffA);
            PG8_WAIT_V(8); PG8_WAIT_L(0); PG8_BAR; PG8_MMA(0, 0, At, B0); PG8_MMA(0, 1, At, B1); PG8_BAR; PG8_SCHED;
            PG8_LDA(At, 0, 1); PG8_STAGE(PG8_SB(0, 0), b2, voffB); PG8_STAGE(PG8_SB(0, 1), b2 + hstepB, voffB); PG8_STAGE(PG8_SA(0, 0), a2, voffA);
            PG8_WAIT_V(8); PG8_WAIT_L(0); PG8_BAR; PG8_MMA(1, 0, At, B0); PG8_MMA(1, 1, At, B1); PG8_BAR; PG8_SCHED;
            PG8_LDB(B0, 1, 0); PG8_LDB(B1, 1, 1); PG8_SCHED; PG8_LDA(At, 1, 0); PG8_STAGE(PG8_SA(0, 1), a2 + hstepA, voffA);
            PG8_WAIT_V(8); PG8_WAIT_L(0); PG8_BAR; PG8_MMA(0, 0, At, B0); PG8_MMA(0, 1, At, B1); PG8_BAR; PG8_SCHED;
            PG8_LDA(At, 1, 1); PG8_STAGE(PG8_SB(1, 0), b3, voffB); PG8_STAGE(PG8_SB(1, 1), b3 + hstepB, voffB); PG8_STAGE(PG8_SA(1, 0), a3, voffA);
            PG8_WAIT_V(8); PG8_WAIT_L(0); PG8_BAR; PG8_MMA(1, 0, At, B0); PG8_MMA(1, 1, At, B1); PG8_BAR; PG8_SCHED;
            } else {
            PG8_LDB(B0, 0, 0); PG8_SCHED; PG8_LDA(At, 0, 0); PG8_STAGE(PG8_SA(1, 1), a1 + hstepA, voffA);
            PG8_WAIT_L(8); PG8_BAR; PG8_WAIT_L(0); PG8_MMA(0, 0, At, B0); PG8_BAR; PG8_SCHED;
            PG8_LDB(B1, 0, 1); PG8_STAGE(PG8_SB(0, 0), b2, voffB);
            PG8_BAR; PG8_WAIT_L(0); PG8_MMA(0, 1, At, B1); PG8_BAR;
            PG8_LDA(At, 0, 1); PG8_STAGE(PG8_SA(0, 0), a2, voffA);
            PG8_BAR; PG8_WAIT_L(0); PG8_MMA(1, 0, At, B0); PG8_BAR; PG8_SCHED;
            PG8_STAGE(PG8_SB(0, 1), b2 + hstepB, voffB);
            PG8_WAIT_V(6); PG8_BAR; PG8_MMA(1, 1, At, B1); PG8_BAR;
            PG8_LDB(B0, 1, 0); PG8_SCHED; PG8_LDA(At, 1, 0); PG8_STAGE(PG8_SA(0, 1), a2 + hstepA, voffA);
            PG8_WAIT_L(8); PG8_BAR; PG8_WAIT_L(0); PG8_MMA(0, 0, At, B0); PG8_BAR; PG8_SCHED;
            PG8_LDB(B1, 1, 1); PG8_STAGE(PG8_SB(1, 0), b3, voffB);
            PG8_BAR; PG8_WAIT_L(0); PG8_MMA(0, 1, At, B1); PG8_BAR;
            PG8_LDA(At, 1, 1); PG8_STAGE(PG8_SA(1, 0), a3, voffA);
            PG8_BAR; PG8_WAIT_L(0); PG8_MMA(1, 0, At, B0); PG8_BAR; PG8_SCHED;
            PG8_STAGE(PG8_SB(1, 1), b3 + hstepB, voffB);
            PG8_WAIT_V(6); PG8_BAR; PG8_MMA(1, 1, At, B1); PG8_BAR;
            }
        }
        if constexpr (ALIGN_EPI) { if (wr == 0) PG8_BAR; }
        if constexpr (!Epi::AFTER_DRAIN) { E(acc, cur, wr, wc, fr, fq); S.done(cur); }
        if (!has_next) break;
#pragma unroll
        for (int a = 0; a < 2; ++a)
#pragma unroll
            for (int b = 0; b < 2; ++b)
#pragma unroll
                for (int m = 0; m < 4; ++m)
#pragma unroll
                    for (int n = 0; n < 2; ++n) acc[a][b][m][n] = (f32x4){0.f, 0.f, 0.f, 0.f};
        cur = nxt; cA = nA; cB = nB; ++ui;
        if constexpr (ALIGN_EPI) { if (wr == 1) PG8_BAR; }
    }
    PG8_WAIT_V(0);
    if constexpr (!ALIGN_EPI) { if (wr == 0) PG8_BAR; }
    PG8_BAR;
    if constexpr (Epi::AFTER_DRAIN) { E.fused(acc, cur, wr, wc, fr, fq, lds, wid, lane); S.done(cur); }
#undef PG8_SA
#undef PG8_SB
#undef PG8_STAGE
#undef PG8_LDA
#undef PG8_LDB
#undef PG8_MMA
#undef PG8_WAIT_V
#undef PG8_WAIT_L
#undef PG8_BAR
#undef PG8_SCHED
}
}

#ifndef PG8_SP2
#define PG8_SP2 true
#endif
#ifndef PG8_ALIGN
#define PG8_ALIGN true
#endif

constexpr int DM = 1024, NB = 16, SEQ = 2048, NMETA = 16, TP = SEQ + NMETA;
constexpr int DB = 32, DS = 32;
constexpr int MP = NB * TP, MS = DB * DS, M = MP + MS;
constexpr int DIN = 5120, DMIX = 2048;
constexpr int NSEQ = NB + DB;
constexpr float EPS = 1e-6f;
static_assert(M % 256 == 0, "M tiles");

constexpr size_t MiB = 1u << 20;
constexpr size_t ACT = (size_t)M * 1024 * 2;
constexpr size_t WS_WIN = 1 * MiB, WS_W2 = 11 * MiB, WS_WOUT = 13 * MiB;
constexpr size_t WS_XN = 20 * MiB;
constexpr size_t WS_XR = WS_XN + ACT, WS_GR = WS_XR + ACT, WS_V = WS_GR + ACT, WS_GC = WS_V + ACT, WS_YCAT = WS_GC + ACT;
constexpr size_t WS_END = WS_YCAT + 2 * ACT;
constexpr size_t WS_PART = WS_XR;

constexpr size_t O_YP = 0, O_YS = (size_t)NB * SEQ * DM, O_RGH_P = O_YS + (size_t)MS * DM, O_RGC_P = O_RGH_P + NB * 1024,
                 O_CVC_P = O_RGC_P + NB * 3 * 1024, O_RGH_S = O_CVC_P + NB * 30 * 1024, O_RGC_S = O_RGH_S + DB * 1024,
                 O_CVC_S = O_RGC_S + DB * 3 * 1024, O_END = O_CVC_S + DB * 30 * 1024;

constexpr int LDS_BYTES = 147456;

#define GAS __attribute__((address_space(1)))
#define LAS __attribute__((address_space(3)))
typedef unsigned short bf16;
typedef unsigned v4u __attribute__((ext_vector_type(4)));
typedef unsigned v2u __attribute__((ext_vector_type(2)));
typedef float f32x4 __attribute__((ext_vector_type(4)));
typedef float f32x2 __attribute__((ext_vector_type(2)));
typedef short bf16x8 __attribute__((ext_vector_type(8)));
#define LDS_WAIT() asm volatile("s_waitcnt lgkmcnt(0)" ::: "memory")
__device__ __forceinline__ void lds_barrier() { asm volatile("s_waitcnt lgkmcnt(0)\n\ts_barrier" ::: "memory"); }

__device__ __forceinline__ unsigned pk2(float lo, float hi) { return pg8::cvt_pk_bf16(lo, hi); }
__device__ __forceinline__ float bflo(unsigned u) { return __builtin_bit_cast(float, u << 16); }
__device__ __forceinline__ float bfhi(unsigned u) { return __builtin_bit_cast(float, u & 0xffff0000u); }
__device__ __forceinline__ float fsigmoid(float x) { return __builtin_amdgcn_rcpf(1.0f + __builtin_amdgcn_exp2f(-1.4426950408889634f * x)); }
__device__ __forceinline__ float fsilu(float x) { return x * fsigmoid(x); }
__device__ __forceinline__ float wave_sum(float v) {
    v += __builtin_bit_cast(float, __builtin_amdgcn_update_dpp(0, __builtin_bit_cast(int, v), 0xB1, 0xf, 0xf, true));
    v += __builtin_bit_cast(float, __builtin_amdgcn_update_dpp(0, __builtin_bit_cast(int, v), 0x4E, 0xf, 0xf, true));
    v += __builtin_bit_cast(float, __builtin_amdgcn_update_dpp(0, __builtin_bit_cast(int, v), 0x141, 0xf, 0xf, true));
    v += __builtin_bit_cast(float, __builtin_amdgcn_update_dpp(0, __builtin_bit_cast(int, v), 0x140, 0xf, 0xf, true));
    const int iv = __builtin_bit_cast(int, v);
    const float r0 = __builtin_bit_cast(float, __builtin_amdgcn_readlane(iv, 0)), r1 = __builtin_bit_cast(float, __builtin_amdgcn_readlane(iv, 16));
    const float r2 = __builtin_bit_cast(float, __builtin_amdgcn_readlane(iv, 32)), r3 = __builtin_bit_cast(float, __builtin_amdgcn_readlane(iv, 48));
    return (r0 + r1) + (r2 + r3);
}

struct Args { const float* in[23]; float* out; unsigned char* ws; int ph_lo, ph_hi, p2mask, pad; };

struct Epi1 {
    static constexpr bool PERM = true, AFTER_DRAIN = false;
    bf16 *XR, *GR, *V, *GC;
    __device__ __forceinline__ void operator()(const pg8::f32x4 (&acc)[2][2][4][2], const pg8::Unit& u, int wr, int wc, int fr, int fq) const {
        const int row0 = u.pm * 256 + wr * 64 + fr; const int pn = u.pn;
        if (pn >= 8 && pn < 16) {
            const int col0 = 128 * (pn - 8) + wc * 32 + 8 * fq;
#pragma unroll
            for (int ai = 0; ai < 2; ++ai)
#pragma unroll
                for (int m = 0; m < 4; ++m) {
                    float o[8];
#pragma unroll
                    for (int n = 0; n < 2; ++n)
#pragma unroll
                        for (int e = 0; e < 4; ++e) o[4 * n + e] = acc[ai][0][m][n][e] * fsigmoid(acc[ai][1][m][n][e]);
                    v4u w; w.x = pk2(o[0], o[1]); w.y = pk2(o[2], o[3]); w.z = pk2(o[4], o[5]); w.w = pk2(o[6], o[7]);
                    *(v4u*)(V + (size_t)(row0 + ai * 128 + m * 16) * 1024 + col0) = w;
                }
        } else {
            bf16* base; int colt; bool act;
            if (pn < 4) { base = XR; colt = pn * 256; act = false; }
            else if (pn < 8) { base = GR; colt = (pn - 4) * 256; act = true; }
            else { base = GC; colt = (pn - 16) * 256; act = true; }
            const int col0 = colt + wc * 32 + 8 * fq;
#pragma unroll
            for (int ai = 0; ai < 2; ++ai)
#pragma unroll
                for (int m = 0; m < 4; ++m) {
                    bf16* rowp = base + (size_t)(row0 + ai * 128 + m * 16) * 1024 + col0;
#pragma unroll
                    for (int bj = 0; bj < 2; ++bj) {
                        float o[8];
#pragma unroll
                        for (int n = 0; n < 2; ++n)
#pragma unroll
                            for (int e = 0; e < 4; ++e) { const float x = acc[ai][bj][m][n][e]; o[4 * n + e] = act ? fsilu(x) : x; }
                        v4u w; w.x = pk2(o[0], o[1]); w.y = pk2(o[2], o[3]); w.z = pk2(o[4], o[5]); w.w = pk2(o[6], o[7]);
                        *(v4u*)(rowp + bj * 128) = w;
                    }
                }
        }
    }
};
struct Epi2 {
    static constexpr bool PERM = true, AFTER_DRAIN = false;
    bf16* YCAT; const bf16* GC; const float* bias;
    __device__ __forceinline__ void operator()(const pg8::f32x4 (&acc)[2][2][4][2], const pg8::Unit& u, int wr, int wc, int fr, int fq) const {
        const int row0 = u.pm * 256 + wr * 64 + fr, col0 = u.pn * 256 + wc * 32 + 8 * fq;
        f32x4 bv[2][2];
#pragma unroll
        for (int bj = 0; bj < 2; ++bj)
#pragma unroll
            for (int n = 0; n < 2; ++n) bv[bj][n] = *(const f32x4*)(bias + col0 + bj * 128 + 4 * n);
#pragma unroll
        for (int ai = 0; ai < 2; ++ai)
#pragma unroll
            for (int m = 0; m < 4; ++m) {
                const size_t r = (size_t)(row0 + ai * 128 + m * 16);
#pragma unroll
                for (int bj = 0; bj < 2; ++bj) {
                    const v4u g = *(const v4u*)(GC + r * 1024 + col0 + bj * 128);
                    const f32x4 v0 = acc[ai][bj][m][0] + bv[bj][0], v1 = acc[ai][bj][m][1] + bv[bj][1];
                    v4u w; w.x = pk2(v0[0] * bflo(g.x), v0[1] * bfhi(g.x)); w.y = pk2(v0[2] * bflo(g.y), v0[3] * bfhi(g.y));
                    w.z = pk2(v1[0] * bflo(g.z), v1[1] * bfhi(g.z)); w.w = pk2(v1[2] * bflo(g.w), v1[3] * bfhi(g.w));
                    *(v4u*)(YCAT + r * 2048 + 1024 + col0 + bj * 128) = w;
                }
            }
    }
};
struct Epi3 {
    static constexpr bool PERM = false, AFTER_DRAIN = false;
    float* C;
    __device__ __forceinline__ void operator()(const pg8::f32x4 (&acc)[2][2][4][2], const pg8::Unit& u, int wr, int wc, int fr, int fq) const {
        const int row0 = u.pm * 256 + wr * 64 + fr, col0 = u.pn * 256 + wc * 32 + 4 * fq;
#pragma unroll
        for (int ai = 0; ai < 2; ++ai)
#pragma unroll
            for (int m = 0; m < 4; ++m) { float* rowp = C + (size_t)(row0 + ai * 128 + m * 16) * 1024 + col0;
#pragma unroll
                for (int bj = 0; bj < 2; ++bj)
#pragma unroll
                    for (int n = 0; n < 2; ++n) *(f32x4*)(rowp + bj * 128 + n * 16) = acc[ai][bj][m][n]; }
    }
};

constexpr size_t CTL_CNT = 0, CTL_SLOTS = 65536, CTL_BF = 655360, CTL_NSP = 917504;
struct OrderP4 {
    int nwg, G, c;
    __device__ void init(int M_, int G_, int c_) { nwg = (M_ / 256) * 4; G = G_; c = c_; }
    __device__ bool next(int i, pg8::Unit& u) const { const int L = i * G + c; if (L >= nwg) return false; u.pm = L >> 2; u.pn = L & 3; return true; }
    __device__ __forceinline__ void a_ready(const pg8::Unit&) const {}
    __device__ __forceinline__ void done(const pg8::Unit&) const {}
};
struct TailOrder {
    int j;
    __device__ bool next(int i, pg8::Unit& u) const { if (i != 0 || j < 0 || j >= 20) return false; u.pm = 128 + (j >> 2); u.pn = j & 3; return true; }
    __device__ __forceinline__ void a_ready(const pg8::Unit&) const {}
    __device__ __forceinline__ void done(const pg8::Unit&) const {}
};
struct EpiFinal {
    static constexpr bool PERM = false, AFTER_DRAIN = false;
    const float* xp; const float* xs; float* out; const float* g; float* slots; unsigned* cnt; LAS float* scr;
    const float* part;
    __device__ __forceinline__ void operator()(pg8::f32x4 (&acc)[2][2][4][2], const pg8::Unit& u, int wr, int wc, int fr, int fq) const {
        const int tid = threadIdx.x, lane = tid & 63, wid = __builtin_amdgcn_readfirstlane(tid >> 6);
        if (part) {
            const float* pb = part + (size_t)(u.pm * 256 + wr * 64 + fr) * 1024 + u.pn * 256 + wc * 32 + 4 * fq;
#pragma unroll
            for (int ai = 0; ai < 2; ++ai)
#pragma unroll
                for (int m = 0; m < 4; ++m) {
#pragma unroll
                    for (int bj = 0; bj < 2; ++bj)
#pragma unroll
                        for (int n = 0; n < 2; ++n) acc[ai][bj][m][n] += *(const f32x4*)(pb + (size_t)(ai * 128 + m * 16) * 1024 + bj * 128 + n * 16);
                    asm volatile("" ::: "memory");
                }
        }
        LAS float* P = scr; LAS float* S = scr + 1024;
#pragma unroll
        for (int ai = 0; ai < 2; ++ai)
#pragma unroll
            for (int m = 0; m < 4; ++m) {
                float s = 0.f;
#pragma unroll
                for (int bj = 0; bj < 2; ++bj)
#pragma unroll
                    for (int n = 0; n < 2; ++n) { const pg8::f32x4 x = acc[ai][bj][m][n]; s += (x[0] * x[0] + x[1] * x[1]) + (x[2] * x[2] + x[3] * x[3]); }
                s += __shfl_xor(s, 16); s += __shfl_xor(s, 32);
                if (fq == 0) P[(ai * 128 + wr * 64 + m * 16 + fr) * 4 + wc] = s;
            }
        asm volatile("s_waitcnt lgkmcnt(0)" ::: "memory"); __builtin_amdgcn_s_barrier(); asm volatile("" ::: "memory");
        if (tid < 256) { const f32x4 p = *(const LAS f32x4*)(P + tid * 4);
            __hip_atomic_store(slots + ((size_t)(u.pm * 256 + tid) * 4 + u.pn), (p.x + p.y) + (p.z + p.w), __ATOMIC_RELAXED, __HIP_MEMORY_SCOPE_AGENT); }
        asm volatile("s_waitcnt vmcnt(0)" ::: "memory");
        if (wid < 4 && lane == 0) __hip_atomic_fetch_add(cnt + 64 * u.pm, 1u, __ATOMIC_RELAXED, __HIP_MEMORY_SCOPE_AGENT);
        if (wid == 0) {
            unsigned spins = 0;
            while ((unsigned)__builtin_amdgcn_readfirstlane(__hip_atomic_load(cnt + 64 * u.pm, __ATOMIC_RELAXED, __HIP_MEMORY_SCOPE_AGENT)) < 16u) { __builtin_amdgcn_s_sleep(2); if (++spins > (1u << 22)) break; }
            __builtin_amdgcn_fence(__ATOMIC_ACQUIRE, "agent");
        }
        asm volatile("s_waitcnt vmcnt(0) lgkmcnt(0)" ::: "memory"); __builtin_amdgcn_s_barrier(); asm volatile("" ::: "memory");
        if (tid < 256) { const float* sl = slots + (size_t)(u.pm * 256 + tid) * 4; float t = 0.f;
#pragma unroll
            for (int q = 0; q < 4; ++q) t += __hip_atomic_load(sl + q, __ATOMIC_RELAXED, __HIP_MEMORY_SCOPE_AGENT);
            S[tid] = 1.0f / sqrtf(t * (1.f / 1024.f) + EPS); }
        asm volatile("s_waitcnt lgkmcnt(0)" ::: "memory"); __builtin_amdgcn_s_barrier(); asm volatile("" ::: "memory");
        const int col0 = u.pn * 256 + wc * 32 + 4 * fq;
        f32x4 gv[2][2];
#pragma unroll
        for (int bj = 0; bj < 2; ++bj)
#pragma unroll
            for (int n = 0; n < 2; ++n) gv[bj][n] = *(const f32x4*)(g + col0 + bj * 128 + n * 16);
#pragma unroll
        for (int ai = 0; ai < 2; ++ai)
#pragma unroll
            for (int m = 0; m < 4; ++m) {
                const int rl = ai * 128 + wr * 64 + m * 16 + fr, r = u.pm * 256 + rl; const float rs = S[rl];
                const float* xrow; float* orow; bool ok = true;
                if (r < MP) { const int b = r / TP, t = r - b * TP; ok = t >= NMETA; const size_t o = ((size_t)b * SEQ + (ok ? t - NMETA : 0)) * DM; xrow = xp + o; orow = out + O_YP + o; }
                else { const size_t o = (size_t)(r - MP) * DM; xrow = xs + o; orow = out + O_YS + o; }
                if (ok) {
#pragma unroll
                    for (int bj = 0; bj < 2; ++bj)
#pragma unroll
                        for (int n = 0; n < 2; ++n) { const f32x4 xv = *(const f32x4*)(xrow + col0 + bj * 128 + n * 16);
                            *(f32x4*)(orow + col0 + bj * 128 + n * 16) = xv + acc[ai][bj][m][n] * rs * gv[bj][n]; }
                }
                asm volatile("" ::: "memory");
            }
    }
};

__device__ __forceinline__ void p0_transpose_item(const float* W, int K, int N, bf16* WT, int k0, int n0, int dst_row0, LAS float* scr, int lane) {
#pragma unroll 8
    for (int i = 0; i < 32; ++i) { const int kk = 2 * i + (lane >> 5); scr[kk * 33 + (lane & 31)] = W[(size_t)(k0 + kk) * N + n0 + (lane & 31)]; }
    LDS_WAIT();
    const int c = lane & 7;
#pragma unroll
    for (int j = 0; j < 4; ++j) { const int n = (lane >> 3) + 8 * j; const LAS float* s = scr + (8 * c) * 33 + n;
        v4u o; o.x = pk2(s[0 * 33], s[1 * 33]); o.y = pk2(s[2 * 33], s[3 * 33]); o.z = pk2(s[4 * 33], s[5 * 33]); o.w = pk2(s[6 * 33], s[7 * 33]);
        *(v4u*)(WT + (size_t)(dst_row0 + n) * K + k0 + 8 * c) = o; }
    LDS_WAIT();
}
__device__ __forceinline__ int win_dst_row(int n) {
    if (n < 2048 || n >= 4096) return n;
    if (n < 3072) { const int c = n - 2048; return 2048 + 256 * (c >> 7) + (c & 127); }
    const int c = n - 3072; return 2048 + 256 * (c >> 7) + 128 + (c & 127);
}
__device__ __forceinline__ const float* x_row_ptr(const float* xp, const float* xs, const float* meta, int r) {
    if (r < MP) { const int b = r / TP, t = r - b * TP; return t < NMETA ? meta + (size_t)t * DM : xp + ((size_t)b * SEQ + (t - NMETA)) * DM; }
    return xs + (size_t)(r - MP) * DM;
}
__device__ __forceinline__ void p0_prologue(const Args& a, LAS unsigned char* lds, int gw, int NGW, int wave, int lane) {
    LAS float* scr = (LAS float*)(lds + wave * 16384);
    constexpr int I_IN = 16 * 160, I_W2 = 16 * 32, I_WO = 32 * 32;
    bf16* WinT = (bf16*)(a.ws + WS_WIN); bf16* W2T = (bf16*)(a.ws + WS_W2); bf16* WoT = (bf16*)(a.ws + WS_WOUT);
    for (int it = gw; it < I_IN + I_W2 + I_WO; it += NGW) {
        int r = it;
        if (r < I_IN) { const int kb = r / 160, nb = r % 160; p0_transpose_item(a.in[7], 1024, DIN, WinT, 64 * kb, 32 * nb, win_dst_row(32 * nb), scr, lane); continue; } r -= I_IN;
        if (r < I_W2) { const int kb = r / 32, nb = r % 32; p0_transpose_item(a.in[19], 1024, 1024, W2T, 64 * kb, 32 * nb, 32 * nb, scr, lane); continue; } r -= I_W2;
        { const int kb = r / 32, nb = r % 32; p0_transpose_item(a.in[21], 2048, 1024, WoT, 64 * kb, 32 * nb, 32 * nb, scr, lane); }
    }
    if (gw < 133) { if (lane == 0) *((unsigned*)(a.ws + CTL_CNT) + 64 * gw) = 0u; }
    {
        bf16* BF = (bf16*)(a.ws + CTL_BF); float* NSP = (float*)(a.ws + CTL_NSP);
        for (int i = gw * 64 + lane; i < 2 * 16 * 4096; i += NGW * 64) {
            const int mat = i >> 16, r = i & 65535, h = r >> 12, k = (r >> 6) & 63, n = r & 63;
            const float v = (mat ? a.in[12] : a.in[10])[r] * -1.4426950408889634f;
            const int f = mat * 8 + (n >> 4) * 2 + (k >> 5), ln = ((k & 31) >> 3) * 16 + (n & 15), e = k & 7;
            BF[((size_t)(h * 16 + f) * 64 + ln) * 8 + e] = (bf16)(pk2(v, 0.f) & 0xffffu);
        }
        for (int c = gw * 64 + lane; c < 1024; c += NGW * 64) { const float x = -a.in[14][c]; const float sp = fmaxf(x, 0.f) + log1pf(expf(-fabsf(x))); NSP[c] = -8.0f * sp * 1.4426950408889634f; }
    }
    bf16* XN = (bf16*)(a.ws + WS_XN);
    const f32x4* gp = (const f32x4*)a.in[6] + lane;
    f32x4 g[4];
#pragma unroll
    for (int j = 0; j < 4; ++j) g[j] = gp[64 * j];
    for (int r = gw; r < M; r += NGW) {
        const f32x4* xr = (const f32x4*)x_row_ptr(a.in[0], a.in[1], a.in[5], r) + lane;
        f32x4 v[4]; float s = 0.f;
#pragma unroll
        for (int j = 0; j < 4; ++j) { v[j] = xr[64 * j]; s += (v[j].x * v[j].x + v[j].y * v[j].y) + (v[j].z * v[j].z + v[j].w * v[j].w); }
        const float rstd = 1.0f / sqrtf(wave_sum(s) * (1.f / DM) + EPS);
        v2u* o8 = (v2u*)(XN + (size_t)r * DM) + lane;
#pragma unroll
        for (int j = 0; j < 4; ++j) { v2u o; o.x = pk2(v[j].x * rstd * g[j].x, v[j].y * rstd * g[j].y); o.y = pk2(v[j].z * rstd * g[j].z, v[j].w * rstd * g[j].w); o8[64 * j] = o; }
    }
}

constexpr int RG_XS0 = 0, RG_XS_SZ = 20160, RG_GS0 = 40320, RG_GS_SZ = 18432, RG_XC = 77184, RG_TOT = 112000, RG_CW = 120192, RG_BF = 121472;
constexpr int XS_STRIDE = 144, XC_STRIDE = 68;

template <bool PACKED>
__device__ __forceinline__ void rg_prefetch(v4u (&px)[3], v4u (&pg)[2], const bf16* XR, const bf16* GR, const float* rgbuf, int row0, int T, int h, int c0, int tid) {
#pragma unroll
    for (int j = 0; j < 3; ++j) {
        const int idx = tid + 512 * j, row = idx >> 3, seg = idx & 7;
        int t;
        if (PACKED) { const int rc = row < 140 ? row : 139; const int q = rc / 35; t = 32 * q + (rc - 35 * q - 3 >= 0 ? rc - 35 * q - 3 : 0); }
        else { t = c0 - 3 + row; t = t < 0 ? 0 : (t > T - 1 ? T - 1 : t); }
        px[j] = *(const v4u*)(XR + (size_t)(row0 + t) * 1024 + h * 64 + seg * 8);
    }
#pragma unroll
    for (int j = 0; j < 2; ++j) {
        const int idx = tid + 512 * j, row = idx >> 3, seg = idx & 7; int t = c0 + row; t = t > T - 1 ? T - 1 : t;
        pg[j] = *(const v4u*)(GR + (size_t)(row0 + t) * 1024 + h * 64 + seg * 8);
    }
}
template <bool PACKED>
__device__ __forceinline__ void rg_stage(LAS unsigned char* lds, int buf, const v4u (&px)[3], const v4u (&pg)[2], const float* rgbuf, int T, int h, int c0, int tid) {
    const v4u z = (v4u){0u, 0u, 0u, 0u};
#pragma unroll
    for (int j = 0; j < 3; ++j) { const int idx = tid + 512 * j, row = idx >> 3, seg = idx & 7;
        v4u v = px[j];
        if (PACKED) {
            if (row < 140) { const int q = row / 35, t = row - 35 * q - 3;
                if (t < 0) { const f32x4* p = (const f32x4*)(rgbuf + (size_t)q * 3072 + (3 + t) * 1024 + h * 64 + seg * 8); const f32x4 a = p[0], b = p[1];
                    v.x = pk2(a.x, a.y); v.y = pk2(a.z, a.w); v.z = pk2(b.x, b.y); v.w = pk2(b.z, b.w); } }
        } else { const int t = c0 - 3 + row; v = (t >= 0 && t < T) ? v : z; }
        if (row < 140) *(LAS v4u*)(lds + RG_XS0 + buf * RG_XS_SZ + row * XS_STRIDE + seg * 16) = v; }
#pragma unroll
    for (int j = 0; j < 2; ++j) { const int idx = tid + 512 * j, row = idx >> 3, seg = idx & 7; const v4u v = (c0 + row < T) ? pg[j] : z;
        *(LAS v4u*)(lds + RG_GS0 + buf * RG_GS_SZ + row * XS_STRIDE + seg * 16) = v; }
}

template <bool PACKED>
__device__ __forceinline__ void rg_item(const Args& a, LAS unsigned char* lds, int sq, int h) {
    const int tid = threadIdx.x, lane = tid & 63, w = __builtin_amdgcn_readfirstlane(tid >> 6), fr = lane & 15, fq = lane >> 4;
    const bf16* XR = (const bf16*)(a.ws + WS_XR); const bf16* GR = (const bf16*)(a.ws + WS_GR); bf16* YCAT = (bf16*)(a.ws + WS_YCAT);
    const int row0 = PACKED ? MP + 128 * sq : sq * TP, T = PACKED ? 128 : TP, nch = PACKED ? 1 : (TP + 127) / 128;
    const float* rgbuf = PACKED ? a.in[3] + (size_t)(4 * sq) * 3072 : nullptr;
    LAS float* cwl = (LAS float*)(lds + RG_CW);
    if (tid < 320) { const int k = tid >> 6, c = tid & 63; cwl[tid] = (k < 4) ? a.in[8][k * 1024 + h * 64 + c] : a.in[9][h * 64 + c]; }
    { const v4u* src = (const v4u*)(a.ws + CTL_BF + (size_t)h * 16384) + tid * 2; LAS v4u* dst = (LAS v4u*)(lds + RG_BF) + tid * 2; dst[0] = src[0]; dst[1] = src[1]; }
    float ba_[4], bx_[4], nsp[4], hc[4];
#pragma unroll
    for (int nt = 0; nt < 4; ++nt) { const int c = h * 64 + 16 * nt + fr; ba_[nt] = -1.4426950408889634f * a.in[11][c]; bx_[nt] = -1.4426950408889634f * a.in[13][c]; nsp[nt] = ((const float*)(a.ws + CTL_NSP))[c];
        hc[nt] = PACKED ? a.in[2][(size_t)(4 * sq + (w >> 1)) * 1024 + c] : 0.f; }
    const int xrow_base = PACKED ? 35 * (w >> 1) + 16 * (w & 1) : 16 * w;

    v4u px[3], pg[2];
    rg_prefetch<PACKED>(px, pg, XR, GR, rgbuf, row0, T, h, 0, tid);
    rg_stage<PACKED>(lds, 0, px, pg, rgbuf, T, h, 0, tid);
    if (nch > 1) { rg_prefetch<PACKED>(px, pg, XR, GR, rgbuf, row0, T, h, 128, tid); rg_stage<PACKED>(lds, 1, px, pg, rgbuf, T, h, 128, tid); }
    lds_barrier();
    LAS float* xcw = (LAS float*)(lds + RG_XC + w * (16 * XC_STRIDE * 4));
    LAS unsigned char* ysw = (LAS unsigned char*)xcw;
    for (int ch = 0; ch < nch; ++ch) {
        const int c0 = ch * 128, buf = ch & 1;
        if (ch + 2 < nch) rg_prefetch<PACKED>(px, pg, XR, GR, rgbuf, row0, T, h, c0 + 256, tid);
        const LAS unsigned char* xs = lds + RG_XS0 + buf * RG_XS_SZ; const LAS unsigned char* gs = lds + RG_GS0 + buf * RG_GS_SZ;
        bf16x8 Af[2];
#pragma unroll
        for (int ks = 0; ks < 2; ++ks) {
            const int cb = 32 * ks + 8 * fq;
            f32x4 lo = *(const LAS f32x4*)(cwl + 256 + cb), hi = *(const LAS f32x4*)(cwl + 256 + cb + 4);
#pragma unroll
            for (int k = 0; k < 4; ++k) {
                const v4u xv = *(const LAS v4u*)(xs + (xrow_base + fr + k) * XS_STRIDE + cb * 2);
                const f32x4 wl = *(const LAS f32x4*)(cwl + 64 * k + cb), wh = *(const LAS f32x4*)(cwl + 64 * k + cb + 4);
                lo.x += wl.x * bflo(xv.x); lo.y += wl.y * bfhi(xv.x); lo.z += wl.z * bflo(xv.y); lo.w += wl.w * bfhi(xv.y);
                hi.x += wh.x * bflo(xv.z); hi.y += wh.y * bfhi(xv.z); hi.z += wh.z * bflo(xv.w); hi.w += wh.w * bfhi(xv.w);
            }
            v4u u; u.x = pk2(lo.x, lo.y); u.y = pk2(lo.z, lo.w); u.z = pk2(hi.x, hi.y); u.w = pk2(hi.z, hi.w);
            Af[ks] = __builtin_bit_cast(bf16x8, u);
            *(LAS f32x4*)(xcw + fr * XC_STRIDE + cb) = lo; *(LAS f32x4*)(xcw + fr * XC_STRIDE + cb + 4) = hi;
        }
        f32x4 accA[4], accX[4];
#pragma unroll
        for (int nt = 0; nt < 4; ++nt) { accA[nt] = (f32x4){ba_[nt], ba_[nt], ba_[nt], ba_[nt]}; accX[nt] = (f32x4){bx_[nt], bx_[nt], bx_[nt], bx_[nt]};
#pragma unroll
            for (int ks = 0; ks < 2; ++ks) { const bf16x8 Ba = *(const LAS bf16x8*)(lds + RG_BF + ((nt * 2 + ks) * 64 + lane) * 16), Bx = *(const LAS bf16x8*)(lds + RG_BF + ((8 + nt * 2 + ks) * 64 + lane) * 16);
                                             accA[nt] = __builtin_amdgcn_mfma_f32_16x16x32_bf16(Af[ks], Ba, accA[nt], 0, 0, 0);
                                             accX[nt] = __builtin_amdgcn_mfma_f32_16x16x32_bf16(Af[ks], Bx, accX[nt], 0, 0, 0); } }
        LDS_WAIT();
        float hl[4][4], pl[4][4], sg[4][4], PE[4], HE[4];
#pragma unroll
        for (int nt = 0; nt < 4; ++nt) {
            float P = 1.f, H = 0.f;
#pragma unroll
            for (int j = 0; j < 4; ++j) {
                const int row = 4 * fq + j, cc = 16 * nt + fr;
                const float xc = xcw[row * XC_STRIDE + cc];
                const unsigned short gsv = *(const LAS unsigned short*)(gs + (16 * w + row) * XS_STRIDE + cc * 2);
                sg[nt][j] = __builtin_bit_cast(float, (unsigned)gsv << 16);
                float r = __builtin_amdgcn_rcpf(1.0f + __builtin_amdgcn_exp2f(accA[nt][j])); const float ig = __builtin_amdgcn_rcpf(1.0f + __builtin_amdgcn_exp2f(accX[nt][j]));
                if (!PACKED && c0 + 16 * w + row >= T) r = 0.f;
                const float av = __builtin_amdgcn_exp2f(r * nsp[nt]);
                const float bv = __builtin_amdgcn_sqrtf(fmaf(-av, av, 1.0f)) * (ig * xc);
                H = fmaf(av, H, bv); P *= av; hl[nt][j] = H; pl[nt][j] = P;
            }
            float Pi = P, Hi = H;
            { const float tp = __shfl_up(Pi, 16), th = __shfl_up(Hi, 16); if (fq >= 1) { Hi = fmaf(Pi, th, Hi); Pi *= tp; } }
            { const float tp = __shfl_up(Pi, 32), th = __shfl_up(Hi, 32); if (fq >= 2) { Hi = fmaf(Pi, th, Hi); Pi *= tp; } }
            { const float tp = __shfl_up(Pi, 16), th = __shfl_up(Hi, 16); PE[nt] = fq >= 1 ? tp : 1.f; HE[nt] = fq >= 1 ? th : 0.f; }
            if (fq == 3) *(LAS f32x2*)(lds + RG_TOT + ((buf * 8 + w) * 64 + 16 * nt + fr) * 8) = (f32x2){Pi, Hi};
        }
        lds_barrier();
#pragma unroll
        for (int nt = 0; nt < 4; ++nt) {
            float cin;
            if (PACKED) {
                const f32x2 tp = *(const LAS f32x2*)(lds + RG_TOT + ((buf * 8 + (w & 6)) * 64 + 16 * nt + fr) * 8);
                const f32x2 tq = *(const LAS f32x2*)(lds + RG_TOT + ((buf * 8 + (w | 1)) * 64 + 16 * nt + fr) * 8);
                const float mid = fmaf(tp.x, hc[nt], tp.y);
                cin = (w & 1) ? mid : hc[nt];
                hc[nt] = fmaf(tq.x, mid, tq.y);
            } else {
                float run = hc[nt]; cin = 0.f;
#pragma unroll
                for (int ww = 0; ww < 8; ++ww) { const f32x2 t = *(const LAS f32x2*)(lds + RG_TOT + ((buf * 8 + ww) * 64 + 16 * nt + fr) * 8);
                    if (ww == w) cin = run; run = fmaf(t.x, run, t.y); }
                hc[nt] = run;
            }
            const float Gc = fmaf(PE[nt], cin, HE[nt]);
#pragma unroll
            for (int j = 0; j < 4; ++j) { const float hv = fmaf(pl[nt][j], Gc, hl[nt][j]); const float y = hv * sg[nt][j];
                *(LAS unsigned short*)(ysw + (4 * fq + j) * XS_STRIDE + (16 * nt + fr) * 2) = (unsigned short)(pk2(y, 0.f) & 0xffffu); }
        }
        LDS_WAIT();
        { const int row = lane >> 2, q = lane & 3, t = c0 + 16 * w + row;
          const v4u y0 = *(const LAS v4u*)(ysw + row * XS_STRIDE + q * 32), y1 = *(const LAS v4u*)(ysw + row * XS_STRIDE + q * 32 + 16);
          LDS_WAIT();
          if (ch + 2 < nch) { asm volatile("s_waitcnt vmcnt(0)" ::: "memory"); rg_stage<PACKED>(lds, buf, px, pg, rgbuf, T, h, c0 + 256, tid); asm volatile("" ::: "memory"); }
          if (t < T) { bf16* dst = YCAT + (size_t)(row0 + t) * 2048 + h * 64 + q * 16; *(v4u*)dst = y0; *(v4u*)(dst + 8) = y1; } }
    }
    if (PACKED) { if ((w & 1) && fq == 0) {
#pragma unroll
        for (int nt = 0; nt < 4; ++nt) a.out[O_RGH_S + (size_t)(4 * sq + (w >> 1)) * 1024 + h * 64 + 16 * nt + fr] = hc[nt]; }
    } else { if (w == 0 && fq == 0) {
#pragma unroll
        for (int nt = 0; nt < 4; ++nt) a.out[O_RGH_P + (size_t)sq * 1024 + h * 64 + 16 * nt + fr] = hc[nt]; } }
    lds_barrier();
}

constexpr int CV_GB = 131072;
__device__ __forceinline__ void cv_unit(const Args& a, LAS unsigned char* lds, int s, int sb0, int sb1, const f32x2 (&cw)[31], f32x2 cb) {
    const int tid = threadIdx.x, lane = tid & 63, w = __builtin_amdgcn_readfirstlane(tid >> 6);
    const bf16* V = (const bf16*)(a.ws + WS_V); bf16* VN = (bf16*)(a.ws + WS_XN);
    int row0; const float* cvbuf = nullptr;
    if (s < NB) row0 = s * TP; else { const int q = s - NB; row0 = MP + q * DS; cvbuf = a.in[4] + (size_t)q * 30 * 1024; }
    unsigned win[30], cur[16], nxt[16];
    if (cvbuf) {
#pragma unroll
        for (int i = 0; i < 30; ++i) { const f32x2 f = *(const f32x2*)(cvbuf + i * 1024 + 2 * tid); win[i] = pk2(f.x, f.y); }
    } else {
#pragma unroll
        for (int i = 0; i < 30; ++i) { const int j = 16 * sb0 + i - 30; const unsigned u = *(const unsigned*)(V + (size_t)(row0 + (j < 0 ? 0 : j)) * 1024 + 2 * tid); win[i] = j < 0 ? 0u : u; }
    }
#pragma unroll
    for (int i = 0; i < 16; ++i) { cur[i] = *(const unsigned*)(V + (size_t)(row0 + 16 * sb0 + i) * 1024 + 2 * tid); nxt[i] = 0u; }
    const LAS f32x4* gl = (const LAS f32x4*)(lds + CV_GB) + lane; const LAS f32x4* bl = (const LAS f32x4*)(lds + CV_GB + 4096) + lane;
    for (int sb = sb0; sb < sb1; ++sb) {
        { const int sbn = sb + 1 < sb1 ? sb + 1 : sb;
#pragma unroll
            for (int i = 0; i < 16; ++i) nxt[i] = *(const unsigned*)(V + (size_t)(row0 + 16 * sbn + i) * 1024 + 2 * tid);
        }
        f32x2 o[16];
#pragma unroll
        for (int k = 0; k < 16; ++k) o[k] = cb;
#pragma unroll
        for (int i = 0; i < 46; ++i) {
            const unsigned u = i < 30 ? win[i] : cur[i - 30];
            const f32x2 x = (f32x2){bflo(u), bfhi(u)};
#pragma unroll
            for (int k = 0; k < 16; ++k) { const int tap = i - k; if (tap >= 0 && tap <= 30) o[k] = cw[tap] * x + o[k]; }
        }
        LAS float* cbuf = (LAS float*)(lds + ((sb - sb0) & 1) * 65536);
#pragma unroll
        for (int k = 0; k < 16; ++k) *(LAS f32x2*)(cbuf + k * 1024 + 2 * tid) = o[k];
#pragma unroll
        for (int i = 0; i < 14; ++i) win[i] = win[i + 16];
#pragma unroll
        for (int i = 0; i < 16; ++i) win[14 + i] = cur[i];
        lds_barrier();
        f32x4 v[2][4]; float s1[2], s2[2];
#pragma unroll
        for (int rr = 0; rr < 2; ++rr) { s1[rr] = 0.f; s2[rr] = 0.f;
#pragma unroll
            for (int j = 0; j < 4; ++j) { const f32x4 x = *(const LAS f32x4*)(cbuf + (2 * w + rr) * 1024 + 4 * lane + 256 * j); v[rr][j] = x;
                s1[rr] += (x.x + x.y) + (x.z + x.w); s2[rr] += (x.x * x.x + x.y * x.y) + (x.z * x.z + x.w * x.w); } }
#pragma unroll
        for (int rr = 0; rr < 2; ++rr) { s1[rr] = wave_sum(s1[rr]); s2[rr] = wave_sum(s2[rr]); }
        v2u ov[2][4];
#pragma unroll
        for (int rr = 0; rr < 2; ++rr) {
            const float mean = s1[rr] * (1.f / 1024.f), var = fmaxf(s2[rr] * (1.f / 1024.f) - mean * mean, 0.f);
            const float rstd = 1.0f / sqrtf(var + EPS);
#pragma unroll
            for (int j = 0; j < 4; ++j) {
                const f32x4 y = (v[rr][j] - mean) * rstd * gl[64 * j] + bl[64 * j];
                ov[rr][j].x = pk2(fsilu(y.x), fsilu(y.y)); ov[rr][j].y = pk2(fsilu(y.z), fsilu(y.w));
            }
        }
        asm volatile("s_waitcnt vmcnt(0)" ::: "memory");
#pragma unroll
        for (int i = 0; i < 16; ++i) cur[i] = nxt[i];
        asm volatile("" ::: "memory");
#pragma unroll
        for (int rr = 0; rr < 2; ++rr) { v2u* dst = (v2u*)(VN + (size_t)(row0 + 16 * sb + 2 * w + rr) * 1024) + lane;
#pragma unroll
            for (int j = 0; j < 4; ++j) dst[64 * j] = ov[rr][j]; }
    }
    lds_barrier();
}

constexpr size_t CTL_BAR = 36864;
constexpr int LDS_BARST = 143360;
#define XB_TMO      128
#define XB_XCNT(j)  (256  + 64 * (j))
#define XB_XSUB(j)  (1280 + 64 * (j))
#define XB_XGEN(j)  (2304 + 64 * (j))
#define XB_TOP      3328
#define XB_TOPGEN   3392
#define XCD_BAR_WORDS 3456
#define XB_SPIN_CAP (1u << 18)

__device__ __forceinline__ unsigned xb_ld(unsigned* p)              { return __hip_atomic_load(p, __ATOMIC_RELAXED, __HIP_MEMORY_SCOPE_AGENT); }
__device__ __forceinline__ unsigned xb_add(unsigned* p, unsigned v) { return __hip_atomic_fetch_add(p, v, __ATOMIC_RELAXED, __HIP_MEMORY_SCOPE_AGENT); }
__device__ __forceinline__ unsigned xb_xcc_id() { return (unsigned)__builtin_amdgcn_s_getreg((3 << 11) | 20) & 0xFu; }
#define XB_SPIN(cond, bar) do { unsigned _sp = 0; while (cond) { __builtin_amdgcn_s_sleep(1); \
    if ((++_sp & 255u) == 0u) { if (xb_ld(&(bar)[XB_TMO])) break; if (_sp > XB_SPIN_CAP) { atomicAdd(&(bar)[XB_TMO], 1u); break; } } } } while (0)

struct XcdBarrier {
    unsigned* bar; unsigned x;
    volatile LAS unsigned* st;
};

__device__ __forceinline__ XcdBarrier xcd_barrier_post(unsigned* bar, volatile LAS unsigned* st) {
    XcdBarrier b; b.bar = bar; b.x = xb_xcc_id(); b.st = st;
    if (threadIdx.x == 0) (void)xb_add(&bar[XB_XCNT(b.x)], 1u);
    return b;
}
__device__ __forceinline__ void xcd_barrier_complete(unsigned* bar, unsigned x, unsigned& nloc, unsigned& nx) {
    const unsigned G = gridDim.x * gridDim.y * gridDim.z;
    unsigned sum, cnt, mine, sp = 0u;
    for (;;) {
        sum = 0u; cnt = 0u; mine = 0u;
#pragma unroll
        for (unsigned j = 0; j < 16; ++j) { const unsigned c = xb_ld(&bar[XB_XCNT(j)]); sum += c; cnt += (c > 0u) ? 1u : 0u; mine = (j == x) ? c : mine; }
        if (sum == G) break;
        __builtin_amdgcn_s_sleep(1);
        if ((++sp & 255u) == 0u) { if (xb_ld(&bar[XB_TMO])) break; if (sp > XB_SPIN_CAP) { atomicAdd(&bar[XB_TMO], 1u); break; } }
    }
    nloc = mine > 0u ? mine : 1u; nx = cnt > 0u ? cnt : 1u;
}

__device__ __forceinline__ void xcd_barrier(const XcdBarrier& b) {
    asm volatile("s_waitcnt vmcnt(0)" ::: "memory");
    __syncthreads();
    if (threadIdx.x == 0) {
        unsigned* bar = b.bar;
        __builtin_amdgcn_s_waitcnt(0);
        unsigned nloc = b.st[0], nx = b.st[1];
        if (nloc == 0u) { xcd_barrier_complete(bar, b.x, nloc, nx); b.st[0] = nloc; b.st[1] = nx; }
        const unsigned old = xb_add(&bar[XB_XSUB(b.x)], 1u);
        const unsigned gen = old / nloc;
        if (old + 1u == (gen + 1u) * nloc) {
            __builtin_amdgcn_fence(__ATOMIC_RELEASE, "agent");
            asm volatile("s_waitcnt vmcnt(0)" ::: "memory");
            const unsigned og = xb_add(&bar[XB_TOP], 1u);
            const unsigned tg = og / nx;
            if (og + 1u == (tg + 1u) * nx) xb_add(&bar[XB_TOPGEN], 1u);
            else XB_SPIN(xb_ld(&bar[XB_TOPGEN]) == tg, bar);
            __builtin_amdgcn_fence(__ATOMIC_ACQUIRE, "agent");
            xb_add(&bar[XB_XGEN(b.x)], 1u);
            asm volatile("s_waitcnt vmcnt(0)" ::: "memory");
        } else {
            XB_SPIN(xb_ld(&bar[XB_XGEN(b.x)]) == gen, bar);
            __builtin_amdgcn_fence(__ATOMIC_ACQUIRE, "agent");
            asm volatile("s_waitcnt vmcnt(0)" ::: "memory");
        }
    }
    __syncthreads();
}

__global__ void __launch_bounds__(512, 2) hymba_fwd(Args args) {
    extern __shared__ __attribute__((aligned(16))) unsigned char lds_raw[];
    cg::grid_group grid = cg::this_grid();
    LAS unsigned char* lds = (LAS unsigned char*)lds_raw;
    const int tid = threadIdx.x, lane = tid & 63, wave = __builtin_amdgcn_readfirstlane(tid >> 6);
    const int G = gridDim.x, bx = blockIdx.x;
    const int vcu = (G % 8 == 0) ? (bx % 8) * (G / 8) + bx / 8 : bx;
    const int gw = vcu * 8 + wave, NGW = G * 8;
    const int lo = args.ph_lo, hi = args.ph_hi;
#define IN(k) (lo <= (k) && (k) < hi)
#define BOTH(k) (IN(k) && IN((k) + 1))
    unsigned char* ws = args.ws;
    if (tid < 2) ((volatile LAS unsigned*)(lds + LDS_BARST))[tid] = 0u;
    __syncthreads();
    const XcdBarrier bar = xcd_barrier_post((unsigned*)(ws + CTL_BAR), (volatile LAS unsigned*)(lds + LDS_BARST));
    if (args.ph_lo < 0) grid.sync();

    if (IN(0)) { p0_prologue(args, lds, gw, NGW, wave, lane); if (BOTH(0)) xcd_barrier(bar); }

    if (IN(1)) {
        pg8::Gemm g{(const bf16*)(ws + WS_XN), (const bf16*)(ws + WS_WIN), M, DIN, 1024, 1024, 1024}; pg8::StaticOrder S; S.init(M, DIN, G, bx);
        Epi1 E{(bf16*)(ws + WS_XR), (bf16*)(ws + WS_GR), (bf16*)(ws + WS_V), (bf16*)(ws + WS_GC)};
        pg8::gemm_phase<Epi1, pg8::StaticOrder, PG8_ALIGN, PG8_SP2>(lds, g, S, E);
        if (BOTH(1)) xcd_barrier(bar);
    }

    if (IN(2)) {
        __syncthreads();
        if (args.p2mask & 1) for (int it = bx; it < NB * 16; it += G) rg_item<false>(args, lds, it >> 4, it & 15);
        if (args.p2mask & 2) {
            for (int i = tid; i < 2048; i += 512) ((LAS float*)(lds + CV_GB))[i] = (i < 1024) ? args.in[17][i] : args.in[18][i - 1024];
            f32x2 cw[31];
#pragma unroll
            for (int k = 0; k < 31; ++k) cw[k] = *(const f32x2*)(args.in[15] + k * 1024 + 2 * tid);
            const f32x2 cb = *(const f32x2*)(args.in[16] + 2 * tid);
            __syncthreads();
            for (int it = bx; it < NB * 16; it += G) {
                const int q = it >> 4, j = it & 15, nrep = (j == 15) ? 2 : 1;
                for (int r = 0; r < nrep; ++r) {
                    int s, sb0, sb1;
                    if (j < 15) { s = q; sb0 = 9 * j; sb1 = (j == 14) ? TP / 16 : 9 * j + 9; } else { s = NB + 2 * q + r; sb0 = 0; sb1 = 2; }
                    cv_unit(args, lds, s, sb0, sb1, cw, cb);
                }
            }
        }
        if (args.p2mask & 4) for (int it = G - 1 - bx; it < 128; it += G) rg_item<true>(args, lds, it >> 4, it & 15);
        if (args.p2mask & 8) {
            const bf16* XR = (const bf16*)(ws + WS_XR); const bf16* V = (const bf16*)(ws + WS_V);
            const int gt = vcu * 512 + tid, NGT = G * 512;
            for (int i = gt; i < NSEQ * 33 * 512; i += NGT) {
                const int c2 = i & 511, rr = (i >> 9) % 33, s = (i >> 9) / 33;
                int row0, T; float* o3; float* o30;
                if (s < NB) { row0 = s * TP; T = TP; o3 = args.out + O_RGC_P + (size_t)s * 3 * 1024; o30 = args.out + O_CVC_P + (size_t)s * 30 * 1024; }
                else { const int q = s - NB; row0 = MP + q * DS; T = DS; o3 = args.out + O_RGC_S + (size_t)q * 3 * 1024; o30 = args.out + O_CVC_S + (size_t)q * 30 * 1024; }
                if (rr < 3) { const unsigned u = *(const unsigned*)(XR + (size_t)(row0 + T - 3 + rr) * 1024 + 2 * c2); *(f32x2*)(o3 + rr * 1024 + 2 * c2) = (f32x2){bflo(u), bfhi(u)}; }
                else { const int r2 = rr - 3; const unsigned u = *(const unsigned*)(V + (size_t)(row0 + T - 30 + r2) * 1024 + 2 * c2); *(f32x2*)(o30 + r2 * 1024 + 2 * c2) = (f32x2){bflo(u), bfhi(u)}; }
            }
        }
        if (BOTH(2)) xcd_barrier(bar);
    }

    if (IN(3)) {
        pg8::Gemm g{(const bf16*)(ws + WS_XN), (const bf16*)(ws + WS_W2), M, 1024, 1024, 1024, 1024}; pg8::StaticOrder S; S.init(M, 1024, G, bx);
        Epi2 E{(bf16*)(ws + WS_YCAT), (const bf16*)(ws + WS_GC), args.in[20]};
        pg8::gemm_phase<Epi2, pg8::StaticOrder, PG8_ALIGN, PG8_SP2>(lds, g, S, E);
        if (G == 256) {
            pg8::Gemm gp{(const bf16*)(ws + WS_YCAT), (const bf16*)(ws + WS_WOUT), M, 1024, 1024, 2048, 2048}; TailOrder Sp{bx - 20};
            Epi3 Ep{(float*)(ws + WS_PART)};
            pg8::gemm_phase<Epi3, TailOrder, PG8_ALIGN, PG8_SP2>(lds, gp, Sp, Ep);
        }
        if (BOTH(3)) xcd_barrier(bar);
    }

    if (IN(4)) {
        const bool ksplit = (G == 256);
        {
            pg8::Gemm g{(const bf16*)(ws + WS_YCAT), (const bf16*)(ws + WS_WOUT), M, 1024, 2048, 2048, 2048}; OrderP4 S; S.init(ksplit ? 128 * 256 : M, G, vcu);
            EpiFinal E{args.in[0], args.in[1], args.out, args.in[22], (float*)(ws + CTL_SLOTS), (unsigned*)(ws + CTL_CNT), (LAS float*)(lds + 131072), nullptr};
            pg8::gemm_phase<EpiFinal, OrderP4, true, PG8_SP2>(lds, g, S, E);
        }
        if (ksplit) {
            pg8::Gemm g{(const bf16*)(ws + WS_YCAT) + 1024, (const bf16*)(ws + WS_WOUT) + 1024, M, 1024, 1024, 2048, 2048}; TailOrder S{vcu};
            EpiFinal E{args.in[0], args.in[1], args.out, args.in[22], (float*)(ws + CTL_SLOTS), (unsigned*)(ws + CTL_CNT), (LAS float*)(lds + 131072), (const float*)(ws + WS_PART)};
            pg8::gemm_phase<EpiFinal, TailOrder, true, PG8_SP2>(lds, g, S, E);
        }
    }
#undef IN
#undef BOTH
}

extern "C" void kernel_launch(void* const* d_in, const int* in_sizes, int n_in, void* d_out, int out_size, void* d_ws, size_t ws_size, hipStream_t stream) {
    static int grid = 0;
    if (grid == 0) {
        if (n_in != 23 || out_size != (int)O_END || ws_size < WS_END) { fprintf(stderr, "kernel_launch: unexpected problem (n_in %d, out %d, ws %zu; need ws >= %zu)\n", n_in, out_size, ws_size, (size_t)WS_END); grid = -1; return; }
        int dev = 0, cus = 0, per_cu = 0;
        if (hipGetDevice(&dev) != hipSuccess || hipDeviceGetAttribute(&cus, hipDeviceAttributeMultiprocessorCount, dev) != hipSuccess) { grid = -1; return; }
        if (hipFuncSetAttribute((const void*)hymba_fwd, hipFuncAttributeMaxDynamicSharedMemorySize, LDS_BYTES) != hipSuccess) { fprintf(stderr, "kernel_launch: hipFuncSetAttribute failed\n"); grid = -1; return; }
        if (hipOccupancyMaxActiveBlocksPerMultiprocessor(&per_cu, (const void*)hymba_fwd, 512, LDS_BYTES) != hipSuccess || per_cu < 1) { fprintf(stderr, "kernel_launch: occupancy query says %d\n", per_cu); per_cu = 1; }
        (void)hipGetLastError();
        grid = cus - (cus % 8);
    }
    if (grid < 0) return;
    Args a{};
    for (int i = 0; i < 23; ++i) a.in[i] = (const float*)d_in[i];
    a.out = (float*)d_out; a.ws = (unsigned char*)d_ws; a.p2mask = 15;
    void* kargs[] = {&a};
#define ZERO_CTL() (void)hipMemsetAsync(d_ws, 0, 65536, stream)
#ifdef PROBE_DBL
    const int cuts[4] = {0, PROBE_DBL + 1, PROBE_DBL + 1, 5}; const int los[3] = {0, PROBE_DBL, PROBE_DBL + 1};
    for (int li = 0; li < 3; ++li) { a.ph_lo = los[li]; a.ph_hi = cuts[li + 1]; if (a.ph_lo >= a.ph_hi) continue; ZERO_CTL();
#ifdef PROBE_P2MASK
        a.p2mask = (li == 1) ? PROBE_P2MASK : 15;
#endif
        hipError_t e = hipLaunchCooperativeKernel((const void*)hymba_fwd, dim3(grid), dim3(512), kargs, LDS_BYTES, stream);
        if (e != hipSuccess) fprintf(stderr, "kernel_launch: cooperative launch failed: %s (grid %d)\n", hipGetErrorString(e), grid); }
#else
    a.ph_lo = 0; a.ph_hi = 5; ZERO_CTL();
    hipError_t e = hipLaunchCooperativeKernel((const void*)hymba_fwd, dim3(grid), dim3(512), kargs, LDS_BYTES, stream);
    if (e != hipSuccess) fprintf(stderr, "kernel_launch: cooperative launch failed: %s (grid %d)\n", hipGetErrorString(e), grid);
#endif
}
```

```cpp
#include <hip/hip_runtime.h>
#include <hip/hip_cooperative_groups.h>
#include <cstdio>
#include <cstdint>
namespace cg = cooperative_groups;
namespace pg8 {
#define PG8_LAS __attribute__((address_space(3)))
typedef unsigned short bf16_t;
typedef short bf16x8 __attribute__((ext_vector_type(8)));
typedef float f32x4 __attribute__((ext_vector_type(4)));
typedef unsigned u32x4 __attribute__((ext_vector_type(4)));
constexpr int BM = 256, BK = 64, HALF = 128, HTB = HALF * BK * 2  , STAGE_BYTES = 8 * HTB, NXCD = 8, WGM = 8;

__host__ __device__ __forceinline__ int lds_byte(int r, int c) { const int st = (r >> 4) * 2 + (c >> 5), rr = r & 15, cc = c & 31, ob = rr * 64 + cc * 2; return st * 1024 + (ob ^ (((ob >> 9) & 1) << 5)); }
__host__ __device__ __forceinline__ void stage_rc(int b, int& R, int& C) { const int st = b / 1024, sb = b % 1024, swz = sb ^ (((sb >> 9) & 1) << 5); R = (st >> 1) * 16 + swz / 64; C = (st & 1) * 32 + (swz % 64) / 2; }
__host__ __device__ __forceinline__ int perm32(int rho) { const int n = rho >> 4, i = rho & 15; return 8 * (i >> 2) + 4 * n + (i & 3); }

struct Unit { int pm, pn; };
struct Gemm { const bf16_t* A; const bf16_t* Bt; int M, N, K, lda, ldb; };

struct StaticOrder {
    int nM, nN, nwg, G, c;
    __host__ __device__ void init(int M, int N, int G_, int c_) { nM = M / BM; nN = N / BM; nwg = nM * nN; G = G_; c = c_; }
    __host__ __device__ bool next(int i, Unit& u) const {
        const long L = (long)i * G + c; if (L >= nwg) return false;
        int wgid = (int)L; { const int q = nwg / NXCD, r = nwg % NXCD, xcd = wgid % NXCD, off = wgid / NXCD; wgid = (xcd < r ? xcd * (q + 1) : r * (q + 1) + (xcd - r) * q) + off; }
        const int nig = WGM * nN, gid = wgid / nig, fm = gid * WGM, gsz = (nM - fm) < WGM ? (nM - fm) : WGM;
        u.pm = fm + ((wgid % nig) % gsz); u.pn = (wgid % nig) / gsz; return true;
    }
    __device__ __forceinline__ void a_ready(const Unit&) const {}
    __device__ __forceinline__ void done(const Unit&) const {}
};

__device__ __forceinline__ unsigned cvt_pk_bf16(float lo, float hi) { unsigned r; asm volatile("v_cvt_pk_bf16_f32 %0, %1, %2" : "=v"(r) : "v"(lo), "v"(hi)); return r; }
template <class Epi, class Sched, bool ALIGN_EPI = false, bool SP2 = false>
__device__ __forceinline__ void gemm_phase(PG8_LAS unsigned char* lds, const Gemm g, const Sched& S, const Epi& E) {
    const int tid = threadIdx.x, wid = __builtin_amdgcn_readfirstlane(tid >> 6), lane = tid & 63, wr = wid >> 2, wc = wid & 3, fr = lane & 15, fq = lane >> 4;
    const int K = g.K, nt = K / BK;
    unsigned voffA[2], voffB[2];
#pragma unroll
    for (int i = 0; i < 2; ++i) { int R, C; stage_rc(tid * 16 + i * 8192, R, C); const int Rb = Epi::PERM ? ((R & ~31) + perm32(R & 31)) : R;
        voffA[i] = (unsigned)(R * g.lda + C) * 2u; voffB[i] = (unsigned)(Rb * g.ldb + C) * 2u; }
    const size_t kstep = (size_t)(BK * 2);
    const size_t hstepA = (size_t)HALF * g.lda * 2, hstepB = (size_t)HALF * g.ldb * 2;
    const size_t tstepA = 2 * hstepA, tstepB = 2 * hstepB;
    const unsigned ldsw = (unsigned)wid * 1024u;
    const int aoff = lds_byte(wr * 64 + fr, fq * 8), boff = lds_byte(wc * 32 + fr, fq * 8);
#define PG8_SA(b, h) (((b) * 2 + (h)) * HTB)
#define PG8_SB(b, h) ((4 + (b) * 2 + (h)) * HTB)
#define PG8_STAGE(bufoff, gbase, voff) do { _Pragma("unroll") for (int _i = 0; _i < 2; ++_i) \
        __builtin_amdgcn_global_load_lds((const unsigned*)((const char*)(gbase) + (voff)[_i]), (PG8_LAS unsigned*)(lds + (bufoff) + ldsw + _i * 8192), 16, 0, 0); } while (0)
#define PG8_LDA(dst, b, h) do { _Pragma("unroll") for (int m = 0; m < 4; ++m) _Pragma("unroll") for (int k = 0; k < 2; ++k) dst[m][k] = *(const PG8_LAS bf16x8*)(lds + PG8_SA(b, h) + aoff + m * 2048 + k * 1024); } while (0)
#define PG8_LDB(dst, b, h) do { _Pragma("unroll") for (int n = 0; n < 2; ++n) _Pragma("unroll") for (int k = 0; k < 2; ++k) dst[n][k] = *(const PG8_LAS bf16x8*)(lds + PG8_SB(b, h) + boff + n * 2048 + k * 1024); } while (0)
#define PG8_MMA(ai, bj, At, Bt) do { __builtin_amdgcn_s_setprio(1); _Pragma("unroll") for (int m = 0; m < 4; ++m) _Pragma("unroll") for (int n = 0; n < 2; ++n) _Pragma("unroll") for (int k = 0; k < 2; ++k) \
        acc[ai][bj][m][n] = __builtin_amdgcn_mfma_f32_16x16x32_bf16(Bt[n][k], At[m][k], acc[ai][bj][m][n], 0, 0, 0); __builtin_amdgcn_s_setprio(0); } while (0)
#define PG8_WAIT_V(n) asm volatile("s_waitcnt vmcnt(" #n ")" ::: "memory")
#define PG8_WAIT_L(n) asm volatile("s_waitcnt lgkmcnt(" #n ")" ::: "memory")
#define PG8_BAR __builtin_amdgcn_s_barrier()
#define PG8_SCHED __builtin_amdgcn_sched_barrier(0)
    Unit cur, nxt; int ui = 0;
    if (!S.next(0, cur)) return;
    f32x4 acc[2][2][4][2];
#pragma unroll
    for (int a = 0; a < 2; ++a)
#pragma unroll
        for (int b = 0; b < 2; ++b)
#pragma unroll
            for (int m = 0; m < 4; ++m)
#pragma unroll
                for (int n = 0; n < 2; ++n) acc[a][b][m][n] = (f32x4){0.f, 0.f, 0.f, 0.f};
    bf16x8 At[4][2], B0[2][2], B1[2][2];
    const char* cA = (const char*)g.A + (size_t)cur.pm * tstepA; const char* cB = (const char*)g.Bt + (size_t)cur.pn * tstepB;
    S.a_ready(cur);
    if constexpr (SP2) {
        PG8_STAGE(PG8_SB(0, 0), cB, voffB); PG8_STAGE(PG8_SB(0, 1), cB + hstepB, voffB); PG8_STAGE(PG8_SA(0, 0), cA, voffA); PG8_STAGE(PG8_SA(0, 1), cA + hstepA, voffA);
        if (wr == 1) PG8_BAR;
        PG8_WAIT_V(2); PG8_BAR;
        PG8_STAGE(PG8_SB(1, 0), cB + kstep, voffB); PG8_STAGE(PG8_SA(1, 0), cA + kstep, voffA); PG8_STAGE(PG8_SB(1, 1), cB + hstepB + kstep, voffB);
        PG8_WAIT_V(6); PG8_BAR;
    } else {
        PG8_STAGE(PG8_SB(0, 0), cB, voffB); PG8_STAGE(PG8_SA(0, 0), cA, voffA); PG8_STAGE(PG8_SB(0, 1), cB + hstepB, voffB); PG8_STAGE(PG8_SA(0, 1), cA + hstepA, voffA);
        if (wr == 1) PG8_BAR;
        PG8_WAIT_V(4); PG8_BAR;
        PG8_STAGE(PG8_SB(1, 0), cB + kstep, voffB); PG8_STAGE(PG8_SA(1, 0), cA + kstep, voffA); PG8_STAGE(PG8_SB(1, 1), cB + hstepB + kstep, voffB);
        PG8_WAIT_V(6); PG8_BAR;
    }
    for (;;) {
        const bool has_next = S.next(ui + 1, nxt);
        const char* nA = has_next ? (const char*)g.A + (size_t)nxt.pm * tstepA : cA; const char* nB = has_next ? (const char*)g.Bt + (size_t)nxt.pn * tstepB : cB;
        for (int t = 0; t < nt; t += 2) {
            const bool last = (t == nt - 2);
            const char* a1 = cA + (size_t)(t + 1) * kstep;
            const char* a2 = last ? nA : cA + (size_t)(t + 2) * kstep; const char* b2 = last ? nB : cB + (size_t)(t + 2) * kstep;
            const char* a3 = a2 + kstep; const char* b3 = b2 + kstep;
            if (last && has_next) S.a_ready(nxt);
            if constexpr (SP2) {
            PG8_LDB(B0, 0, 0); PG8_LDB(B1, 0, 1); PG8_SCHED; PG8_LDA(At, 0, 0); PG8_STAGE(PG8_SA(1, 1), a1 + hstepA, voffA);
            PG8_WAIT_V(8); PG8_WAIT_L(0); PG8_BAR; PG8_MMA(0, 0, At, B0); PG8_MMA(0, 1, At, B1); PG8_BAR; PG8_SCHED;
            PG8_LDA(At, 0, 1); PG8_STAGE(PG8_SB(0, 0), b2, voffB); PG8_STAGE(PG8_SB(0, 1), b2 + hstepB, voffB); PG8_STAGE(PG8_SA(0, 0), a2, voffA);
            PG8_WAIT_V(8); PG8_WAIT_L(0); PG8_BAR; PG8_MMA(1, 0, At, B0); PG8_MMA(1, 1, At, B1); PG8_BAR; PG8_SCHED;
            PG8_LDB(B0, 1, 0); PG8_LDB(B1, 1, 1); PG8_SCHED; PG8_LDA(At, 1, 0); PG8_STAGE(PG8_SA(0, 1), a2 + hstepA, voffA);
            PG8_WAIT_V(8); PG8_WAIT_L(0); PG8_BAR; PG8_MMA(0, 0, At, B0); PG8_MMA(0, 1, At, B1); PG8_BAR; PG8_SCHED;
            PG8_LDA(At, 1, 1); PG8_STAGE(PG8_SB(1, 0), b3, voffB); PG8_STAGE(PG8_SB(1, 1), b3 + hstepB, voffB); PG8_STAGE(PG8_SA(1, 0), a3, voffA);
            PG8_WAIT_V(8); PG8_WAIT_L(0); PG8_BAR; PG8_MMA(1, 0, At, B0); PG8_MMA(1, 1, At, B1); PG8_BAR; PG8_SCHED;
            } else {
            PG8_LDB(B0, 0, 0); PG8_SCHED; PG8_LDA(At, 0, 0); PG8_STAGE(PG8_SA(1, 1), a1 + hstepA, voffA);
            PG8_WAIT_L(8); PG8_BAR; PG8_WAIT_L(0); PG8_MMA(0, 0, At, B0); PG8_BAR; PG8_SCHED;
            PG8_LDB(B1, 0, 1); PG8_STAGE(PG8_SB(0, 0), b2, voffB);
            PG8_BAR; PG8_WAIT_L(0); PG8_MMA(0, 1, At, B1); PG8_BAR;
            PG8_LDA(At, 0, 1); PG8_STAGE(PG8_SA(0, 0), a2, voffA);
            PG8_BAR; PG8_WAIT_L(0); PG8_MMA(1, 0, At, B0); PG8_BAR; PG8_SCHED;
            PG8_STAGE(PG8_SB(0, 1), b2 + hstepB, voffB);
            PG8_WAIT_V(6); PG8_BAR; PG8_MMA(1, 1, At, B1); PG8_BAR;
            PG8_LDB(B0, 1, 0); PG8_SCHED; PG8_LDA(At, 1, 0); PG8_STAGE(PG8_SA(0, 1), a2 + hstepA, voffA);
            PG8_WAIT_L(8); PG8_BAR; PG8_WAIT_L(0); PG8_MMA(0, 0, At, B0); PG8_BAR; PG8_SCHED;
            PG8_LDB(B1, 1, 1); PG8_STAGE(PG8_SB(1, 0), b3, voffB);
            PG8_BAR; PG8_WAIT_L(0); PG8_MMA(0, 1, At, B1); PG8_BAR;
            PG8_LDA(At, 1, 1); PG8_STAGE(PG8_SA(1, 0), a3, voffA);
            PG8_BAR; PG8_WAIT_L(0); PG8_MMA(1, 0, At, B0); PG8_BAR; PG8_SCHED;
            PG8_STAGE(PG8_SB(1, 1), b3 + hstepB, voffB);
            PG8_WAIT_V(6); PG8_BAR; PG8_MMA(1, 1, At, B1); PG8_BAR;
            }
        }
        if constexpr (ALIGN_EPI) { if (wr == 0) PG8_BAR; }
        if constexpr (!Epi::AFTER_DRAIN) { E(acc, cur, wr, wc, fr, fq); S.done(cur); }
        if (!has_next) break;
#pragma unroll
        for (int a = 0; a < 2; ++a)
#pragma unroll
            for (int b = 0; b < 2; ++b)
#pragma unroll
                for (int m = 0; m < 4; ++m)
#pragma unroll
                    for (int n = 0; n < 2; ++n) acc[a][b][m][n] = (f32x4){0.f, 0.f, 0.f, 0.f};
        cur = nxt; cA = nA; cB = nB; ++ui;
        if constexpr (ALIGN_EPI) { if (wr == 1) PG8_BAR; }
    }
    PG8_WAIT_V(0);
    if constexpr (!ALIGN_EPI) { if (wr == 0) PG8_BAR; }
    PG8_BAR;
    if constexpr (Epi::AFTER_DRAIN) { E.fused(acc, cur, wr, wc, fr, fq, lds, wid, lane); S.done(cur); }
#undef PG8_SA
#undef PG8_SB
#undef PG8_STAGE
#undef PG8_LDA
#undef PG8_LDB
#undef PG8_MMA
#undef PG8_WAIT_V
#undef PG8_WAIT_L
#undef PG8_BAR
#undef PG8_SCHED
}
}

#ifndef PG8_SP2
#define PG8_SP2 true
#endif
#ifndef PG8_ALIGN
#define PG8_ALIGN true
#endif

constexpr int DM = 1024, NB = 16, SEQ = 2048, NMETA = 16, TP = SEQ + NMETA;
constexpr int DB = 32, DS = 32;
constexpr int MP = NB * TP, MS = DB * DS, M = MP + MS;
constexpr int DIN = 5120, DMIX = 2048;
constexpr int NSEQ = NB + DB;
constexpr float EPS = 1e-6f;
static_assert(M % 256 == 0, "M tiles");

constexpr size_t MiB = 1u << 20;
constexpr size_t ACT = (size_t)M * 1024 * 2;
constexpr size_t WS_WIN = 1 * MiB, WS_W2 = 11 * MiB, WS_WOUT = 13 * MiB;
constexpr size_t WS_XN = 20 * MiB;
constexpr size_t WS_XR = WS_XN + ACT, WS_GR = WS_XR + ACT, WS_V = WS_GR + ACT, WS_GC = WS_V + ACT, WS_YCAT = WS_GC + ACT;
constexpr size_t WS_HALF = WS_YCAT + 2 * ACT;
constexpr size_t WS_END = WS_HALF + 100 * 262144;
constexpr size_t WS_PART = WS_XR;

constexpr size_t O_YP = 0, O_YS = (size_t)NB * SEQ * DM, O_RGH_P = O_YS + (size_t)MS * DM, O_RGC_P = O_RGH_P + NB * 1024,
                 O_CVC_P = O_RGC_P + NB * 3 * 1024, O_RGH_S = O_CVC_P + NB * 30 * 1024, O_RGC_S = O_RGH_S + DB * 1024,
                 O_CVC_S = O_RGC_S + DB * 3 * 1024, O_END = O_CVC_S + DB * 30 * 1024;

constexpr int LDS_BYTES = 147456;

#define GAS __attribute__((address_space(1)))
#define LAS __attribute__((address_space(3)))
typedef unsigned short bf16;
typedef unsigned v4u __attribute__((ext_vector_type(4)));
typedef unsigned v2u __attribute__((ext_vector_type(2)));
typedef float f32x4 __attribute__((ext_vector_type(4)));
typedef float f32x2 __attribute__((ext_vector_type(2)));
typedef short bf16x8 __attribute__((ext_vector_type(8)));
#define LDS_WAIT() asm volatile("s_waitcnt lgkmcnt(0)" ::: "memory")
__device__ __forceinline__ void lds_barrier() { asm volatile("s_waitcnt lgkmcnt(0)\n\ts_barrier" ::: "memory"); }

__device__ __forceinline__ unsigned pk2(float lo, float hi) { return pg8::cvt_pk_bf16(lo, hi); }
__device__ __forceinline__ float bflo(unsigned u) { return __builtin_bit_cast(float, u << 16); }
__device__ __forceinline__ float bfhi(unsigned u) { return __builtin_bit_cast(float, u & 0xffff0000u); }
__device__ __forceinline__ float fsigmoid(float x) { return __builtin_amdgcn_rcpf(1.0f + __builtin_amdgcn_exp2f(-1.4426950408889634f * x)); }
__device__ __forceinline__ float fsilu(float x) { return x * fsigmoid(x); }
__device__ __forceinline__ float wave_sum(float v) {
    v += __builtin_bit_cast(float, __builtin_amdgcn_update_dpp(0, __builtin_bit_cast(int, v), 0xB1, 0xf, 0xf, true));
    v += __builtin_bit_cast(float, __builtin_amdgcn_update_dpp(0, __builtin_bit_cast(int, v), 0x4E, 0xf, 0xf, true));
    v += __builtin_bit_cast(float, __builtin_amdgcn_update_dpp(0, __builtin_bit_cast(int, v), 0x141, 0xf, 0xf, true));
    v += __builtin_bit_cast(float, __builtin_amdgcn_update_dpp(0, __builtin_bit_cast(int, v), 0x140, 0xf, 0xf, true));
    const int iv = __builtin_bit_cast(int, v);
    const float r0 = __builtin_bit_cast(float, __builtin_amdgcn_readlane(iv, 0)), r1 = __builtin_bit_cast(float, __builtin_amdgcn_readlane(iv, 16));
    const float r2 = __builtin_bit_cast(float, __builtin_amdgcn_readlane(iv, 32)), r3 = __builtin_bit_cast(float, __builtin_amdgcn_readlane(iv, 48));
    return (r0 + r1) + (r2 + r3);
}

struct Args { const float* in[23]; float* out; unsigned char* ws; int ph_lo, ph_hi, p2mask, pad; };

struct Epi1 {
    static constexpr bool PERM = true, AFTER_DRAIN = false;
    bf16 *XR, *GR, *V, *GC;
    __device__ __forceinline__ void operator()(const pg8::f32x4 (&acc)[2][2][4][2], const pg8::Unit& u, int wr, int wc, int fr, int fq) const {
        const int row0 = u.pm * 256 + wr * 64 + fr; const int pn = u.pn;
        if (pn >= 8 && pn < 16) {
            const int col0 = 128 * (pn - 8) + wc * 32 + 8 * fq;
#pragma unroll
            for (int ai = 0; ai < 2; ++ai)
#pragma unroll
                for (int m = 0; m < 4; ++m) {
                    float o[8];
#pragma unroll
                    for (int n = 0; n < 2; ++n)
#pragma unroll
                        for (int e = 0; e < 4; ++e) o[4 * n + e] = acc[ai][0][m][n][e] * fsigmoid(acc[ai][1][m][n][e]);
                    v4u w; w.x = pk2(o[0], o[1]); w.y = pk2(o[2], o[3]); w.z = pk2(o[4], o[5]); w.w = pk2(o[6], o[7]);
                    *(v4u*)(V + (size_t)(row0 + ai * 128 + m * 16) * 1024 + col0) = w;
                }
        } else {
            bf16* base; int colt; bool act;
            if (pn < 4) { base = XR; colt = pn * 256; act = false; }
            else if (pn < 8) { base = GR; colt = (pn - 4) * 256; act = true; }
            else { base = GC; colt = (pn - 16) * 256; act = true; }
            const int col0 = colt + wc * 32 + 8 * fq;
#pragma unroll
            for (int ai = 0; ai < 2; ++ai)
#pragma unroll
                for (int m = 0; m < 4; ++m) {
                    bf16* rowp = base + (size_t)(row0 + ai * 128 + m * 16) * 1024 + col0;
#pragma unroll
                    for (int bj = 0; bj < 2; ++bj) {
                        float o[8];
#pragma unroll
                        for (int n = 0; n < 2; ++n)
#pragma unroll
                            for (int e = 0; e < 4; ++e) { const float x = acc[ai][bj][m][n][e]; o[4 * n + e] = act ? fsilu(x) : x; }
                        v4u w; w.x = pk2(o[0], o[1]); w.y = pk2(o[2], o[3]); w.z = pk2(o[4], o[5]); w.w = pk2(o[6], o[7]);
                        *(v4u*)(rowp + bj * 128) = w;
                    }
                }
        }
    }
};
struct Epi2 {
    static constexpr bool PERM = true, AFTER_DRAIN = false;
    bf16* YCAT; const bf16* GC; const float* bias;
    __device__ __forceinline__ void operator()(const pg8::f32x4 (&acc)[2][2][4][2], const pg8::Unit& u, int wr, int wc, int fr, int fq) const {
        const int row0 = u.pm * 256 + wr * 64 + fr, col0 = u.pn * 256 + wc * 32 + 8 * fq;
        const __amdgpu_buffer_rsrc_t rs = __builtin_amdgcn_make_buffer_rsrc(YCAT, 0, (int)((size_t)M * 2048 * 2), 0x00020000);
        f32x4 bv[2][2];
#pragma unroll
        for (int bj = 0; bj < 2; ++bj)
#pragma unroll
            for (int n = 0; n < 2; ++n) bv[bj][n] = *(const f32x4*)(bias + col0 + bj * 128 + 4 * n);
#pragma unroll
        for (int ai = 0; ai < 2; ++ai)
#pragma unroll
            for (int m = 0; m < 4; ++m) {
                const size_t r = (size_t)(row0 + ai * 128 + m * 16);
#pragma unroll
                for (int bj = 0; bj < 2; ++bj) {
                    const v4u g = *(const v4u*)(GC + r * 1024 + col0 + bj * 128);
                    const f32x4 v0 = acc[ai][bj][m][0] + bv[bj][0], v1 = acc[ai][bj][m][1] + bv[bj][1];
                    v4u w; w.x = pk2(v0[0] * bflo(g.x), v0[1] * bfhi(g.x)); w.y = pk2(v0[2] * bflo(g.y), v0[3] * bfhi(g.y));
                    w.z = pk2(v1[0] * bflo(g.z), v1[1] * bfhi(g.z)); w.w = pk2(v1[2] * bflo(g.w), v1[3] * bfhi(g.w));
                    __builtin_amdgcn_raw_buffer_store_b128(w, rs, (unsigned)((r * 2048 + 1024 + col0 + bj * 128) * 2), 0, 16);
                }
            }
    }
};
struct Epi3 {
    static constexpr bool PERM = false, AFTER_DRAIN = false;
    float* C;
    __device__ __forceinline__ void operator()(const pg8::f32x4 (&acc)[2][2][4][2], const pg8::Unit& u, int wr, int wc, int fr, int fq) const {
        const int row0 = u.pm * 256 + wr * 64 + fr, col0 = u.pn * 256 + wc * 32 + 4 * fq;
        const __amdgpu_buffer_rsrc_t rs = __builtin_amdgcn_make_buffer_rsrc(C, 0, (int)((size_t)M * 1024 * 4), 0x00020000);
#pragma unroll
        for (int ai = 0; ai < 2; ++ai)
#pragma unroll
            for (int m = 0; m < 4; ++m) {
#pragma unroll
                for (int bj = 0; bj < 2; ++bj)
#pragma unroll
                    for (int n = 0; n < 2; ++n) __builtin_amdgcn_raw_buffer_store_b128(__builtin_bit_cast(v4u, acc[ai][bj][m][n]), rs, (unsigned)(((size_t)(row0 + ai * 128 + m * 16) * 1024 + col0 + bj * 128 + n * 16) * 4), 0, 16); }
    }
};

constexpr size_t CTL_CNT = 0, CTL_SLOTS = 65536, CTL_BF = 655360, CTL_NSP = 917504;
constexpr size_t CTL_CNT3 = 52224, CTL_CNTP = 61440;
__device__ __forceinline__ void panel_publish(unsigned* cnt, int idx) {
    asm volatile("s_waitcnt vmcnt(0)" ::: "memory");
    if ((threadIdx.x & 63) == 0) __hip_atomic_fetch_add(cnt + 16 * idx, 1u, __ATOMIC_RELAXED, __HIP_MEMORY_SCOPE_AGENT);
}
__device__ __forceinline__ void panel_wait(const unsigned* c1, int i1, const unsigned* c2, int i2) {
    if (threadIdx.x < 64) {
        unsigned spins = 0;
        while ((unsigned)__builtin_amdgcn_readfirstlane(__hip_atomic_load(c1 + 16 * i1, __ATOMIC_RELAXED, __HIP_MEMORY_SCOPE_AGENT)) < 32u) { __builtin_amdgcn_s_sleep(4); if (++spins > (1u << 22)) break; }
        if (c2) { spins = 0; while ((unsigned)__builtin_amdgcn_readfirstlane(__hip_atomic_load(c2 + 16 * i2, __ATOMIC_RELAXED, __HIP_MEMORY_SCOPE_AGENT)) < 32u) { __builtin_amdgcn_s_sleep(4); if (++spins > (1u << 22)) break; } }
        __builtin_amdgcn_fence(__ATOMIC_ACQUIRE, "agent");
        asm volatile("s_waitcnt vmcnt(0)" ::: "memory");
    }
    asm volatile("" ::: "memory"); __builtin_amdgcn_s_barrier(); asm volatile("" ::: "memory");
}
struct OrderP4 {
    int nwg, G, c; unsigned* pub; const unsigned* dep;
    __device__ void init(int npanels, int G_, int c_, unsigned* pub_, const unsigned* dep_) { nwg = npanels * 4; G = G_; c = c_; pub = pub_; dep = dep_; }
    __device__ bool next(int i, pg8::Unit& u) const {
        int L = i * G + c;
        if (pub && G == 256) {
            if (i == 1 && c >= 80 && c < 100) return false;
            if (i == 2 && c >= 100 && c < 120) L = 256 + (c - 20);
        }
        if (L >= nwg) return false; u.pm = L >> 2; u.pn = L & 3; return true; }
    __device__ __forceinline__ void a_ready(const pg8::Unit& u) const { if (dep) panel_wait(dep, u.pm, nullptr, 0); }
    __device__ __forceinline__ void done(const pg8::Unit& u) const { if (pub) panel_publish(pub, u.pm); }
};
struct TailOrder {
    int j; unsigned* pub; const unsigned* dep; const unsigned* dep2;
    __device__ bool next(int i, pg8::Unit& u) const { if (i != 0 || j < 0 || j >= 20) return false; u.pm = 128 + (j >> 2); u.pn = j & 3; return true; }
    __device__ __forceinline__ void a_ready(const pg8::Unit& u) const { if (dep) panel_wait(dep, u.pm, dep2, u.pm - 128); }
    __device__ __forceinline__ void done(const pg8::Unit& u) const { if (pub) panel_publish(pub, u.pm - 128); }
};
struct EpiFinal {
    static constexpr bool PERM = false, AFTER_DRAIN = false;
    const float* xp; const float* xs; float* out; const float* g; float* slots; unsigned* cnt; LAS float* scr;
    const float* part;
    __device__ __forceinline__ void operator()(pg8::f32x4 (&acc)[2][2][4][2], const pg8::Unit& u, int wr, int wc, int fr, int fq) const {
        const int tid = threadIdx.x, lane = tid & 63, wid = __builtin_amdgcn_readfirstlane(tid >> 6);
        if (part) {
            const float* pb = part + (size_t)(u.pm * 256 + wr * 64 + fr) * 1024 + u.pn * 256 + wc * 32 + 4 * fq;
#pragma unroll
            for (int ai = 0; ai < 2; ++ai)
#pragma unroll
                for (int m = 0; m < 4; ++m) {
#pragma unroll
                    for (int bj = 0; bj < 2; ++bj)
#pragma unroll
                        for (int n = 0; n < 2; ++n) acc[ai][bj][m][n] += *(const f32x4*)(pb + (size_t)(ai * 128 + m * 16) * 1024 + bj * 128 + n * 16);
                    asm volatile("" ::: "memory");
                }
        }
        LAS float* P = scr; LAS float* S = scr + 1024;
#pragma unroll
        for (int ai = 0; ai < 2; ++ai)
#pragma unroll
            for (int m = 0; m < 4; ++m) {
                float s = 0.f;
#pragma unroll
                for (int bj = 0; bj < 2; ++bj)
#pragma unroll
                    for (int n = 0; n < 2; ++n) { const pg8::f32x4 x = acc[ai][bj][m][n]; s += (x[0] * x[0] + x[1] * x[1]) + (x[2] * x[2] + x[3] * x[3]); }
                s += __shfl_xor(s, 16); s += __shfl_xor(s, 32);
                if (fq == 0) P[(ai * 128 + wr * 64 + m * 16 + fr) * 4 + wc] = s;
            }
        asm volatile("s_waitcnt lgkmcnt(0)" ::: "memory"); __builtin_amdgcn_s_barrier(); asm volatile("" ::: "memory");
        if (tid < 256) { const f32x4 p = *(const LAS f32x4*)(P + tid * 4);
            __hip_atomic_store(slots + ((size_t)(u.pm * 256 + tid) * 4 + u.pn), (p.x + p.y) + (p.z + p.w), __ATOMIC_RELAXED, __HIP_MEMORY_SCOPE_AGENT); }
        asm volatile("s_waitcnt vmcnt(0)" ::: "memory");
        if (wid < 4 && lane == 0) __hip_atomic_fetch_add(cnt + 64 * u.pm, 1u, __ATOMIC_RELAXED, __HIP_MEMORY_SCOPE_AGENT);
        if (wid == 0) {
            unsigned spins = 0;
            while ((unsigned)__builtin_amdgcn_readfirstlane(__hip_atomic_load(cnt + 64 * u.pm, __ATOMIC_RELAXED, __HIP_MEMORY_SCOPE_AGENT)) < 16u) { __builtin_amdgcn_s_sleep(2); if (++spins > (1u << 22)) break; }
            __builtin_amdgcn_fence(__ATOMIC_ACQUIRE, "agent");
        }
        asm volatile("s_waitcnt vmcnt(0) lgkmcnt(0)" ::: "memory"); __builtin_amdgcn_s_barrier(); asm volatile("" ::: "memory");
        if (tid < 256) { const float* sl = slots + (size_t)(u.pm * 256 + tid) * 4; float t = 0.f;
#pragma unroll
            for (int q = 0; q < 4; ++q) t += __hip_atomic_load(sl + q, __ATOMIC_RELAXED, __HIP_MEMORY_SCOPE_AGENT);
            S[tid] = 1.0f / sqrtf(t * (1.f / 1024.f) + EPS); }
        asm volatile("s_waitcnt lgkmcnt(0)" ::: "memory"); __builtin_amdgcn_s_barrier(); asm volatile("" ::: "memory");
        const int col0 = u.pn * 256 + wc * 32 + 4 * fq;
        f32x4 gv[2][2];
#pragma unroll
        for (int bj = 0; bj < 2; ++bj)
#pragma unroll
            for (int n = 0; n < 2; ++n) gv[bj][n] = *(const f32x4*)(g + col0 + bj * 128 + n * 16);
#pragma unroll
        for (int ai = 0; ai < 2; ++ai)
#pragma unroll
            for (int m = 0; m < 4; ++m) {
                const int rl = ai * 128 + wr * 64 + m * 16 + fr, r = u.pm * 256 + rl; const float rs = S[rl];
                const float* xrow; float* orow; bool ok = true;
                if (r < MP) { const int b = r / TP, t = r - b * TP; ok = t >= NMETA; const size_t o = ((size_t)b * SEQ + (ok ? t - NMETA : 0)) * DM; xrow = xp + o; orow = out + O_YP + o; }
                else { const size_t o = (size_t)(r - MP) * DM; xrow = xs + o; orow = out + O_YS + o; }
                if (ok) {
#pragma unroll
                    for (int bj = 0; bj < 2; ++bj)
#pragma unroll
                        for (int n = 0; n < 2; ++n) { const f32x4 xv = *(const f32x4*)(xrow + col0 + bj * 128 + n * 16);
                            *(f32x4*)(orow + col0 + bj * 128 + n * 16) = xv + acc[ai][bj][m][n] * rs * gv[bj][n]; }
                }
                asm volatile("" ::: "memory");
            }
    }
};

constexpr size_t CTL_CNTH = 61952;
struct LimitedOrder : pg8::StaticOrder {
    int imax;
    __device__ bool next(int i, pg8::Unit& u) const { if (i >= imax) return false; return pg8::StaticOrder::next(i, u); }
};
struct OneOf : pg8::StaticOrder {
    int round; bool on; unsigned* pub; int slot;
    __device__ bool next(int i, pg8::Unit& u) const { if (i != 0 || !on) return false; return pg8::StaticOrder::next(round, u); }
    __device__ __forceinline__ void a_ready(const pg8::Unit&) const {}
    __device__ __forceinline__ void done(const pg8::Unit&) const { if (pub) { asm volatile("s_waitcnt vmcnt(0)" ::: "memory"); if ((threadIdx.x & 63) == 0) __hip_atomic_fetch_add(pub + 8 * slot, 1u, __ATOMIC_RELAXED, __HIP_MEMORY_SCOPE_AGENT); } }
};
struct EpiHalfOut {
    static constexpr bool PERM = true, AFTER_DRAIN = false;
    float* tile;
    __device__ __forceinline__ void operator()(const pg8::f32x4 (&acc)[2][2][4][2], const pg8::Unit&, int, int, int, int) const {
        const __amdgpu_buffer_rsrc_t rs = __builtin_amdgcn_make_buffer_rsrc(tile, 0, 262144, 0x00020000);
#pragma unroll
        for (int ai = 0; ai < 2; ++ai)
#pragma unroll
            for (int bj = 0; bj < 2; ++bj)
#pragma unroll
                for (int m = 0; m < 4; ++m)
#pragma unroll
                    for (int n = 0; n < 2; ++n) __builtin_amdgcn_raw_buffer_store_b128(__builtin_bit_cast(v4u, acc[ai][bj][m][n]), rs, (unsigned)((((ai * 2 + bj) * 4 + m) * 2 + n) * 8192 + threadIdx.x * 16), 0, 16);
    }
};
struct Epi1Half {
    static constexpr bool PERM = true, AFTER_DRAIN = false;
    Epi1 base; const float* tile; const unsigned* cnt;
    __device__ __forceinline__ void operator()(pg8::f32x4 (&acc)[2][2][4][2], const pg8::Unit& u, int wr, int wc, int fr, int fq) const {
        if (threadIdx.x < 64) { unsigned spins = 0;
            while ((unsigned)__builtin_amdgcn_readfirstlane(__hip_atomic_load(cnt, __ATOMIC_RELAXED, __HIP_MEMORY_SCOPE_AGENT)) < 8u) { __builtin_amdgcn_s_sleep(2); if (++spins > (1u << 22)) break; }
            __builtin_amdgcn_fence(__ATOMIC_ACQUIRE, "agent"); asm volatile("s_waitcnt vmcnt(0)" ::: "memory"); }
        asm volatile("" ::: "memory"); __builtin_amdgcn_s_barrier(); asm volatile("" ::: "memory");
        const f32x4* tp = (const f32x4*)tile + threadIdx.x;
#pragma unroll
        for (int ai = 0; ai < 2; ++ai) {
#pragma unroll
            for (int bj = 0; bj < 2; ++bj)
#pragma unroll
                for (int m = 0; m < 4; ++m)
#pragma unroll
                    for (int n = 0; n < 2; ++n) acc[ai][bj][m][n] += tp[(((ai * 2 + bj) * 4 + m) * 2 + n) * 512];
            asm volatile("" ::: "memory");
        }
        base(acc, u, wr, wc, fr, fq);
    }
};

__device__ __forceinline__ void p0_transpose_item(const float* W, int K, int N, bf16* WT, int k0, int n0, int dst_row0, LAS float* scr, int lane) {
#pragma unroll 8
    for (int i = 0; i < 32; ++i) { const int kk = 2 * i + (lane >> 5); scr[kk * 33 + (lane & 31)] = W[(size_t)(k0 + kk) * N + n0 + (lane & 31)]; }
    LDS_WAIT();
    const int c = lane & 7;
#pragma unroll
    for (int j = 0; j < 4; ++j) { const int n = (lane >> 3) + 8 * j; const LAS float* s = scr + (8 * c) * 33 + n;
        v4u o; o.x = pk2(s[0 * 33], s[1 * 33]); o.y = pk2(s[2 * 33], s[3 * 33]); o.z = pk2(s[4 * 33], s[5 * 33]); o.w = pk2(s[6 * 33], s[7 * 33]);
        *(v4u*)(WT + (size_t)(dst_row0 + n) * K + k0 + 8 * c) = o; }
    LDS_WAIT();
}
__device__ __forceinline__ int win_dst_row(int n) {
    if (n < 2048 || n >= 4096) return n;
    if (n < 3072) { const int c = n - 2048; return 2048 + 256 * (c >> 7) + (c & 127); }
    const int c = n - 3072; return 2048 + 256 * (c >> 7) + 128 + (c & 127);
}
__device__ __forceinline__ const float* x_row_ptr(const float* xp, const float* xs, const float* meta, int r) {
    if (r < MP) { const int b = r / TP, t = r - b * TP; return t < NMETA ? meta + (size_t)t * DM : xp + ((size_t)b * SEQ + (t - NMETA)) * DM; }
    return xs + (size_t)(r - MP) * DM;
}
__device__ __forceinline__ void p0_prologue(const Args& a, LAS unsigned char* lds, int gw, int NGW, int wave, int lane) {
    LAS float* scr = (LAS float*)(lds + wave * 16384);
    constexpr int I_IN = 16 * 160, I_W2 = 16 * 32, I_WO = 32 * 32;
    bf16* WinT = (bf16*)(a.ws + WS_WIN); bf16* W2T = (bf16*)(a.ws + WS_W2); bf16* WoT = (bf16*)(a.ws + WS_WOUT);
    for (int it = gw; it < I_IN + I_W2 + I_WO; it += NGW) {
        int r = it;
        if (r < I_IN) { const int kb = r / 160, nb = r % 160; p0_transpose_item(a.in[7], 1024, DIN, WinT, 64 * kb, 32 * nb, win_dst_row(32 * nb), scr, lane); continue; } r -= I_IN;
        if (r < I_W2) { const int kb = r / 32, nb = r % 32; p0_transpose_item(a.in[19], 1024, 1024, W2T, 64 * kb, 32 * nb, 32 * nb, scr, lane); continue; } r -= I_W2;
        { const int kb = r / 32, nb = r % 32; p0_transpose_item(a.in[21], 2048, 1024, WoT, 64 * kb, 32 * nb, 32 * nb, scr, lane); }
    }
    if (gw < 133) { if (lane == 0) *((unsigned*)(a.ws + CTL_CNT) + 64 * gw) = 0u; }
    {
        bf16* BF = (bf16*)(a.ws + CTL_BF); float* NSP = (float*)(a.ws + CTL_NSP);
        for (int i = gw * 64 + lane; i < 2 * 16 * 4096; i += NGW * 64) {
            const int mat = i >> 16, r = i & 65535, h = r >> 12, k = (r >> 6) & 63, n = r & 63;
            const float v = (mat ? a.in[12] : a.in[10])[r] * -1.4426950408889634f;
            const int f = mat * 8 + (n >> 4) * 2 + (k >> 5), ln = ((k & 31) >> 3) * 16 + (n & 15), e = k & 7;
            BF[((size_t)(h * 16 + f) * 64 + ln) * 8 + e] = (bf16)(pk2(v, 0.f) & 0xffffu);
        }
        for (int c = gw * 64 + lane; c < 1024; c += NGW * 64) { const float x = -a.in[14][c]; const float sp = fmaxf(x, 0.f) + log1pf(expf(-fabsf(x))); NSP[c] = -8.0f * sp * 1.4426950408889634f; }
    }
    bf16* XN = (bf16*)(a.ws + WS_XN);
    const f32x4* gp = (const f32x4*)a.in[6] + lane;
    f32x4 g[4];
#pragma unroll
    for (int j = 0; j < 4; ++j) g[j] = gp[64 * j];
    for (int r = gw; r < M; r += NGW) {
        const f32x4* xr = (const f32x4*)x_row_ptr(a.in[0], a.in[1], a.in[5], r) + lane;
        f32x4 v[4]; float s = 0.f;
#pragma unroll
        for (int j = 0; j < 4; ++j) { v[j] = xr[64 * j]; s += (v[j].x * v[j].x + v[j].y * v[j].y) + (v[j].z * v[j].z + v[j].w * v[j].w); }
        const float rstd = 1.0f / sqrtf(wave_sum(s) * (1.f / DM) + EPS);
        v2u* o8 = (v2u*)(XN + (size_t)r * DM) + lane;
#pragma unroll
        for (int j = 0; j < 4; ++j) { v2u o; o.x = pk2(v[j].x * rstd * g[j].x, v[j].y * rstd * g[j].y); o.y = pk2(v[j].z * rstd * g[j].z, v[j].w * rstd * g[j].w); o8[64 * j] = o; }
    }
}

constexpr int RG_XS0 = 0, RG_XS_SZ = 20160, RG_GS0 = 40320, RG_GS_SZ = 18432, RG_XC = 77184, RG_TOT = 112000, RG_CW = 120192, RG_BF = 121472;
constexpr int XS_STRIDE = 144, XC_STRIDE = 68;

template <bool PACKED>
__device__ __forceinline__ void rg_prefetch(v4u (&px)[3], v4u (&pg)[2], const bf16* XR, const bf16* GR, const float* rgbuf, int row0, int T, int h, int c0, int tid) {
#pragma unroll
    for (int j = 0; j < 3; ++j) {
        const int idx = tid + 512 * j, row = idx >> 3, seg = idx & 7;
        int t;
        if (PACKED) { const int rc = row < 140 ? row : 139; const int q = rc / 35; t = 32 * q + (rc - 35 * q - 3 >= 0 ? rc - 35 * q - 3 : 0); }
        else { t = c0 - 3 + row; t = t < 0 ? 0 : (t > T - 1 ? T - 1 : t); }
        px[j] = *(const v4u*)(XR + (size_t)(row0 + t) * 1024 + h * 64 + seg * 8);
    }
#pragma unroll
    for (int j = 0; j < 2; ++j) {
        const int idx = tid + 512 * j, row = idx >> 3, seg = idx & 7; int t = c0 + row; t = t > T - 1 ? T - 1 : t;
        pg[j] = *(const v4u*)(GR + (size_t)(row0 + t) * 1024 + h * 64 + seg * 8);
    }
}
template <bool PACKED>
__device__ __forceinline__ void rg_stage(LAS unsigned char* lds, int buf, const v4u (&px)[3], const v4u (&pg)[2], const float* rgbuf, int T, int h, int c0, int tid) {
    const v4u z = (v4u){0u, 0u, 0u, 0u};
#pragma unroll
    for (int j = 0; j < 3; ++j) { const int idx = tid + 512 * j, row = idx >> 3, seg = idx & 7;
        v4u v = px[j];
        if (PACKED) {
            if (row < 140) { const int q = row / 35, t = row - 35 * q - 3;
                if (t < 0) { const f32x4* p = (const f32x4*)(rgbuf + (size_t)q * 3072 + (3 + t) * 1024 + h * 64 + seg * 8); const f32x4 a = p[0], b = p[1];
                    v.x = pk2(a.x, a.y); v.y = pk2(a.z, a.w); v.z = pk2(b.x, b.y); v.w = pk2(b.z, b.w); } }
        } else { const int t = c0 - 3 + row; v = (t >= 0 && t < T) ? v : z; }
        if (row < 140) *(LAS v4u*)(lds + RG_XS0 + buf * RG_XS_SZ + row * XS_STRIDE + seg * 16) = v; }
#pragma unroll
    for (int j = 0; j < 2; ++j) { const int idx = tid + 512 * j, row = idx >> 3, seg = idx & 7; const v4u v = (c0 + row < T) ? pg[j] : z;
        *(LAS v4u*)(lds + RG_GS0 + buf * RG_GS_SZ + row * XS_STRIDE + seg * 16) = v; }
}

template <bool PACKED>
__device__ __forceinline__ void rg_item(const Args& a, LAS unsigned char* lds, int sq, int h) {
    const int tid = threadIdx.x, lane = tid & 63, w = __builtin_amdgcn_readfirstlane(tid >> 6), fr = lane & 15, fq = lane >> 4;
    const bf16* XR = (const bf16*)(a.ws + WS_XR); const bf16* GR = (const bf16*)(a.ws + WS_GR); bf16* YCAT = (bf16*)(a.ws + WS_YCAT);
    const int row0 = PACKED ? MP + 128 * sq : sq * TP, T = PACKED ? 128 : TP, nch = PACKED ? 1 : (TP + 127) / 128;
    const float* rgbuf = PACKED ? a.in[3] + (size_t)(4 * sq) * 3072 : nullptr;
    LAS float* cwl = (LAS float*)(lds + RG_CW);
    if (tid < 320) { const int k = tid >> 6, c = tid & 63; cwl[tid] = (k < 4) ? a.in[8][k * 1024 + h * 64 + c] : a.in[9][h * 64 + c]; }
    { const v4u* src = (const v4u*)(a.ws + CTL_BF + (size_t)h * 16384) + tid * 2; LAS v4u* dst = (LAS v4u*)(lds + RG_BF) + tid * 2; dst[0] = src[0]; dst[1] = src[1]; }
    float ba_[4], bx_[4], nsp[4], hc[4];
#pragma unroll
    for (int nt = 0; nt < 4; ++nt) { const int c = h * 64 + 16 * nt + fr; ba_[nt] = -1.4426950408889634f * a.in[11][c]; bx_[nt] = -1.4426950408889634f * a.in[13][c]; nsp[nt] = ((const float*)(a.ws + CTL_NSP))[c];
        hc[nt] = PACKED ? a.in[2][(size_t)(4 * sq + (w >> 1)) * 1024 + c] : 0.f; }
    const int xrow_base = PACKED ? 35 * (w >> 1) + 16 * (w & 1) : 16 * w;

    v4u px[3], pg[2];
    rg_prefetch<PACKED>(px, pg, XR, GR, rgbuf, row0, T, h, 0, tid);
    rg_stage<PACKED>(lds, 0, px, pg, rgbuf, T, h, 0, tid);
    if (nch > 1) { rg_prefetch<PACKED>(px, pg, XR, GR, rgbuf, row0, T, h, 128, tid); rg_stage<PACKED>(lds, 1, px, pg, rgbuf, T, h, 128, tid); }
    lds_barrier();
    LAS float* xcw = (LAS float*)(lds + RG_XC + w * (16 * XC_STRIDE * 4));
    LAS unsigned char* ysw = (LAS unsigned char*)xcw;
    for (int ch = 0; ch < nch; ++ch) {
        const int c0 = ch * 128, buf = ch & 1;
        if (ch + 2 < nch) rg_prefetch<PACKED>(px, pg, XR, GR, rgbuf, row0, T, h, c0 + 256, tid);
        const LAS unsigned char* xs = lds + RG_XS0 + buf * RG_XS_SZ; const LAS unsigned char* gs = lds + RG_GS0 + buf * RG_GS_SZ;
        bf16x8 Af[2];
#pragma unroll
        for (int ks = 0; ks < 2; ++ks) {
            const int cb = 32 * ks + 8 * fq;
            f32x4 lo = *(const LAS f32x4*)(cwl + 256 + cb), hi = *(const LAS f32x4*)(cwl + 256 + cb + 4);
#pragma unroll
            for (int k = 0; k < 4; ++k) {
                const v4u xv = *(const LAS v4u*)(xs + (xrow_base + fr + k) * XS_STRIDE + cb * 2);
                const f32x4 wl = *(const LAS f32x4*)(cwl + 64 * k + cb), wh = *(const LAS f32x4*)(cwl + 64 * k + cb + 4);
                lo.x += wl.x * bflo(xv.x); lo.y += wl.y * bfhi(xv.x); lo.z += wl.z * bflo(xv.y); lo.w += wl.w * bfhi(xv.y);
                hi.x += wh.x * bflo(xv.z); hi.y += wh.y * bfhi(xv.z); hi.z += wh.z * bflo(xv.w); hi.w += wh.w * bfhi(xv.w);
            }
            v4u u; u.x = pk2(lo.x, lo.y); u.y = pk2(lo.z, lo.w); u.z = pk2(hi.x, hi.y); u.w = pk2(hi.z, hi.w);
            Af[ks] = __builtin_bit_cast(bf16x8, u);
            *(LAS f32x4*)(xcw + fr * XC_STRIDE + cb) = lo; *(LAS f32x4*)(xcw + fr * XC_STRIDE + cb + 4) = hi;
        }
        f32x4 accA[4], accX[4];
#pragma unroll
        for (int nt = 0; nt < 4; ++nt) { accA[nt] = (f32x4){ba_[nt], ba_[nt], ba_[nt], ba_[nt]}; accX[nt] = (f32x4){bx_[nt], bx_[nt], bx_[nt], bx_[nt]};
#pragma unroll
            for (int ks = 0; ks < 2; ++ks) { const bf16x8 Ba = *(const LAS bf16x8*)(lds + RG_BF + ((nt * 2 + ks) * 64 + lane) * 16), Bx = *(const LAS bf16x8*)(lds + RG_BF + ((8 + nt * 2 + ks) * 64 + lane) * 16);
                                             accA[nt] = __builtin_amdgcn_mfma_f32_16x16x32_bf16(Af[ks], Ba, accA[nt], 0, 0, 0);
                                             accX[nt] = __builtin_amdgcn_mfma_f32_16x16x32_bf16(Af[ks], Bx, accX[nt], 0, 0, 0); } }
        LDS_WAIT();
        float hl[4][4], pl[4][4], sg[4][4], PE[4], HE[4];
#pragma unroll
        for (int nt = 0; nt < 4; ++nt) {
            float P = 1.f, H = 0.f;
#pragma unroll
            for (int j = 0; j < 4; ++j) {
                const int row = 4 * fq + j, cc = 16 * nt + fr;
                const float xc = xcw[row * XC_STRIDE + cc];
                const unsigned short gsv = *(const LAS unsigned short*)(gs + (16 * w + row) * XS_STRIDE + cc * 2);
                sg[nt][j] = __builtin_bit_cast(float, (unsigned)gsv << 16);
                float r = __builtin_amdgcn_rcpf(1.0f + __builtin_amdgcn_exp2f(accA[nt][j])); const float ig = __builtin_amdgcn_rcpf(1.0f + __builtin_amdgcn_exp2f(accX[nt][j]));
                if (!PACKED && c0 + 16 * w + row >= T) r = 0.f;
                const float av = __builtin_amdgcn_exp2f(r * nsp[nt]);
                const float bv = __builtin_amdgcn_sqrtf(fmaf(-av, av, 1.0f)) * (ig * xc);
                H = fmaf(av, H, bv); P *= av; hl[nt][j] = H; pl[nt][j] = P;
            }
            float Pi = P, Hi = H;
            { const float tp = __shfl_up(Pi, 16), th = __shfl_up(Hi, 16); if (fq >= 1) { Hi = fmaf(Pi, th, Hi); Pi *= tp; } }
            { const float tp = __shfl_up(Pi, 32), th = __shfl_up(Hi, 32); if (fq >= 2) { Hi = fmaf(Pi, th, Hi); Pi *= tp; } }
            { const float tp = __shfl_up(Pi, 16), th = __shfl_up(Hi, 16); PE[nt] = fq >= 1 ? tp : 1.f; HE[nt] = fq >= 1 ? th : 0.f; }
            if (fq == 3) *(LAS f32x2*)(lds + RG_TOT + ((buf * 8 + w) * 64 + 16 * nt + fr) * 8) = (f32x2){Pi, Hi};
        }
        lds_barrier();
#pragma unroll
        for (int nt = 0; nt < 4; ++nt) {
            float cin;
            if (PACKED) {
                const f32x2 tp = *(const LAS f32x2*)(lds + RG_TOT + ((buf * 8 + (w & 6)) * 64 + 16 * nt + fr) * 8);
                const f32x2 tq = *(const LAS f32x2*)(lds + RG_TOT + ((buf * 8 + (w | 1)) * 64 + 16 * nt + fr) * 8);
                const float mid = fmaf(tp.x, hc[nt], tp.y);
                cin = (w & 1) ? mid : hc[nt];
                hc[nt] = fmaf(tq.x, mid, tq.y);
            } else {
                float run = hc[nt]; cin = 0.f;
#pragma unroll
                for (int ww = 0; ww < 8; ++ww) { const f32x2 t = *(const LAS f32x2*)(lds + RG_TOT + ((buf * 8 + ww) * 64 + 16 * nt + fr) * 8);
                    if (ww == w) cin = run; run = fmaf(t.x, run, t.y); }
                hc[nt] = run;
            }
            const float Gc = fmaf(PE[nt], cin, HE[nt]);
#pragma unroll
            for (int j = 0; j < 4; ++j) { const float hv = fmaf(pl[nt][j], Gc, hl[nt][j]); const float y = hv * sg[nt][j];
                *(LAS unsigned short*)(ysw + (4 * fq + j) * XS_STRIDE + (16 * nt + fr) * 2) = (unsigned short)(pk2(y, 0.f) & 0xffffu); }
        }
        LDS_WAIT();
        { const int row = lane >> 2, q = lane & 3, t = c0 + 16 * w + row;
          const v4u y0 = *(const LAS v4u*)(ysw + row * XS_STRIDE + q * 32), y1 = *(const LAS v4u*)(ysw + row * XS_STRIDE + q * 32 + 16);
          LDS_WAIT();
          if (ch + 2 < nch) { asm volatile("s_waitcnt vmcnt(0)" ::: "memory"); rg_stage<PACKED>(lds, buf, px, pg, rgbuf, T, h, c0 + 256, tid); asm volatile("" ::: "memory"); }
          if (t < T) { bf16* dst = YCAT + (size_t)(row0 + t) * 2048 + h * 64 + q * 16; *(v4u*)dst = y0; *(v4u*)(dst + 8) = y1; } }
    }
    if (PACKED) { if ((w & 1) && fq == 0) {
#pragma unroll
        for (int nt = 0; nt < 4; ++nt) a.out[O_RGH_S + (size_t)(4 * sq + (w >> 1)) * 1024 + h * 64 + 16 * nt + fr] = hc[nt]; }
    } else { if (w == 0 && fq == 0) {
#pragma unroll
        for (int nt = 0; nt < 4; ++nt) a.out[O_RGH_P + (size_t)sq * 1024 + h * 64 + 16 * nt + fr] = hc[nt]; } }
    lds_barrier();
}

constexpr int CV_GB = 131072;
__device__ __forceinline__ void cv_unit(const Args& a, LAS unsigned char* lds, int s, int sb0, int sb1, const f32x2 (&cw)[31], f32x2 cb) {
    const int tid = threadIdx.x, lane = tid & 63, w = __builtin_amdgcn_readfirstlane(tid >> 6);
    const bf16* V = (const bf16*)(a.ws + WS_V); bf16* VN = (bf16*)(a.ws + WS_XN);
    int row0; const float* cvbuf = nullptr;
    if (s < NB) row0 = s * TP; else { const int q = s - NB; row0 = MP + q * DS; cvbuf = a.in[4] + (size_t)q * 30 * 1024; }
    unsigned win[30], cur[16], nxt[16];
    if (cvbuf) {
#pragma unroll
        for (int i = 0; i < 30; ++i) { const f32x2 f = *(const f32x2*)(cvbuf + i * 1024 + 2 * tid); win[i] = pk2(f.x, f.y); }
    } else {
#pragma unroll
        for (int i = 0; i < 30; ++i) { const int j = 16 * sb0 + i - 30; const unsigned u = *(const unsigned*)(V + (size_t)(row0 + (j < 0 ? 0 : j)) * 1024 + 2 * tid); win[i] = j < 0 ? 0u : u; }
    }
#pragma unroll
    for (int i = 0; i < 16; ++i) { cur[i] = *(const unsigned*)(V + (size_t)(row0 + 16 * sb0 + i) * 1024 + 2 * tid); nxt[i] = 0u; }
    const LAS f32x4* gl = (const LAS f32x4*)(lds + CV_GB) + lane; const LAS f32x4* bl = (const LAS f32x4*)(lds + CV_GB + 4096) + lane;
    for (int sb = sb0; sb < sb1; ++sb) {
        { const int sbn = sb + 1 < sb1 ? sb + 1 : sb;
#pragma unroll
            for (int i = 0; i < 16; ++i) nxt[i] = *(const unsigned*)(V + (size_t)(row0 + 16 * sbn + i) * 1024 + 2 * tid);
        }
        f32x2 o[16];
#pragma unroll
        for (int k = 0; k < 16; ++k) o[k] = cb;
#pragma unroll
        for (int i = 0; i < 46; ++i) {
            const unsigned u = i < 30 ? win[i] : cur[i - 30];
            const f32x2 x = (f32x2){bflo(u), bfhi(u)};
#pragma unroll
            for (int k = 0; k < 16; ++k) { const int tap = i - k; if (tap >= 0 && tap <= 30) o[k] = cw[tap] * x + o[k]; }
        }
        LAS float* cbuf = (LAS float*)(lds + ((sb - sb0) & 1) * 65536);
#pragma unroll
        for (int k = 0; k < 16; ++k) *(LAS f32x2*)(cbuf + k * 1024 + 2 * tid) = o[k];
#pragma unroll
        for (int i = 0; i < 14; ++i) win[i] = win[i + 16];
#pragma unroll
        for (int i = 0; i < 16; ++i) win[14 + i] = cur[i];
        lds_barrier();
        f32x4 v[2][4]; float s1[2], s2[2];
#pragma unroll
        for (int rr = 0; rr < 2; ++rr) { s1[rr] = 0.f; s2[rr] = 0.f;
#pragma unroll
            for (int j = 0; j < 4; ++j) { const f32x4 x = *(const LAS f32x4*)(cbuf + (2 * w + rr) * 1024 + 4 * lane + 256 * j); v[rr][j] = x;
                s1[rr] += (x.x + x.y) + (x.z + x.w); s2[rr] += (x.x * x.x + x.y * x.y) + (x.z * x.z + x.w * x.w); } }
#pragma unroll
        for (int rr = 0; rr < 2; ++rr) { s1[rr] = wave_sum(s1[rr]); s2[rr] = wave_sum(s2[rr]); }
        v2u ov[2][4];
#pragma unroll
        for (int rr = 0; rr < 2; ++rr) {
            const float mean = s1[rr] * (1.f / 1024.f), var = fmaxf(s2[rr] * (1.f / 1024.f) - mean * mean, 0.f);
            const float rstd = 1.0f / sqrtf(var + EPS);
#pragma unroll
            for (int j = 0; j < 4; ++j) {
                const f32x4 y = (v[rr][j] - mean) * rstd * gl[64 * j] + bl[64 * j];
                ov[rr][j].x = pk2(fsilu(y.x), fsilu(y.y)); ov[rr][j].y = pk2(fsilu(y.z), fsilu(y.w));
            }
        }
        asm volatile("s_waitcnt vmcnt(0)" ::: "memory");
#pragma unroll
        for (int i = 0; i < 16; ++i) cur[i] = nxt[i];
        asm volatile("" ::: "memory");
#pragma unroll
        for (int rr = 0; rr < 2; ++rr) { v2u* dst = (v2u*)(VN + (size_t)(row0 + 16 * sb + 2 * w + rr) * 1024) + lane;
#pragma unroll
            for (int j = 0; j < 4; ++j) dst[64 * j] = ov[rr][j]; }
    }
    lds_barrier();
}

constexpr size_t CTL_BAR = 36864;
constexpr int LDS_BARST = 143360;
#define XB_TMO      128
#define XB_XCNT(j)  (256  + 64 * (j))
#define XB_XSUB(j)  (1280 + 64 * (j))
#define XB_XGEN(j)  (2304 + 64 * (j))
#define XB_TOP      3328
#define XB_TOPGEN   3392
#define XCD_BAR_WORDS 3456
#define XB_SPIN_CAP (1u << 18)

__device__ __forceinline__ unsigned xb_ld(unsigned* p)              { return __hip_atomic_load(p, __ATOMIC_RELAXED, __HIP_MEMORY_SCOPE_AGENT); }
__device__ __forceinline__ unsigned xb_add(unsigned* p, unsigned v) { return __hip_atomic_fetch_add(p, v, __ATOMIC_RELAXED, __HIP_MEMORY_SCOPE_AGENT); }
__device__ __forceinline__ unsigned xb_xcc_id() { return (unsigned)__builtin_amdgcn_s_getreg((3 << 11) | 20) & 0xFu; }
#define XB_SPIN(cond, bar) do { unsigned _sp = 0; while (cond) { __builtin_amdgcn_s_sleep(1); \
    if ((++_sp & 255u) == 0u) { if (xb_ld(&(bar)[XB_TMO])) break; if (_sp > XB_SPIN_CAP) { atomicAdd(&(bar)[XB_TMO], 1u); break; } } } } while (0)

struct XcdBarrier {
    unsigned* bar; unsigned x;
    volatile LAS unsigned* st;
};

__device__ __forceinline__ XcdBarrier xcd_barrier_post(unsigned* bar, volatile LAS unsigned* st) {
    XcdBarrier b; b.bar = bar; b.x = xb_xcc_id(); b.st = st;
    if (threadIdx.x == 0) (void)xb_add(&bar[XB_XCNT(b.x)], 1u);
    return b;
}
__device__ __forceinline__ void xcd_barrier_complete(unsigned* bar, unsigned x, unsigned& nloc, unsigned& nx) {
    const unsigned G = gridDim.x * gridDim.y * gridDim.z;
    unsigned sum, cnt, mine, sp = 0u;
    for (;;) {
        sum = 0u; cnt = 0u; mine = 0u;
#pragma unroll
        for (unsigned j = 0; j < 16; ++j) { const unsigned c = xb_ld(&bar[XB_XCNT(j)]); sum += c; cnt += (c > 0u) ? 1u : 0u; mine = (j == x) ? c : mine; }
        if (sum == G) break;
        __builtin_amdgcn_s_sleep(1);
        if ((++sp & 255u) == 0u) { if (xb_ld(&bar[XB_TMO])) break; if (sp > XB_SPIN_CAP) { atomicAdd(&bar[XB_TMO], 1u); break; } }
    }
    nloc = mine > 0u ? mine : 1u; nx = cnt > 0u ? cnt : 1u;
}

__device__ __forceinline__ void xcd_barrier(const XcdBarrier& b) {
    asm volatile("s_waitcnt vmcnt(0)" ::: "memory");
    __syncthreads();
    if (threadIdx.x == 0) {
        unsigned* bar = b.bar;
        __builtin_amdgcn_s_waitcnt(0);
        unsigned nloc = b.st[0], nx = b.st[1];
        if (nloc == 0u) { xcd_barrier_complete(bar, b.x, nloc, nx); b.st[0] = nloc; b.st[1] = nx; }
        const unsigned old = xb_add(&bar[XB_XSUB(b.x)], 1u);
        const unsigned gen = old / nloc;
        if (old + 1u == (gen + 1u) * nloc) {
            __builtin_amdgcn_fence(__ATOMIC_RELEASE, "agent");
            asm volatile("s_waitcnt vmcnt(0)" ::: "memory");
            const unsigned og = xb_add(&bar[XB_TOP], 1u);
            const unsigned tg = og / nx;
            if (og + 1u == (tg + 1u) * nx) xb_add(&bar[XB_TOPGEN], 1u);
            else XB_SPIN(xb_ld(&bar[XB_TOPGEN]) == tg, bar);
            __builtin_amdgcn_fence(__ATOMIC_ACQUIRE, "agent");
            xb_add(&bar[XB_XGEN(b.x)], 1u);
            asm volatile("s_waitcnt vmcnt(0)" ::: "memory");
        } else {
            XB_SPIN(xb_ld(&bar[XB_XGEN(b.x)]) == gen, bar);
            __builtin_amdgcn_fence(__ATOMIC_ACQUIRE, "agent");
            asm volatile("s_waitcnt vmcnt(0)" ::: "memory");
        }
    }
    __syncthreads();
}

__device__ __forceinline__ void stagger(unsigned ticks) {
    if (ticks) { const unsigned long long t0 = __builtin_amdgcn_s_memrealtime(); while (__builtin_amdgcn_s_memrealtime() - t0 < (unsigned long long)ticks) __builtin_amdgcn_s_sleep(16); }
}
__global__ void __launch_bounds__(512, 2) hymba_fwd(Args args) {
    extern __shared__ __attribute__((aligned(16))) unsigned char lds_raw[];
    cg::grid_group grid = cg::this_grid();
    LAS unsigned char* lds = (LAS unsigned char*)lds_raw;
    const int tid = threadIdx.x, lane = tid & 63, wave = __builtin_amdgcn_readfirstlane(tid >> 6);
    const int G = gridDim.x, bx = blockIdx.x;
    const int vcu = (G % 8 == 0) ? (bx % 8) * (G / 8) + bx / 8 : bx;
    const int gw = vcu * 8 + wave, NGW = G * 8;
    const int lo = args.ph_lo, hi = args.ph_hi;
#define IN(k) (lo <= (k) && (k) < hi)
#define BOTH(k) (IN(k) && IN((k) + 1))
    unsigned char* ws = args.ws;
    if (tid < 2) ((volatile LAS unsigned*)(lds + LDS_BARST))[tid] = 0u;
    __syncthreads();
    const XcdBarrier bar = xcd_barrier_post((unsigned*)(ws + CTL_BAR), (volatile LAS unsigned*)(lds + LDS_BARST));
    if (args.ph_lo < 0) grid.sync();

    if (IN(0)) { p0_prologue(args, lds, gw, NGW, wave, lane); if (BOTH(0)) xcd_barrier(bar); }

    if (IN(1)) {
        Epi1 E{(bf16*)(ws + WS_XR), (bf16*)(ws + WS_GR), (bf16*)(ws + WS_V), (bf16*)(ws + WS_GC)};
        if (G == 256) {
            { pg8::Gemm g{(const bf16*)(ws + WS_XN), (const bf16*)(ws + WS_WIN), M, DIN, 1024, 1024, 1024}; LimitedOrder S; S.init(M, DIN, G, bx); S.imax = 10;
              pg8::gemm_phase<Epi1, LimitedOrder, PG8_ALIGN, PG8_SP2>(lds, g, S, E); }
            unsigned* cnth = (unsigned*)(ws + CTL_CNTH);
            if (bx < 100) {
                pg8::Gemm g{(const bf16*)(ws + WS_XN), (const bf16*)(ws + WS_WIN), M, DIN, 512, 1024, 1024}; OneOf S; S.init(M, DIN, G, bx); S.round = 10; S.on = true; S.pub = nullptr; S.slot = 0;
                Epi1Half Eh{E, (const float*)(ws + WS_HALF) + (size_t)bx * 65536, cnth + 8 * bx};
                pg8::gemm_phase<Epi1Half, OneOf, true, PG8_SP2>(lds, g, S, Eh);
            } else if (bx < 200) {
                pg8::Gemm g{(const bf16*)(ws + WS_XN) + 512, (const bf16*)(ws + WS_WIN) + 512, M, DIN, 512, 1024, 1024}; OneOf S; S.init(M, DIN, G, bx - 100); S.round = 10; S.on = true; S.pub = cnth; S.slot = bx - 100;
                EpiHalfOut Eo{(float*)(ws + WS_HALF) + (size_t)(bx - 100) * 65536};
                pg8::gemm_phase<EpiHalfOut, OneOf, true, PG8_SP2>(lds, g, S, Eo);
            }
        } else {
            pg8::Gemm g{(const bf16*)(ws + WS_XN), (const bf16*)(ws + WS_WIN), M, DIN, 1024, 1024, 1024}; pg8::StaticOrder S; S.init(M, DIN, G, bx);
            pg8::gemm_phase<Epi1, pg8::StaticOrder, PG8_ALIGN, PG8_SP2>(lds, g, S, E);
        }
        if (BOTH(1)) xcd_barrier(bar);
    }

    if (IN(2)) {
        __syncthreads();
        if (args.p2mask & 1) for (int it = bx; it < NB * 16; it += G) rg_item<false>(args, lds, it >> 4, it & 15);
        if (args.p2mask & 2) {
            for (int i = tid; i < 2048; i += 512) ((LAS float*)(lds + CV_GB))[i] = (i < 1024) ? args.in[17][i] : args.in[18][i - 1024];
            f32x2 cw[31];
#pragma unroll
            for (int k = 0; k < 31; ++k) cw[k] = *(const f32x2*)(args.in[15] + k * 1024 + 2 * tid);
            const f32x2 cb = *(const f32x2*)(args.in[16] + 2 * tid);
            __syncthreads();
            for (int it = bx; it < NB * 16; it += G) {
                const int q = it >> 4, j = it & 15, nrep = (j == 15) ? 2 : 1;
                for (int r = 0; r < nrep; ++r) {
                    int s, sb0, sb1;
                    if (j < 15) { s = q; sb0 = 9 * j; sb1 = (j == 14) ? TP / 16 : 9 * j + 9; } else { s = NB + 2 * q + r; sb0 = 0; sb1 = 2; }
                    cv_unit(args, lds, s, sb0, sb1, cw, cb);
                }
            }
        }
        if (args.p2mask & 4) for (int it = G - 1 - bx; it < 128; it += G) rg_item<true>(args, lds, it >> 4, it & 15);
        if (args.p2mask & 8) {
            const bf16* XR = (const bf16*)(ws + WS_XR); const bf16* V = (const bf16*)(ws + WS_V);
            const int gt = vcu * 512 + tid, NGT = G * 512;
            for (int i = gt; i < NSEQ * 33 * 512; i += NGT) {
                const int c2 = i & 511, rr = (i >> 9) % 33, s = (i >> 9) / 33;
                int row0, T; float* o3; float* o30;
                if (s < NB) { row0 = s * TP; T = TP; o3 = args.out + O_RGC_P + (size_t)s * 3 * 1024; o30 = args.out + O_CVC_P + (size_t)s * 30 * 1024; }
                else { const int q = s - NB; row0 = MP + q * DS; T = DS; o3 = args.out + O_RGC_S + (size_t)q * 3 * 1024; o30 = args.out + O_CVC_S + (size_t)q * 30 * 1024; }
                if (rr < 3) { const unsigned u = *(const unsigned*)(XR + (size_t)(row0 + T - 3 + rr) * 1024 + 2 * c2); *(f32x2*)(o3 + rr * 1024 + 2 * c2) = (f32x2){bflo(u), bfhi(u)}; }
                else { const int r2 = rr - 3; const unsigned u = *(const unsigned*)(V + (size_t)(row0 + T - 30 + r2) * 1024 + 2 * c2); *(f32x2*)(o30 + r2 * 1024 + 2 * c2) = (f32x2){bflo(u), bfhi(u)}; }
            }
        }
        if (BOTH(2)) xcd_barrier(bar);
    }

    if (IN(3)) {
        unsigned* cnt3 = (unsigned*)(ws + CTL_CNT3); unsigned* cntp = (unsigned*)(ws + CTL_CNTP);
        const bool ksplit = (G == 256);
        {
            pg8::Gemm g{(const bf16*)(ws + WS_XN), (const bf16*)(ws + WS_W2), M, 1024, 1024, 1024, 1024}; OrderP4 S; S.init(133, G, vcu, cnt3, nullptr);
            Epi2 E{(bf16*)(ws + WS_YCAT), (const bf16*)(ws + WS_GC), args.in[20]};
            pg8::gemm_phase<Epi2, OrderP4, PG8_ALIGN, PG8_SP2>(lds, g, S, E);
        }
        if (ksplit) {
            pg8::Gemm gp{(const bf16*)(ws + WS_YCAT), (const bf16*)(ws + WS_WOUT), M, 1024, 1024, 2048, 2048}; TailOrder Sp{vcu - 40, cntp, nullptr, nullptr};
            Epi3 Ep{(float*)(ws + WS_PART)};
            pg8::gemm_phase<Epi3, TailOrder, PG8_ALIGN, PG8_SP2>(lds, gp, Sp, Ep);
        }
        {
            pg8::Gemm g{(const bf16*)(ws + WS_YCAT), (const bf16*)(ws + WS_WOUT), M, 1024, 2048, 2048, 2048}; OrderP4 S; S.init(ksplit ? 128 : 133, G, vcu, nullptr, cnt3);
            EpiFinal E{args.in[0], args.in[1], args.out, args.in[22], (float*)(ws + CTL_SLOTS), (unsigned*)(ws + CTL_CNT), (LAS float*)(lds + 131072), nullptr};
            pg8::gemm_phase<EpiFinal, OrderP4, true, PG8_SP2>(lds, g, S, E);
        }
        if (ksplit) {
            pg8::Gemm g{(const bf16*)(ws + WS_YCAT) + 1024, (const bf16*)(ws + WS_WOUT) + 1024, M, 1024, 1024, 2048, 2048}; TailOrder S{vcu - 80, nullptr, cnt3, cntp};
            EpiFinal E{args.in[0], args.in[1], args.out, args.in[22], (float*)(ws + CTL_SLOTS), (unsigned*)(ws + CTL_CNT), (LAS float*)(lds + 131072), (const float*)(ws + WS_PART)};
            pg8::gemm_phase<EpiFinal, TailOrder, true, PG8_SP2>(lds, g, S, E);
        }
    }
#undef IN
#undef BOTH
}

extern "C" void kernel_launch(void* const* d_in, const int* in_sizes, int n_in, void* d_out, int out_size, void* d_ws, size_t ws_size, hipStream_t stream) {
    static int grid = 0;
    if (grid == 0) {
        if (n_in != 23 || out_size != (int)O_END || ws_size < WS_END) { fprintf(stderr, "kernel_launch: unexpected problem (n_in %d, out %d, ws %zu; need ws >= %zu)\n", n_in, out_size, ws_size, (size_t)WS_END); grid = -1; return; }
        int dev = 0, cus = 0, per_cu = 0;
        if (hipGetDevice(&dev) != hipSuccess || hipDeviceGetAttribute(&cus, hipDeviceAttributeMultiprocessorCount, dev) != hipSuccess) { grid = -1; return; }
        if (hipFuncSetAttribute((const void*)hymba_fwd, hipFuncAttributeMaxDynamicSharedMemorySize, LDS_BYTES) != hipSuccess) { fprintf(stderr, "kernel_launch: hipFuncSetAttribute failed\n"); grid = -1; return; }
        if (hipOccupancyMaxActiveBlocksPerMultiprocessor(&per_cu, (const void*)hymba_fwd, 512, LDS_BYTES) != hipSuccess || per_cu < 1) { fprintf(stderr, "kernel_launch: occupancy query says %d\n", per_cu); per_cu = 1; }
        (void)hipGetLastError();
        grid = cus - (cus % 8);
    }
    if (grid < 0) return;
    Args a{};
    for (int i = 0; i < 23; ++i) a.in[i] = (const float*)d_in[i];
    a.out = (float*)d_out; a.ws = (unsigned char*)d_ws; a.p2mask = 15;
    void* kargs[] = {&a};
#define ZERO_CTL() (void)hipMemsetAsync(d_ws, 0, 65536, stream)
#ifdef PROBE_DBL
    const int cuts[4] = {0, PROBE_DBL + 1, PROBE_DBL + 1, 5}; const int los[3] = {0, PROBE_DBL, PROBE_DBL + 1};
    for (int li = 0; li < 3; ++li) { a.ph_lo = los[li]; a.ph_hi = cuts[li + 1]; if (a.ph_lo >= a.ph_hi) continue; ZERO_CTL();
#ifdef PROBE_P2MASK
        a.p2mask = (li == 1) ? PROBE_P2MASK : 15;
#endif
        hipError_t e = hipLaunchCooperativeKernel((const void*)hymba_fwd, dim3(grid), dim3(512), kargs, LDS_BYTES, stream);
        if (e != hipSuccess) fprintf(stderr, "kernel_launch: cooperative launch failed: %s (grid %d)\n", hipGetErrorString(e), grid); }
#else
    a.ph_lo = 0; a.ph_hi = 4; ZERO_CTL();
    hipError_t e = hipLaunchCooperativeKernel((const void*)hymba_fwd, dim3(grid), dim3(512), kargs, LDS_BYTES, stream);
    if (e != hipSuccess) fprintf(stderr, "kernel_launch: cooperative launch failed: %s (grid %d)\n", hipGetErrorString(e), grid);
#endif
}
```
